# Optimizing an MI355X kernel written in HIP

```python
import math
import jax
import jax.numpy as jnp
from jax import lax
import numpy as np

D_MODEL = 1024
BATCH = 16
SEQ = 2048
DEPTH = 2
DEC_BATCH = 8
DEC_SEQ = 4096
PAST_LEN = 128

BRANCH_W = D_MODEL // 2
N_BRANCH = 3
D_FF = 2816
RMS_EPS = 1e-6

S5_H = 16
S5_G = BRANCH_W // S5_H
S5_P = 64
S5_DT_MIN = 1e-3
S5_DT_MAX = 1e-1
S5_MAX_RE = -1e-4

HEAD_DIM = 64
ATT_HQ = BRANCH_W // HEAD_DIM
ATT_HKV = 2
ATT_GROUP = ATT_HQ // ATT_HKV
WINDOW = 128
ATT_BLOCK = 128
ROPE_DIM = HEAD_DIM // 4
ROPE_THETA = 500000.0
NEG_INF = -1e30

RW_N = 64
RW_H = BRANCH_W // RW_N
RW_RANK_W = 64
RW_RANK_A = 64
RW_RANK_G = 128
RW_LN_EPS = 64e-5
N_RW_IN = 3 * BRANCH_W + 2 * RW_RANK_W + 2 * RW_RANK_A + RW_RANK_G

N_IN = BRANCH_W + ATT_HQ * HEAD_DIM + 2 * ATT_HKV * HEAD_DIM + N_RW_IN + N_BRANCH * D_MODEL

kernel_name = 'hybrid_bidir_s5_swa_rwkv7_encoder'


def rms_norm(x, gain):
    xf = x.astype(jnp.float32)
    y = xf * lax.rsqrt(jnp.mean(xf * xf, axis=-1, keepdims=True) + RMS_EPS)
    return (y * gain.astype(jnp.float32)).astype(x.dtype)


def swiglu(h, w_gate, w_up, w_down):
    return (jax.nn.silu(h @ w_gate) * (h @ w_up)) @ w_down


def rope_tables(seq_len):
    inv_freq = ROPE_THETA ** (-jnp.arange(0, ROPE_DIM, 2, dtype=jnp.float32) / ROPE_DIM)
    ang = jnp.arange(seq_len, dtype=jnp.float32)[:, None] * inv_freq[None, :]
    return jnp.cos(ang), jnp.sin(ang)


def partial_rope(t, cos, sin):
    half = ROPE_DIM // 2
    tf = t.astype(jnp.float32)
    t1, t2 = tf[..., :half], tf[..., half:ROPE_DIM]
    c, s = cos[None, :, None, :], sin[None, :, None, :]
    rot = jnp.concatenate([t1 * c - t2 * s, t2 * c + t1 * s], axis=-1)
    return jnp.concatenate([rot, tf[..., ROPE_DIM:]], axis=-1).astype(t.dtype)


def _linear_recurrence(e1, e2):
    a1, b1 = e1
    a2, b2 = e2
    return a1 * a2, a2 * b1 + b2


def s5_branch(u, lam_re, lam_im, log_step, b_re, b_im, c_re, c_im, d_skip, w_glu):
    bsz, seq_len, _ = u.shape
    f32 = jnp.float32
    uf = u.astype(f32).reshape(bsz, seq_len, S5_G, S5_H)
    y = d_skip.astype(f32) * uf
    for d in range(2):
        lam = lax.complex(jnp.minimum(lam_re[d].astype(f32), S5_MAX_RE), lam_im[d].astype(f32))
        dt = jnp.exp(log_step[d].astype(f32))[:, None]
        a_bar = jnp.exp(lam * dt)
        b_bar = ((a_bar - 1.0) / lam)[..., None] * lax.complex(b_re[d].astype(f32), b_im[d].astype(f32))
        bu = jnp.einsum('blgh,gph->blgp', uf, b_bar)
        a_seq = jnp.broadcast_to(a_bar, (1, seq_len, S5_G, S5_P))
        _, states = lax.associative_scan(_linear_recurrence, (a_seq, bu), reverse=(d == 1), axis=1)
        c = lax.complex(c_re[d].astype(f32), c_im[d].astype(f32))
        y = y + jnp.real(jnp.einsum('blgp,ghp->blgh', states, c))
    y = jax.nn.gelu(y.reshape(bsz, seq_len, BRANCH_W)).astype(u.dtype)
    return y * jax.nn.sigmoid(y @ w_glu)


def band_blocks(t):
    bsz, seq_len, nh, hd = t.shape
    nb = seq_len // ATT_BLOCK
    tp = jnp.pad(t, ((0, 0), (ATT_BLOCK, ATT_BLOCK), (0, 0), (0, 0)))
    tp = tp.reshape(bsz, nb + 2, ATT_BLOCK, nh, hd)
    return jnp.concatenate([tp[:, :-2], tp[:, 1:-1], tp[:, 2:]], axis=2)


def window_attention(q, k, v, q_gain, k_gain, sink, cos, sin):
    bsz, seq_len = q.shape[:2]
    nb = seq_len // ATT_BLOCK
    q = partial_rope(rms_norm(q, q_gain), cos, sin)
    k = partial_rope(rms_norm(k, k_gain), cos, sin)
    qb = q.reshape(bsz, nb, ATT_BLOCK, ATT_HKV, ATT_GROUP, HEAD_DIM)
    kb, vb = band_blocks(k), band_blocks(v)
    s = jnp.einsum('bnqkgd,bnskd->bnkgqs', qb, kb).astype(jnp.float32) * (HEAD_DIM ** -0.5)
    blk = jnp.arange(nb)[:, None, None] * ATT_BLOCK
    qpos = blk + jnp.arange(ATT_BLOCK)[None, :, None]
    kpos = blk - ATT_BLOCK + jnp.arange(3 * ATT_BLOCK)[None, None, :]
    mask = (jnp.abs(kpos - qpos) <= WINDOW) & (kpos >= 0) & (kpos < seq_len)
    s = jnp.where(mask[None, :, None, None], s, NEG_INF)
    sink_col = jnp.broadcast_to(sink.astype(jnp.float32).reshape(1, 1, ATT_HKV, ATT_GROUP, 1, 1),
                                s.shape[:-1] + (1,))
    p = jax.nn.softmax(jnp.concatenate([s, sink_col], axis=-1), axis=-1)[..., :-1]
    o = jnp.einsum('bnkgqs,bnskd->bnqkgd', p.astype(v.dtype), vb)
    return o.reshape(bsz, seq_len, ATT_HQ * HEAD_DIM)


def token_shift_centred(z, mu):
    prev = jnp.pad(z[:, :-1], ((0, 0), (1, 0), (0, 0)))
    nxt = jnp.pad(z[:, 1:], ((0, 0), (0, 1), (0, 0)))
    return z + mu[0] * (prev - z) + mu[1] * (nxt - z)


def wkv7_scan(r, w, k, v, kk, a, reverse):
    bsz = r.shape[0]
    xs = tuple(jnp.moveaxis(t, 1, 0) for t in (r, w, k, v, kk, a))

    def step(state, inp):
        r_t, w_t, k_t, v_t, kk_t, a_t = inp
        sa = jnp.einsum('bhij,bhj->bhi', state, -kk_t)
        state = (state * w_t[:, :, None, :]
                 + sa[..., None] * (kk_t * a_t)[:, :, None, :]
                 + v_t[..., None] * k_t[:, :, None, :])
        return state, jnp.einsum('bhij,bhj->bhi', state, r_t)

    state0 = jnp.zeros((bsz, RW_H, RW_N, RW_N), jnp.float32)
    _, ys = lax.scan(step, state0, xs, reverse=reverse)
    return jnp.moveaxis(ys, 0, 1)


def rwkv7_branch(z, mu, w0, w2, a0, a2, g2, k_k, k_a, r_k, ln_w, ln_b):
    bsz, seq_len, _ = z.shape
    f32 = jnp.float32
    z = token_shift_centred(z, mu)
    idx = np.cumsum([BRANCH_W, BRANCH_W, BRANCH_W, RW_RANK_W, RW_RANK_W, RW_RANK_A, RW_RANK_A]).tolist()
    r, k, v, wl_f, wl_b, al_f, al_b, gl = jnp.split(z, idx, axis=-1)

    def heads(t):
        return t.astype(f32).reshape(bsz, seq_len, RW_H, RW_N)

    rh, kh, vh = heads(r), heads(k), heads(v)
    kk = kh * k_k.astype(f32).reshape(RW_H, RW_N)
    kk = kk / jnp.maximum(jnp.sqrt(jnp.sum(kk * kk, axis=-1, keepdims=True)), 1e-12)
    k_a_h = k_a.astype(f32).reshape(RW_H, RW_N)
    outs = []
    for d, (wl, al) in enumerate(((wl_f, al_f), (wl_b, al_b))):
        w_pre = (w0[d] + jnp.tanh(wl) @ w2[d]).astype(f32)
        decay = heads(jnp.exp(-jnp.exp(-jax.nn.softplus(-w_pre) - 0.5)))
        a = heads(jax.nn.sigmoid((a0[d] + al @ a2[d]).astype(f32)))
        kd = kh * (1.0 + (a - 1.0) * k_a_h)
        outs.append(wkv7_scan(rh, decay, kd, vh, kk, a, reverse=(d == 1)))
    y = outs[0] + outs[1]
    mean = jnp.mean(y, axis=-1, keepdims=True)
    var = jnp.mean(jnp.square(y - mean), axis=-1, keepdims=True)
    y = ((y - mean) * lax.rsqrt(var + RW_LN_EPS)).reshape(bsz, seq_len, BRANCH_W)
    y = y * ln_w.astype(f32) + ln_b.astype(f32)
    bonus = jnp.sum(rh * kh * r_k.astype(f32), axis=-1, keepdims=True) * vh
    y = y + bonus.reshape(bsz, seq_len, BRANCH_W)
    g = jax.nn.sigmoid(gl) @ g2
    return (y * g.astype(f32)).astype(z.dtype)


def encoder_layer(x, p, cos, sin):
    bsz, seq_len, _ = x.shape
    x = x + 0.5 * swiglu(rms_norm(x, p['ffn1_norm']), p['ffn1_w_gate'], p['ffn1_w_up'], p['ffn1_w_down'])
    h = rms_norm(x, p['mix_norm'])
    idx = np.cumsum([BRANCH_W, ATT_HQ * HEAD_DIM, ATT_HKV * HEAD_DIM, ATT_HKV * HEAD_DIM, N_RW_IN]).tolist()
    u_s5, q, k, v, z_rw, gate_logits = jnp.split(h @ p['w_in'], idx, axis=-1)
    y_a = s5_branch(u_s5, p['s5_lam_re'], p['s5_lam_im'], p['s5_log_step'], p['s5_b_re'], p['s5_b_im'],
                    p['s5_c_re'], p['s5_c_im'], p['s5_d'], p['s5_w_glu'])
    y_b = window_attention(q.reshape(bsz, seq_len, ATT_HQ, HEAD_DIM),
                           k.reshape(bsz, seq_len, ATT_HKV, HEAD_DIM),
                           v.reshape(bsz, seq_len, ATT_HKV, HEAD_DIM),
                           p['q_norm'], p['k_norm'], p['attn_sink'], cos, sin)
    y_c = rwkv7_branch(z_rw, p['rw_mu'], p['rw_w0'], p['rw_w2'], p['rw_a0'], p['rw_a2'], p['rw_g2'],
                       p['rw_k_k'], p['rw_k_a'], p['rw_r_k'], p['rw_ln_w'], p['rw_ln_b'])
    up = jnp.einsum('blnw,nwd->blnd', jnp.stack([y_a, y_b, y_c], axis=2), p['w_branch'])
    gates = jax.nn.sigmoid(gate_logits.reshape(bsz, seq_len, N_BRANCH, D_MODEL))
    x = x + jnp.sum(gates * up, axis=2) @ p['w_out']
    x = x + 0.5 * swiglu(rms_norm(x, p['ffn2_norm']), p['ffn2_w_gate'], p['ffn2_w_up'], p['ffn2_w_down'])
    return x


def encoder_trunk(x, weights):
    cos, sin = rope_tables(x.shape[1])
    for i in range(DEPTH):
        x = encoder_layer(x, {name: w[i] for name, w in weights.items()}, cos, sin)
    return x


def setup_inputs(seed: int = 0) -> dict:
    key = jax.random.key(seed)
    ks = jax.random.split(key, 40)
    f32 = jnp.float32

    def nrm(k, shape, scale):
        return scale * jax.random.normal(k, shape, f32)

    W = BRANCH_W
    n_idx = jnp.arange(S5_P, dtype=f32)
    return {
        'x_prompt': nrm(ks[0], (BATCH, SEQ, D_MODEL), 1.0),
        'x_sample': nrm(ks[1], (DEC_BATCH, DEC_SEQ, D_MODEL), 1.0),
        'ffn1_norm': 1.0 + nrm(ks[2], (DEPTH, D_MODEL), 0.02),
        'ffn1_w_gate': nrm(ks[3], (DEPTH, D_MODEL, D_FF), D_MODEL ** -0.5),
        'ffn1_w_up': nrm(ks[4], (DEPTH, D_MODEL, D_FF), D_MODEL ** -0.5),
        'ffn1_w_down': nrm(ks[5], (DEPTH, D_FF, D_MODEL), D_FF ** -0.5),
        'mix_norm': 1.0 + nrm(ks[6], (DEPTH, D_MODEL), 0.02),
        'w_in': nrm(ks[7], (DEPTH, D_MODEL, N_IN), D_MODEL ** -0.5),
        's5_lam_re': -0.5 + nrm(ks[8], (DEPTH, 2, S5_G, S5_P), 0.01),
        's5_lam_im': math.pi * n_idx + nrm(ks[9], (DEPTH, 2, S5_G, S5_P), 0.01),
        's5_log_step': jax.random.uniform(ks[10], (DEPTH, 2, S5_G), f32,
                                          math.log(S5_DT_MIN), math.log(S5_DT_MAX)),
        's5_b_re': nrm(ks[11], (DEPTH, 2, S5_G, S5_P, S5_H), (2 * S5_H) ** -0.5),
        's5_b_im': nrm(ks[12], (DEPTH, 2, S5_G, S5_P, S5_H), (2 * S5_H) ** -0.5),
        's5_c_re': nrm(ks[13], (DEPTH, 2, S5_G, S5_H, S5_P), S5_P ** -0.5),
        's5_c_im': nrm(ks[14], (DEPTH, 2, S5_G, S5_H, S5_P), S5_P ** -0.5),
        's5_d': nrm(ks[15], (DEPTH, S5_G, S5_H), 1.0),
        's5_w_glu': nrm(ks[16], (DEPTH, W, W), W ** -0.5),
        'q_norm': 1.0 + nrm(ks[17], (DEPTH, HEAD_DIM), 0.02),
        'k_norm': 1.0 + nrm(ks[18], (DEPTH, HEAD_DIM), 0.02),
        'attn_sink': nrm(ks[19], (DEPTH, ATT_HQ), 0.5),
        'rw_mu': jax.random.uniform(ks[20], (DEPTH, 2, N_RW_IN), f32, 0.0, 0.5),
        'rw_w0': jax.random.uniform(ks[21], (DEPTH, 2, W), f32, -5.0, -0.5),
        'rw_w2': nrm(ks[22], (DEPTH, 2, RW_RANK_W, W), 0.5 * RW_RANK_W ** -0.5),
        'rw_a0': nrm(ks[23], (DEPTH, 2, W), 0.5),
        'rw_a2': nrm(ks[24], (DEPTH, 2, RW_RANK_A, W), RW_RANK_A ** -0.5),
        'rw_g2': nrm(ks[25], (DEPTH, RW_RANK_G, W), RW_RANK_G ** -0.5),
        'rw_k_k': 0.85 + nrm(ks[26], (DEPTH, W), 0.02),
        'rw_k_a': 1.0 + nrm(ks[27], (DEPTH, W), 0.02),
        'rw_r_k': nrm(ks[28], (DEPTH, RW_H, RW_N), 0.1),
        'rw_ln_w': 1.0 + nrm(ks[29], (DEPTH, W), 0.02),
        'rw_ln_b': nrm(ks[30], (DEPTH, W), 0.02),
        'w_branch': nrm(ks[31], (DEPTH, N_BRANCH, W, D_MODEL), W ** -0.5),
        'w_out': nrm(ks[32], (DEPTH, D_MODEL, D_MODEL), D_MODEL ** -0.5),
        'ffn2_norm': 1.0 + nrm(ks[33], (DEPTH, D_MODEL), 0.02),
        'ffn2_w_gate': nrm(ks[34], (DEPTH, D_MODEL, D_FF), D_MODEL ** -0.5),
        'ffn2_w_up': nrm(ks[35], (DEPTH, D_MODEL, D_FF), D_MODEL ** -0.5),
        'ffn2_w_down': nrm(ks[36], (DEPTH, D_FF, D_MODEL), D_FF ** -0.5),
    }


def reference(x_prompt, x_sample, ffn1_norm, ffn1_w_gate, ffn1_w_up, ffn1_w_down, mix_norm, w_in,
              s5_lam_re, s5_lam_im, s5_log_step, s5_b_re, s5_b_im, s5_c_re, s5_c_im, s5_d, s5_w_glu,
              q_norm, k_norm, attn_sink, rw_mu, rw_w0, rw_w2, rw_a0, rw_a2, rw_g2, rw_k_k, rw_k_a,
              rw_r_k, rw_ln_w, rw_ln_b, w_branch, w_out, ffn2_norm, ffn2_w_gate, ffn2_w_up, ffn2_w_down):
    weights = {
        'ffn1_norm': ffn1_norm, 'ffn1_w_gate': ffn1_w_gate, 'ffn1_w_up': ffn1_w_up,
        'ffn1_w_down': ffn1_w_down, 'mix_norm': mix_norm, 'w_in': w_in,
        's5_lam_re': s5_lam_re, 's5_lam_im': s5_lam_im, 's5_log_step': s5_log_step,
        's5_b_re': s5_b_re, 's5_b_im': s5_b_im, 's5_c_re': s5_c_re, 's5_c_im': s5_c_im,
        's5_d': s5_d, 's5_w_glu': s5_w_glu, 'q_norm': q_norm, 'k_norm': k_norm,
        'attn_sink': attn_sink, 'rw_mu': rw_mu, 'rw_w0': rw_w0, 'rw_w2': rw_w2, 'rw_a0': rw_a0,
        'rw_a2': rw_a2, 'rw_g2': rw_g2, 'rw_k_k': rw_k_k, 'rw_k_a': rw_k_a, 'rw_r_k': rw_r_k,
        'rw_ln_w': rw_ln_w, 'rw_ln_b': rw_ln_b, 'w_branch': w_branch, 'w_out': w_out,
        'ffn2_norm': ffn2_norm, 'ffn2_w_gate': ffn2_w_gate, 'ffn2_w_up': ffn2_w_up,
        'ffn2_w_down': ffn2_w_down,
    }
    y_prompt = encoder_trunk(x_prompt, weights)
    y_sample = encoder_trunk(x_sample, weights)
    return (y_prompt, y_sample)
```

```cpp
#include <hip/hip_runtime.h>
#include <hip/hip_cooperative_groups.h>
#include <cstdio>
namespace cg = cooperative_groups;

typedef unsigned short u16;
typedef unsigned int u32;
typedef unsigned long long u64;
typedef __attribute__((ext_vector_type(8))) short bf16x8;
typedef __attribute__((ext_vector_type(16))) float f32x16;
typedef __attribute__((ext_vector_type(4))) float f32x4;
typedef __bf16 bf2_t __attribute__((ext_vector_type(2)));
typedef float f2_t __attribute__((ext_vector_type(2)));

#define NTOK 65536
#define NTHREADS 512
#define SMEM_BYTES 114688
#define AS_BYTES 36864
#define BS_BYTES 18432
#define MISC_OFF 110592

#define OFF_A 0L
#define OFF_Z 167772160L
#define OFF_Y 419430400L
#define OFF_H 0L
#define OFF_YA OFF_Z
#define OFF_M 234881024L
#define OFF_F 369098752L
#define OFF_FD (OFF_F + 11534336L)
#define OFF_HN 386400256L
#define OFF_WM 486539264L
#define OFF_WIN OFF_WM
#define OFF_WGLU (OFF_WM + 12845056L)
#define OFF_WB (OFF_WGLU + 524288L)
#define OFF_WOUT (OFF_WB + 3145728L)
#define OFF_CAR 505151488L
#define OFF_CTR 521928704L
#define WS_NEED 521932800L

struct Params {
  const float* in[37];
  float* out;
  char* ws;
};

__device__ __forceinline__ int tid_() {
  int t = threadIdx.x;
  asm volatile("" : "+v"(t));
  return t;
}
__device__ __forceinline__ u32 pack2(float a, float b) {
  f2_t v = {a, b};
  bf2_t r = __builtin_convertvector(v, bf2_t);
  return *(u32*)&r;
}
__device__ __forceinline__ u16 f2bf(float a) { return (u16)(pack2(a, 0.f) & 0xffffu); }
__device__ __forceinline__ float bflo(u32 v) { return __uint_as_float(v << 16); }
__device__ __forceinline__ float bfhi(u32 v) { return __uint_as_float(v & 0xffff0000u); }
__device__ __forceinline__ float sigm(float x) { return 1.f / (1.f + __expf(-x)); }
__device__ __forceinline__ float dpp_xor1(float v) {
  return __int_as_float(__builtin_amdgcn_mov_dpp(__float_as_int(v), 0xB1, 0xF, 0xF, true));
}
__device__ __forceinline__ float dpp_xor2(float v) {
  return __int_as_float(__builtin_amdgcn_mov_dpp(__float_as_int(v), 0x4E, 0xF, 0xF, true));
}

template <bool AF32, int NI>
__device__ __forceinline__ void gemm_loop(const void* Aptr, long lda, const u16* Bt, long ldb, int K,
                                          f32x16 (&acc)[2][NI], float& ss, char* smem) {
  const int tid = tid_(), lane = tid & 63, w = tid >> 6;
  const int wm = w >> 1, wn = w & 1, lr = lane & 31, lh = lane >> 5;
  const int arow = tid >> 1, ahalf = tid & 1;
  const int brow = (NI == 2) ? (tid >> 2) : (tid >> 3), bq = (NI == 2) ? (tid & 3) : (tid & 7);
  const int nk = K >> 6;
  float4 raf[8];
  uint4 rab[4];
  uint4 rb[2];
  const float* Af = (const float*)Aptr + (long)arow * lda + 32 * ahalf;
  const u16* Ab = (const u16*)Aptr + (long)arow * lda + 32 * ahalf;
  const u16* Bp = Bt + (long)brow * ldb + 8 * NI * bq;
  char* a_dst = smem + arow * 144 + ahalf * 64;
  char* b_dst = smem + AS_BYTES + brow * 144 + bq * 16 * NI;
  const char* a_src = smem + (wm * 64 + lr) * 144 + lh * 16;
  const char* b_src = smem + AS_BYTES + (wn * 32 * NI + lr) * 144 + lh * 16;

#define G_LOAD(kt)                                                                       \
  {                                                                                      \
    if (AF32) {                                                                          \
      _Pragma("unroll") for (int i = 0; i < 8; ++i) raf[i] = *(const float4*)(Af + (kt) * 64 + 4 * i); \
    } else {                                                                             \
      _Pragma("unroll") for (int i = 0; i < 4; ++i) rab[i] = *(const uint4*)(Ab + (kt) * 64 + 8 * i); \
    }                                                                                    \
    rb[0] = *(const uint4*)(Bp + (kt) * 64);                                             \
    if (NI == 2) rb[1] = *(const uint4*)(Bp + (kt) * 64 + 8);                            \
  }
#define G_STORE(buf)                                                                     \
  {                                                                                      \
    char* ad = a_dst + (buf) * (AS_BYTES + BS_BYTES);                                    \
    char* bd = b_dst + (buf) * (AS_BYTES + BS_BYTES);                                    \
    if (AF32) {                                                                          \
      _Pragma("unroll") for (int i = 0; i < 4; ++i) {                                    \
        float4 x0 = raf[2 * i], x1 = raf[2 * i + 1];                                     \
        ss += x0.x * x0.x + x0.y * x0.y + x0.z * x0.z + x0.w * x0.w;                     \
        ss += x1.x * x1.x + x1.y * x1.y + x1.z * x1.z + x1.w * x1.w;                     \
        uint4 o;                                                                         \
        o.x = pack2(x0.x, x0.y); o.y = pack2(x0.z, x0.w);                                \
        o.z = pack2(x1.x, x1.y); o.w = pack2(x1.z, x1.w);                                \
        *(uint4*)(ad + 16 * i) = o;                                                      \
      }                                                                                  \
    } else {                                                                             \
      _Pragma("unroll") for (int i = 0; i < 4; ++i) *(uint4*)(ad + 16 * i) = rab[i];     \
    }                                                                                    \
    *(uint4*)(bd) = rb[0];                                                               \
    if (NI == 2) *(uint4*)(bd + 16) = rb[1];                                             \
  }

  G_LOAD(0);
  G_STORE(0);
  __syncthreads();
  for (int kt = 0; kt < nk; ++kt) {
    const int buf = kt & 1;
    if (kt + 1 < nk) G_LOAD(kt + 1);
    const char* as = a_src + buf * (AS_BYTES + BS_BYTES);
    const char* bs = b_src + buf * (AS_BYTES + BS_BYTES);
#pragma unroll
    for (int kk = 0; kk < 4; ++kk) {
      bf16x8 a0 = *(const bf16x8*)(as + kk * 32);
      bf16x8 a1 = *(const bf16x8*)(as + 32 * 144 + kk * 32);
      bf16x8 b0 = *(const bf16x8*)(bs + kk * 32);
      acc[0][0] = __builtin_amdgcn_mfma_f32_32x32x16_bf16(a0, b0, acc[0][0], 0, 0, 0);
      acc[1][0] = __builtin_amdgcn_mfma_f32_32x32x16_bf16(a1, b0, acc[1][0], 0, 0, 0);
      if (NI == 2) {
        bf16x8 b1 = *(const bf16x8*)(bs + 32 * 144 + kk * 32);
        acc[0][NI - 1] = __builtin_amdgcn_mfma_f32_32x32x16_bf16(a0, b1, acc[0][NI - 1], 0, 0, 0);
        acc[1][NI - 1] = __builtin_amdgcn_mfma_f32_32x32x16_bf16(a1, b1, acc[1][NI - 1], 0, 0, 0);
      }
    }
    if (kt + 1 < nk) G_STORE(buf ^ 1);
    __syncthreads();
  }
#undef G_LOAD
#undef G_STORE
}

template <int NI>
__device__ __forceinline__ void zero_acc(f32x16 (&acc)[2][NI]) {
#pragma unroll
  for (int i = 0; i < 2; ++i)
#pragma unroll
    for (int j = 0; j < NI; ++j)
#pragma unroll
      for (int r = 0; r < 16; ++r) acc[i][j][r] = 0.f;
}

__device__ __forceinline__ void publish_rstd(float ss, char* smem) {
  float tot = ss + __shfl_xor(ss, 1);
  float* rs = (float*)(smem + MISC_OFF);
  if ((tid_() & 1) == 0) rs[tid_() >> 1] = rsqrtf(tot * (1.f / 1024.f) + 1e-6f);
  __syncthreads();
}

__device__ __forceinline__ void decode_tile(int id, int NT, int& mt, int& nt) {
  int grp = id / (8 * NT);
  int loc = id - grp * 8 * NT;
  mt = grp * 8 + (loc & 7);
  nt = loc >> 3;
}

__device__ __forceinline__ const float* xin_row(const Params& p, long t) {
  return t < 32768 ? p.in[0] + t * 1024 : p.in[1] + (t - 32768) * 1024;
}

__device__ void conv_tile(const float* src, int N, int K, u16* dst, int rs, int off, int tile, char* smem,
                          const float* gain = nullptr) {
  const int tid = tid_();
  float* tl = (float*)smem;
  int ntn = N >> 6;
  int kt = tile / ntn, nt = tile - kt * ntn;
  int k0 = kt * 64, n0 = nt * 64;
  __syncthreads();
  {
    int ty = tid >> 6, tx = tid & 63;
#pragma unroll
    for (int i = 0; i < 8; ++i) {
      int k = ty + 8 * i;
      float gv = gain ? gain[k0 + k] : 1.f;
      tl[k * 65 + tx] = src[(long)(k0 + k) * N + n0 + tx] * gv;
    }
  }
  __syncthreads();
  {
    int n = tid >> 3, kq = tid & 7;
    float v[8];
#pragma unroll
    for (int j = 0; j < 8; ++j) v[j] = tl[(8 * kq + j) * 65 + n];
    int nn = n0 + n;
    long drow = (long)(nn >> 5) * rs + (nn & 31) + off;
    uint4 o;
    o.x = pack2(v[0], v[1]); o.y = pack2(v[2], v[3]); o.z = pack2(v[4], v[5]); o.w = pack2(v[6], v[7]);
    *(uint4*)(dst + drow * K + k0 + 8 * kq) = o;
  }
}

__device__ void conv_ffn(const Params& p, int layer, int which, char* smem) {
  const float* wg = p.in[which ? 34 : 3] + (long)layer * 1024 * 2816;
  const float* wu = p.in[which ? 35 : 4] + (long)layer * 1024 * 2816;
  const float* wd = p.in[which ? 36 : 5] + (long)layer * 1024 * 2816;
  u16* dgu = (u16*)(p.ws + OFF_F);
  u16* dd = (u16*)(p.ws + OFF_FD);
  for (int j = blockIdx.x; j < 2112; j += gridDim.x) {
    if (j < 704) conv_tile(wg, 2816, 1024, dgu, 64, 0, j, smem);
    else if (j < 1408) conv_tile(wu, 2816, 1024, dgu, 64, 32, j - 704, smem);
    else conv_tile(wd, 1024, 2816, dd, 32, 0, j - 1408, smem);
  }
}
__device__ void conv_mix(const Params& p, int layer, char* smem) {
  const float* win = p.in[7] + (long)layer * 1024 * 6272;
  const float* wglu = p.in[16] + (long)layer * 512 * 512;
  const float* wb = p.in[31] + (long)layer * 3 * 512 * 1024;
  const float* wout = p.in[32] + (long)layer * 1024 * 1024;
  for (int j = blockIdx.x; j < 2272; j += gridDim.x) {
    if (j < 1568) conv_tile(win, 6272, 1024, (u16*)(p.ws + OFF_WIN), 32, 0, j, smem, p.in[6] + layer * 1024);
    else if (j < 1632) conv_tile(wglu, 512, 512, (u16*)(p.ws + OFF_WGLU), 32, 0, j - 1568, smem);
    else if (j < 2016) {
      int jj = j - 1632, i = jj >> 7;
      conv_tile(wb + (long)i * 512 * 1024, 1024, 512, (u16*)(p.ws + OFF_WB) + (long)i * 1024 * 512, 32, 0, jj & 127, smem);
    } else conv_tile(wout, 1024, 1024, (u16*)(p.ws + OFF_WOUT), 32, 0, j - 2016, smem);
  }
}

__device__ void phase_norm(const Params& p, bool from_in, const float* gain) {
  const int lane = tid_() & 63, w = tid_() >> 6;
  u16* hn = (u16*)(p.ws + OFF_HN);
  for (long row = (long)blockIdx.x * 8 + w; row < NTOK; row += (long)gridDim.x * 8) {
    const float* src = from_in ? xin_row(p, row) : p.out + row * 1024;
    float4 v[4];
    float ss = 0.f;
#pragma unroll
    for (int i = 0; i < 4; ++i) {
      v[i] = *(const float4*)(src + 4 * (i * 64 + lane));
      ss += v[i].x * v[i].x + v[i].y * v[i].y + v[i].z * v[i].z + v[i].w * v[i].w;
    }
#pragma unroll
    for (int m = 32; m >= 1; m >>= 1) ss += __shfl_xor(ss, m);
    float rstd = rsqrtf(ss * (1.f / 1024.f) + 1e-6f);
#pragma unroll
    for (int i = 0; i < 4; ++i) {
      float4 g = *(const float4*)(gain + 4 * (i * 64 + lane));
      uint2 o;
      o.x = pack2(v[i].x * rstd * g.x, v[i].y * rstd * g.y);
      o.y = pack2(v[i].z * rstd * g.z, v[i].w * rstd * g.w);
      *(uint2*)(hn + row * 1024 + 4 * (i * 64 + lane)) = o;
    }
  }
}

__device__ void phase_ffn_a(const Params& p, char* smem) {
  const int lane = tid_() & 63, w = tid_() >> 6;
  const int wm = w >> 1, wn = w & 1, lr = lane & 31, lh = lane >> 5;
  const u16* hn = (const u16*)(p.ws + OFF_HN);
  const u16* wgu = (const u16*)(p.ws + OFF_F);
  u16* H = (u16*)(p.ws + OFF_H);
  const int NT = 44;
  for (int id = blockIdx.x; id < 256 * NT; id += gridDim.x) {
    int mt, nt;
    decode_tile(id, NT, mt, nt);
    f32x16 acc[2][2];
    zero_acc<2>(acc);
    float ss = 0.f;
    gemm_loop<false, 2>(hn + (long)mt * 256 * 1024, 1024, wgu + (long)nt * 128 * 1024, 1024, 1024, acc, ss, smem);
    int hc = ((nt * 128 + wn * 64) >> 1) + lr;
#pragma unroll
    for (int mi = 0; mi < 2; ++mi)
#pragma unroll
      for (int r = 0; r < 16; ++r) {
        long row = (long)mt * 256 + wm * 64 + mi * 32 + (r & 3) + 8 * (r >> 2) + 4 * lh;
        float g = acc[mi][0][r], u = acc[mi][1][r];
        H[row * 2816 + hc] = f2bf(g * sigm(g) * u);
      }
  }
}

__device__ void phase_ffn_b(const Params& p, bool from_in, char* smem) {
  const int lane = tid_() & 63, w = tid_() >> 6;
  const int wm = w >> 1, wn = w & 1, lr = lane & 31, lh = lane >> 5;
  const u16* H = (const u16*)(p.ws + OFF_H);
  const u16* wd = (const u16*)(p.ws + OFF_FD);
  const int NT = 8;
  for (int id = blockIdx.x; id < 256 * NT; id += gridDim.x) {
    int mt, nt;
    decode_tile(id, NT, mt, nt);
    f32x16 acc[2][2];
    zero_acc<2>(acc);
    float ss = 0.f;
    gemm_loop<false, 2>(H + (long)mt * 256 * 2816, 2816, wd + (long)nt * 128 * 2816, 2816, 2816, acc, ss, smem);
#pragma unroll
    for (int mi = 0; mi < 2; ++mi)
#pragma unroll
      for (int ni = 0; ni < 2; ++ni)
#pragma unroll
        for (int r = 0; r < 16; ++r) {
          long row = (long)mt * 256 + wm * 64 + mi * 32 + (r & 3) + 8 * (r >> 2) + 4 * lh;
          int col = nt * 128 + wn * 64 + ni * 32 + lr;
          const float* xi = from_in ? xin_row(p, row) : p.out + row * 1024;
          p.out[row * 1024 + col] = xi[col] + 0.5f * acc[mi][ni][r];
        }
  }
}

__device__ void phase_proj(const Params& p, char* smem) {
  const int lane = tid_() & 63, w = tid_() >> 6;
  const int wm = w >> 1, wn = w & 1, lr = lane & 31, lh = lane >> 5;
  const u16* win = (const u16*)(p.ws + OFF_WIN);
  u16* RA = (u16*)(p.ws + OFF_A);
  u16* RZ = (u16*)(p.ws + OFF_Z);
  const float* rs = (const float*)(smem + MISC_OFF);
  const int NT = 25;
  for (int id = blockIdx.x; id < 256 * NT; id += gridDim.x) {
    int mt, nt;
    decode_tile(id, NT, mt, nt);
    f32x16 acc[2][2];
    zero_acc<2>(acc);
    float ss = 0.f;
    gemm_loop<true, 2>(p.out + (long)mt * 256 * 1024, 1024, win + (long)nt * 128 * 1024, 1024, 1024, acc, ss, smem);
    publish_rstd(ss, smem);
#pragma unroll
    for (int mi = 0; mi < 2; ++mi)
#pragma unroll
      for (int ni = 0; ni < 2; ++ni)
#pragma unroll
        for (int r = 0; r < 16; ++r) {
          int lrow = wm * 64 + mi * 32 + (r & 3) + 8 * (r >> 2) + 4 * lh;
          long row = (long)mt * 256 + lrow;
          int col = nt * 128 + wn * 64 + ni * 32 + lr;
          u16 v = f2bf(acc[mi][ni][r] * rs[lrow]);
          if (nt < 10) RA[row * 1280 + col] = v;
          else RZ[row * 1920 + (col - 1280)] = v;
        }
  }
}

__device__ void phase_glu(const Params& p, char* smem) {
  const int lane = tid_() & 63, w = tid_() >> 6;
  const int wm = w >> 1, wn = w & 1, lr = lane & 31, lh = lane >> 5;
  const u16* RA = (const u16*)(p.ws + OFF_A);
  const u16* wg = (const u16*)(p.ws + OFF_WGLU);
  u16* YA = (u16*)(p.ws + OFF_YA);
  const int NT = 4;
  for (int id = blockIdx.x; id < 256 * NT; id += gridDim.x) {
    int mt, nt;
    decode_tile(id, NT, mt, nt);
    f32x16 acc[2][2];
    zero_acc<2>(acc);
    float ss = 0.f;
    gemm_loop<false, 2>(RA + (long)mt * 256 * 1280, 1280, wg + (long)nt * 128 * 512, 512, 512, acc, ss, smem);
#pragma unroll
    for (int mi = 0; mi < 2; ++mi)
#pragma unroll
      for (int ni = 0; ni < 2; ++ni)
#pragma unroll
        for (int r = 0; r < 16; ++r) {
          long row = (long)mt * 256 + wm * 64 + mi * 32 + (r & 3) + 8 * (r >> 2) + 4 * lh;
          int col = nt * 128 + wn * 64 + ni * 32 + lr;
          float y = bflo(RA[row * 1280 + col]);
          YA[row * 512 + col] = f2bf(y * sigm(acc[mi][ni][r]));
        }
  }
}

__device__ void phase_m(const Params& p, char* smem) {
  const int lane = tid_() & 63, w = tid_() >> 6;
  const int wm = w >> 1, wn = w & 1, lr = lane & 31, lh = lane >> 5;
  const u16* win = (const u16*)(p.ws + OFF_WIN);
  const u16* wb = (const u16*)(p.ws + OFF_WB);
  u16* Mo = (u16*)(p.ws + OFF_M);
  const float* rs = (const float*)(smem + MISC_OFF);
  const int NT = 16;
  for (int id = blockIdx.x; id < 256 * NT; id += gridDim.x) {
    int mt, nt;
    decode_tile(id, NT, mt, nt);
    f32x16 macc[2][1];
    zero_acc<1>(macc);
#pragma unroll 1
    for (int i = 0; i < 3; ++i) {
      f32x16 acc[2][1];
      zero_acc<1>(acc);
      float ss = 0.f;
      gemm_loop<true, 1>(p.out + (long)mt * 256 * 1024, 1024, win + (long)(3200 + 1024 * i + nt * 64) * 1024, 1024, 1024,
                         acc, ss, smem);
      if (i == 0) publish_rstd(ss, smem);
      u32 gp[2][8];
#pragma unroll
      for (int mi = 0; mi < 2; ++mi)
#pragma unroll
        for (int r = 0; r < 16; r += 2) {
          int lrow = wm * 64 + mi * 32 + (r & 3) + 8 * (r >> 2) + 4 * lh;
          float g0 = sigm(acc[mi][0][r] * rs[lrow]);
          float g1 = sigm(acc[mi][0][r + 1] * rs[lrow + 1]);
          gp[mi][r >> 1] = pack2(g0, g1);
        }
      zero_acc<1>(acc);
      const u16* ya;
      long lda;
      if (i == 0) { ya = (const u16*)(p.ws + OFF_YA) + (long)mt * 256 * 512; lda = 512; }
      else if (i == 1) { ya = (const u16*)(p.ws + OFF_A) + (long)mt * 256 * 1280 + 512; lda = 1280; }
      else { ya = (const u16*)(p.ws + OFF_Y) + (long)mt * 256 * 512; lda = 512; }
      gemm_loop<false, 1>(ya, lda, wb + (long)i * 1024 * 512 + (long)nt * 64 * 512, 512, 512, acc, ss, smem);
#pragma unroll
      for (int mi = 0; mi < 2; ++mi)
#pragma unroll
        for (int r = 0; r < 16; r += 2) {
          u32 g = gp[mi][r >> 1];
          macc[mi][0][r] += bflo(g) * acc[mi][0][r];
          macc[mi][0][r + 1] += bfhi(g) * acc[mi][0][r + 1];
        }
    }
#pragma unroll
    for (int mi = 0; mi < 2; ++mi)
#pragma unroll
      for (int r = 0; r < 16; ++r) {
        long row = (long)mt * 256 + wm * 64 + mi * 32 + (r & 3) + 8 * (r >> 2) + 4 * lh;
        int col = nt * 64 + wn * 32 + lr;
        Mo[row * 1024 + col] = f2bf(macc[mi][0][r]);
      }
  }
}

__device__ void phase_out(const Params& p, char* smem) {
  const int lane = tid_() & 63, w = tid_() >> 6;
  const int wm = w >> 1, wn = w & 1, lr = lane & 31, lh = lane >> 5;
  const u16* Mi = (const u16*)(p.ws + OFF_M);
  const u16* wo = (const u16*)(p.ws + OFF_WOUT);
  const int NT = 8;
  for (int id = blockIdx.x; id < 256 * NT; id += gridDim.x) {
    int mt, nt;
    decode_tile(id, NT, mt, nt);
    f32x16 acc[2][2];
    zero_acc<2>(acc);
    float ss = 0.f;
    gemm_loop<false, 2>(Mi + (long)mt * 256 * 1024, 1024, wo + (long)nt * 128 * 1024, 1024, 1024, acc, ss, smem);
#pragma unroll
    for (int mi = 0; mi < 2; ++mi)
#pragma unroll
      for (int ni = 0; ni < 2; ++ni)
#pragma unroll
        for (int r = 0; r < 16; ++r) {
          long row = (long)mt * 256 + wm * 64 + mi * 32 + (r & 3) + 8 * (r >> 2) + 4 * lh;
          int col = nt * 128 + wn * 64 + ni * 32 + lr;
          p.out[row * 1024 + col] += acc[mi][ni][r];
        }
  }
}

#define KS_PITCH 144
#define VT_PITCH 784
__device__ void attn_item(const Params& p, int layer, int item, char* smem) {
  const int tid = tid_(), lane = tid & 63, w = tid >> 6;
  const int lr = lane & 31, lh = lane >> 5;
  const int qb = item >> 1, kvh = item & 1;
  const long t0 = (long)qb * 128;
  int L, pos0;
  if (t0 < 32768) { L = 2048; pos0 = (int)(t0 & 2047); } else { L = 4096; pos0 = (int)((t0 - 32768) & 4095); }
  u16* RA = (u16*)(p.ws + OFF_A);
  char* Ks = smem;
  char* Vt = smem + 384 * KS_PITCH;
  float* gq = (float*)(smem + MISC_OFF);
  float* gk = gq + 64;
  __syncthreads();
  if (tid < 64) gq[tid] = p.in[17][layer * 64 + tid];
  else if (tid < 128) gk[tid - 64] = p.in[18][layer * 64 + tid - 64];
  __syncthreads();
  {
    const int q4 = tid & 3;
    for (int pass = 0; pass < 3; ++pass) {
      int r = pass * 128 + (tid >> 2);
      int kpos = pos0 - 128 + r;
      bool valid = (kpos >= 0) && (kpos < L);
      float kv[16], vv[16];
      if (valid) {
        const u16* kp = RA + (t0 - 128 + r) * 1280 + 1024 + kvh * 64 + 16 * q4;
        uint4 a = *(const uint4*)kp, b = *(const uint4*)(kp + 8);
        uint4 c = *(const uint4*)(kp + 128), d = *(const uint4*)(kp + 136);
        u32 ka[8] = {a.x, a.y, a.z, a.w, b.x, b.y, b.z, b.w};
        u32 va[8] = {c.x, c.y, c.z, c.w, d.x, d.y, d.z, d.w};
#pragma unroll
        for (int i = 0; i < 8; ++i) {
          kv[2 * i] = bflo(ka[i]); kv[2 * i + 1] = bfhi(ka[i]);
          vv[2 * i] = bflo(va[i]); vv[2 * i + 1] = bfhi(va[i]);
        }
      } else {
#pragma unroll
        for (int i = 0; i < 16; ++i) { kv[i] = 0.f; vv[i] = 0.f; }
      }
      float ss = 0.f;
#pragma unroll
      for (int i = 0; i < 16; ++i) ss += kv[i] * kv[i];
      ss += __shfl_xor(ss, 1);
      ss += __shfl_xor(ss, 2);
      float rstd = rsqrtf(ss * (1.f / 64.f) + 1e-6f);
#pragma unroll
      for (int i = 0; i < 16; ++i) kv[i] = kv[i] * rstd * gk[16 * q4 + i];
      if (q4 == 0) {
#pragma unroll
        for (int i = 0; i < 8; ++i) {
          float invf = __expf(-1.6402954f * (float)i);
          float rev = (float)kpos * invf * 0.15915494f;
          rev -= floorf(rev);
          float cs = __builtin_amdgcn_cosf(rev), sn = __builtin_amdgcn_sinf(rev);
          float t1 = kv[i], t2 = kv[8 + i];
          kv[i] = t1 * cs - t2 * sn;
          kv[8 + i] = t2 * cs + t1 * sn;
        }
      }
      uint4 o0, o1;
      o0.x = pack2(kv[0], kv[1]); o0.y = pack2(kv[2], kv[3]); o0.z = pack2(kv[4], kv[5]); o0.w = pack2(kv[6], kv[7]);
      o1.x = pack2(kv[8], kv[9]); o1.y = pack2(kv[10], kv[11]); o1.z = pack2(kv[12], kv[13]); o1.w = pack2(kv[14], kv[15]);
      *(uint4*)(Ks + r * KS_PITCH + q4 * 32) = o0;
      *(uint4*)(Ks + r * KS_PITCH + q4 * 32 + 16) = o1;
#pragma unroll
      for (int i = 0; i < 16; ++i) *(u16*)(Vt + (16 * q4 + i) * VT_PITCH + r * 2) = f2bf(vv[i]);
    }
  }
  __syncthreads();
  float gqm = 0.f, gkm = 0.f;
  for (int i = 0; i < 64; ++i) { gqm = fmaxf(gqm, fabsf(gq[i])); gkm = fmaxf(gkm, fabsf(gk[i])); }
  const float mb = 8.f * gqm * gkm;
  for (int uu = 0; uu < 2; ++uu) {
    const int u = 2 * w + uu;
    const int hl = u >> 2, qt = u & 3;
    const int head = kvh * 4 + hl;
    const long tq = t0 + 32 * qt + lr;
    const int qpos = pos0 + 32 * qt + lr;
    u16* qrow = RA + tq * 1280 + 512 + head * 64;
    bf16x8 qf[4];
    {
      uint4 qraw[8];
      float ss = 0.f;
#pragma unroll
      for (int i = 0; i < 8; ++i) {
        uint4 a = *(const uint4*)(qrow + 8 * i);
        qraw[i] = a;
        float f0 = bflo(a.x), f1 = bfhi(a.x), f2 = bflo(a.y), f3 = bfhi(a.y);
        float f4 = bflo(a.z), f5 = bfhi(a.z), f6 = bflo(a.w), f7 = bfhi(a.w);
        ss += f0 * f0 + f1 * f1 + f2 * f2 + f3 * f3 + f4 * f4 + f5 * f5 + f6 * f6 + f7 * f7;
      }
      const float rstd = rsqrtf(ss * (1.f / 64.f) + 1e-6f) * 0.125f;
      {
        uint4 lo = qraw[0], hi = qraw[1];
        float t1[8] = {bflo(lo.x), bfhi(lo.x), bflo(lo.y), bfhi(lo.y), bflo(lo.z), bfhi(lo.z), bflo(lo.w), bfhi(lo.w)};
        float t2[8] = {bflo(hi.x), bfhi(hi.x), bflo(hi.y), bfhi(hi.y), bflo(hi.z), bfhi(hi.z), bflo(hi.w), bfhi(hi.w)};
        float f[8];
#pragma unroll
        for (int i = 0; i < 8; ++i) {
          float invf = __expf(-1.6402954f * (float)i);
          float rev = (float)qpos * invf * 0.15915494f;
          rev -= floorf(rev);
          float cs = __builtin_amdgcn_cosf(rev), sn = __builtin_amdgcn_sinf(rev);
          float x1 = t1[i] * rstd * gq[i], x2 = t2[i] * rstd * gq[8 + i];
          float a = lh ? x2 : x1;
          float b = lh ? x1 : -x2;
          f[i] = a * cs + b * sn;
        }
        u32 pk[4] = {pack2(f[0], f[1]), pack2(f[2], f[3]), pack2(f[4], f[5]), pack2(f[6], f[7])};
        qf[0] = *(bf16x8*)pk;
      }
#pragma unroll
      for (int s = 1; s < 4; ++s) {
        uint4 lo = qraw[2 * s], hi = qraw[2 * s + 1];
        uint4 sel;
        sel.x = lh ? hi.x : lo.x; sel.y = lh ? hi.y : lo.y; sel.z = lh ? hi.z : lo.z; sel.w = lh ? hi.w : lo.w;
        const float* gp = gq + 16 * s + 8 * lh;
        float f[8] = {bflo(sel.x), bfhi(sel.x), bflo(sel.y), bfhi(sel.y), bflo(sel.z), bfhi(sel.z), bflo(sel.w), bfhi(sel.w)};
#pragma unroll
        for (int i = 0; i < 8; ++i) f[i] = f[i] * rstd * gp[i];
        u32 pk2[4] = {pack2(f[0], f[1]), pack2(f[2], f[3]), pack2(f[4], f[5]), pack2(f[6], f[7])};
        qf[s] = *(bf16x8*)pk2;
      }
    }
    f32x16 o0, o1;
#pragma unroll
    for (int r = 0; r < 16; ++r) { o0[r] = 0.f; o1[r] = 0.f; }
    float lsum = 0.f;
    for (int kt = qt; kt < qt + 9; ++kt) {
      f32x16 s;
#pragma unroll
      for (int r = 0; r < 16; ++r) s[r] = 0.f;
      const char* kb = Ks + (kt * 32 + lr) * KS_PITCH + lh * 16;
#pragma unroll
      for (int ks = 0; ks < 4; ++ks) {
        bf16x8 kf = *(const bf16x8*)(kb + ks * 32);
        s = __builtin_amdgcn_mfma_f32_32x32x16_bf16(kf, qf[ks], s, 0, 0, 0);
      }
      float pv[16];
#pragma unroll
      for (int r = 0; r < 16; ++r) {
        int kw = kt * 32 + (r & 3) + 8 * (r >> 2) + 4 * lh;
        int kpos = pos0 - 128 + kw;
        int dlt = kpos - qpos;
        bool ok = (dlt <= 128) && (dlt >= -128) && (kpos >= 0) && (kpos < L);
        float e = ok ? __expf(s[r] - mb) : 0.f;
        pv[r] = e;
        lsum += e;
      }
#pragma unroll
      for (int sk = 0; sk < 2; ++sk) {
        u32 pk[4] = {pack2(pv[8 * sk + 0], pv[8 * sk + 1]), pack2(pv[8 * sk + 2], pv[8 * sk + 3]),
                     pack2(pv[8 * sk + 4], pv[8 * sk + 5]), pack2(pv[8 * sk + 6], pv[8 * sk + 7])};
        bf16x8 pf = *(bf16x8*)pk;
        const char* vb = Vt + lr * VT_PITCH + (kt * 32 + 16 * sk + 4 * lh) * 2;
        uint2 va = *(const uint2*)(vb), vb2 = *(const uint2*)(vb + 16);
        u32 vk[4] = {va.x, va.y, vb2.x, vb2.y};
        bf16x8 vf0 = *(bf16x8*)vk;
        uint2 vc = *(const uint2*)(vb + 32 * VT_PITCH), vd = *(const uint2*)(vb + 32 * VT_PITCH + 16);
        u32 vk1[4] = {vc.x, vc.y, vd.x, vd.y};
        bf16x8 vf1 = *(bf16x8*)vk1;
        o0 = __builtin_amdgcn_mfma_f32_32x32x16_bf16(vf0, pf, o0, 0, 0, 0);
        o1 = __builtin_amdgcn_mfma_f32_32x32x16_bf16(vf1, pf, o1, 0, 0, 0);
      }
    }
    lsum += __shfl_xor(lsum, 32);
    lsum += __expf(p.in[19][layer * 8 + head] - mb);
    float inv = 1.f / lsum;
#pragma unroll
    for (int g = 0; g < 4; ++g) {
      uint2 a, b;
      a.x = pack2(o0[4 * g] * inv, o0[4 * g + 1] * inv); a.y = pack2(o0[4 * g + 2] * inv, o0[4 * g + 3] * inv);
      b.x = pack2(o1[4 * g] * inv, o1[4 * g + 1] * inv); b.y = pack2(o1[4 * g + 2] * inv, o1[4 * g + 3] * inv);
      *(uint2*)(qrow + 8 * g + 4 * lh) = a;
      *(uint2*)(qrow + 32 + 8 * g + 4 * lh) = b;
    }
  }
}

template <bool PASS2>
__device__ void s5_unit(const Params& p, int layer, int unit, char* wsm) {
  const int lane = tid_() & 63;
  const int c = unit >> 5, g = unit & 31;
  const long t0 = (long)c * 128;
  float* U = (float*)wsm;
  char* ST = wsm + 8192;
  u16* RA = (u16*)(p.ws + OFF_A);
  float* CAR = (float*)(p.ws + OFF_CAR);
  __builtin_amdgcn_wave_barrier();
#pragma unroll
  for (int i = 0; i < 2; ++i) {
    int tau = lane + 64 * i;
    const u16* src = RA + (t0 + tau) * 1280 + 16 * g;
    uint4 a = *(const uint4*)src, b = *(const uint4*)(src + 8);
    float4 f0 = {bflo(a.x), bfhi(a.x), bflo(a.y), bfhi(a.y)};
    float4 f1 = {bflo(a.z), bfhi(a.z), bflo(a.w), bfhi(a.w)};
    float4 f2 = {bflo(b.x), bfhi(b.x), bflo(b.y), bfhi(b.y)};
    float4 f3 = {bflo(b.z), bfhi(b.z), bflo(b.w), bfhi(b.w)};
    float4* d = (float4*)(U + tau * 16);
    d[0] = f0; d[1] = f1; d[2] = f2; d[3] = f3;
  }
  __builtin_amdgcn_wave_barrier();
  f32x4 acc[8];
#pragma unroll
  for (int i = 0; i < 8; ++i) acc[i] = (f32x4){0.f, 0.f, 0.f, 0.f};
  int clo, chi;
  if (c < 256) { clo = c & ~15; chi = clo + 16; } else { clo = c & ~31; chi = clo + 32; }

#pragma unroll
  for (int d = 0; d < 2; ++d) {
    const long pg = ((long)(layer * 2 + d) * 32 + g);
    float lre = fminf(p.in[8][pg * 64 + lane], -1e-4f);
    float lim = p.in[9][pg * 64 + lane];
    float dt = expf(p.in[10][pg]);
    float er = expf(lre * dt);
    float ang = lim * dt;
    float nrev = rintf(ang * 0.15915494f);
    float rr = fmaf(-nrev, 6.28125f, ang);
    rr = fmaf(-nrev, 1.9353071795864769e-3f, rr);
    float ar = er * cosf(rr), ai = er * sinf(rr);
    float den = 1.f / (lre * lre + lim * lim);
    float nr = ar - 1.f;
    float c0r = (nr * lre + ai * lim) * den, c0i = (ai * lre - nr * lim) * den;
    float Br[16], Bi[16];
    {
      const float4* br = (const float4*)(p.in[11] + (pg * 64 + lane) * 16);
      const float4* bi = (const float4*)(p.in[12] + (pg * 64 + lane) * 16);
#pragma unroll
      for (int i = 0; i < 4; ++i) {
        float4 x = br[i], y = bi[i];
        Br[4 * i + 0] = c0r * x.x - c0i * y.x; Bi[4 * i + 0] = c0r * y.x + c0i * x.x;
        Br[4 * i + 1] = c0r * x.y - c0i * y.y; Bi[4 * i + 1] = c0r * y.y + c0i * x.y;
        Br[4 * i + 2] = c0r * x.z - c0i * y.z; Bi[4 * i + 2] = c0r * y.z + c0i * x.z;
        Br[4 * i + 3] = c0r * x.w - c0i * y.w; Bi[4 * i + 3] = c0r * y.w + c0i * x.w;
      }
    }
    float sr = 0.f, si = 0.f;
    bf16x8 cf[4];
    if (PASS2) {
      float pr = ar, pi = ai;
#pragma unroll
      for (int i = 0; i < 7; ++i) { float t = pr * pr - pi * pi; pi = 2.f * pr * pi; pr = t; }
      if (d == 0) {
        for (int cc = clo; cc < c; ++cc) {
          float2 e = *(const float2*)(CAR + (((long)cc * 32 + g) * 2 + 0) * 128 + 2 * lane);
          float t = pr * sr - pi * si + e.x; si = pr * si + pi * sr + e.y; sr = t;
        }
      } else {
        for (int cc = chi - 1; cc > c; --cc) {
          float2 e = *(const float2*)(CAR + (((long)cc * 32 + g) * 2 + 1) * 128 + 2 * lane);
          float t = pr * sr - pi * si + e.x; si = pr * si + pi * sr + e.y; sr = t;
        }
      }
      const int h = lane & 15, q = lane >> 4;
      const float* cre = p.in[13] + (pg * 16 + h) * 64;
      const float* cim = p.in[14] + (pg * 16 + h) * 64;
#pragma unroll
      for (int ks = 0; ks < 4; ++ks) {
        float4 x = *(const float4*)(cre + 16 * ks + 4 * q);
        float4 y = *(const float4*)(cim + 16 * ks + 4 * q);
        u32 pk[4] = {pack2(x.x, -y.x), pack2(x.y, -y.y), pack2(x.z, -y.z), pack2(x.w, -y.w)};
        cf[ks] = *(bf16x8*)pk;
      }
    }
#pragma unroll
    for (int sbi = 0; sbi < 8; ++sbi) {
      const int sb = d ? 7 - sbi : sbi;
#pragma unroll 4
      for (int s = 0; s < 16; ++s) {
        const int tl = d ? 15 - s : s;
        const int tau = sb * 16 + tl;
        const float4* up = (const float4*)(U + tau * 16);
        float4 u0 = up[0], u1 = up[1], u2 = up[2], u3 = up[3];
        float uu[16] = {u0.x, u0.y, u0.z, u0.w, u1.x, u1.y, u1.z, u1.w, u2.x, u2.y, u2.z, u2.w, u3.x, u3.y, u3.z, u3.w};
        float bur = 0.f, bui = 0.f;
#pragma unroll
        for (int hh = 0; hh < 16; ++hh) { bur += Br[hh] * uu[hh]; bui += Bi[hh] * uu[hh]; }
        float t = ar * sr - ai * si + bur;
        si = ar * si + ai * sr + bui;
        sr = t;
        if (PASS2) *(u32*)(ST + tl * 272 + 4 * lane) = pack2(sr, si);
      }
      if (PASS2) {
        __builtin_amdgcn_wave_barrier();
        const char* ab = ST + (lane & 15) * 272 + (lane >> 4) * 16;
#pragma unroll
        for (int ks = 0; ks < 4; ++ks) {
          bf16x8 af = *(const bf16x8*)(ab + ks * 64);
          acc[sb] = __builtin_amdgcn_mfma_f32_16x16x32_bf16(af, cf[ks], acc[sb], 0, 0, 0);
        }
        __builtin_amdgcn_wave_barrier();
      }
    }
    if (!PASS2) {
      float2 e = {sr, si};
      *(float2*)(CAR + (((long)c * 32 + g) * 2 + d) * 128 + 2 * lane) = e;
    }
  }
  if (PASS2) {
    const int h = lane & 15, q = lane >> 4;
    const float dsk = p.in[15][(layer * 32 + g) * 16 + h];
#pragma unroll
    for (int sb = 0; sb < 8; ++sb)
#pragma unroll
      for (int r = 0; r < 4; ++r) {
        int tau = sb * 16 + 4 * q + r;
        float y = acc[sb][r] + dsk * U[tau * 16 + h];
        float t = tanhf(0.7978845608f * (y + 0.044715f * y * y * y));
        y = 0.5f * y * (1.f + t);
        RA[(t0 + tau) * 1280 + 16 * g + h] = f2bf(y);
      }
  }
}

#define RW_GRP 49664
__device__ void rwkv_pair(const Params& p, int layer, int pr, char* smem) {
  const int tid = tid_(), d = tid >> 8, gt = tid & 255, gw = gt >> 6, lane = tid & 63;
  int head, L;
  long tok0;
  if (pr < 64) { head = pr & 7; L = 4096; tok0 = 32768 + (long)(pr >> 3) * 4096; }
  else { int q = pr - 64; head = q & 7; L = 2048; tok0 = (long)(q >> 3) * 2048; }
  char* sm = smem + d * RW_GRP;
  float* R = (float*)sm;
  float* KP = R + 1024; float* V = KP + 1024; float* W = V + 1024; float* NKK = W + 1024; float* KKA = NKK + 1024;
  float* AA = KKA + 1024; float* G = AA + 1024; float* YO = G + 1024;
  char* TW = sm + 36864; char* AL = TW + 2304; char* SG = AL + 2304;
  float* BON = (float*)(SG + 4352);
  float* MU = BON + 16;
  const u16* RZ = (const u16*)(p.ws + OFF_Z);
  u16* RY = (u16*)(p.ws + OFF_Y);
  const float* mu = p.in[20] + (long)layer * 2 * 1920;
  const float* w0 = p.in[21] + (long)(layer * 2 + d) * 512;
  const float* w2 = p.in[22] + (long)(layer * 2 + d) * 64 * 512;
  const float* a0 = p.in[23] + (long)(layer * 2 + d) * 512;
  const float* a2 = p.in[24] + (long)(layer * 2 + d) * 64 * 512;
  const float* g2 = p.in[25] + (long)layer * 128 * 512;
  __syncthreads();
  for (int idx = gt; idx < 896; idx += 256) {
    int m = idx / 448, rem = idx - m * 448, v = rem >> 6, cc = rem & 63;
    int zb = (v == 0) ? 64 * head : (v == 1) ? 512 + 64 * head : (v == 2) ? 1024 + 64 * head
           : (v == 3) ? 1536 + 64 * d : (v == 4) ? 1664 + 64 * d : (v == 5) ? 1792 : 1856;
    MU[idx] = mu[m * 1920 + zb + cc];
  }
  const int tau_a = gt >> 4, c4 = gt & 15;
  float kkc[4], kac[4], rkc[4], lnw[4], lnb[4];
#pragma unroll
  for (int e = 0; e < 4; ++e) {
    int cc = 64 * head + 4 * c4 + e;
    kkc[e] = p.in[26][layer * 512 + cc];
    kac[e] = p.in[27][layer * 512 + cc];
    rkc[e] = p.in[28][layer * 512 + cc];
    lnw[e] = p.in[29][layer * 512 + cc];
    lnb[e] = p.in[30][layer * 512 + cc];
  }
  const int c16 = lane & 15, q4 = lane >> 4;
  const int colb = 64 * head + 16 * gw + c16;
  bf16x8 w2f[2], a2f[2], g2f[4];
#pragma unroll
  for (int s = 0; s < 4; ++s) {
    float fw[8], fa[8], fg[8];
#pragma unroll
    for (int j = 0; j < 8; ++j) {
      int m = 32 * s + 8 * q4 + j;
      fg[j] = g2[(long)m * 512 + colb];
      if (s < 2) { fw[j] = w2[(long)m * 512 + colb]; fa[j] = a2[(long)m * 512 + colb]; }
    }
    u32 pg[4] = {pack2(fg[0], fg[1]), pack2(fg[2], fg[3]), pack2(fg[4], fg[5]), pack2(fg[6], fg[7])};
    g2f[s] = *(bf16x8*)pg;
    if (s < 2) {
      u32 pw[4] = {pack2(fw[0], fw[1]), pack2(fw[2], fw[3]), pack2(fw[4], fw[5]), pack2(fw[6], fw[7])};
      u32 pa[4] = {pack2(fa[0], fa[1]), pack2(fa[2], fa[3]), pack2(fa[4], fa[5]), pack2(fa[6], fa[7])};
      w2f[s] = *(bf16x8*)pw;
      a2f[s] = *(bf16x8*)pa;
    }
  }
  const float w0c = w0[colb], a0c = a0[colb];
  float S[16];
#pragma unroll
  for (int j = 0; j < 16; ++j) S[j] = 0.f;
  const int irow = 16 * gw + (lane >> 2), jq = lane & 3;
  const int NC = L >> 4;
  __syncthreads();

  for (int ci = 0; ci < NC; ++ci) {
    const int chunk = d ? NC - 1 - ci : ci;
    const long tb = tok0 + (long)chunk * 16;
    {
      const long t = tb + tau_a;
      const int pos = chunk * 16 + tau_a;
      const bool hp = pos > 0, hn = pos < L - 1;
#pragma unroll
      for (int v = 0; v < 7; ++v) {
        int zb = (v == 0) ? 64 * head : (v == 1) ? 512 + 64 * head : (v == 2) ? 1024 + 64 * head
               : (v == 3) ? 1536 + 64 * d : (v == 4) ? 1664 + 64 * d : (v == 5) ? 1792 : 1856;
        const u16* zp = RZ + t * 1920 + zb + 4 * c4;
        uint2 zc = *(const uint2*)zp;
        uint2 zpv = hp ? *(const uint2*)(zp - 1920) : make_uint2(0u, 0u);
        uint2 znv = hn ? *(const uint2*)(zp + 1920) : make_uint2(0u, 0u);
        float4 m0 = *(const float4*)(MU + v * 64 + 4 * c4);
        float4 m1 = *(const float4*)(MU + 448 + v * 64 + 4 * c4);
        float zc4[4] = {bflo(zc.x), bfhi(zc.x), bflo(zc.y), bfhi(zc.y)};
        float zp4[4] = {bflo(zpv.x), bfhi(zpv.x), bflo(zpv.y), bfhi(zpv.y)};
        float zn4[4] = {bflo(znv.x), bfhi(znv.x), bflo(znv.y), bfhi(znv.y)};
        float mm0[4] = {m0.x, m0.y, m0.z, m0.w}, mm1[4] = {m1.x, m1.y, m1.z, m1.w};
        float o[4];
#pragma unroll
        for (int e = 0; e < 4; ++e) o[e] = zc4[e] + mm0[e] * (zp4[e] - zc4[e]) + mm1[e] * (zn4[e] - zc4[e]);
        if (v == 0) *(float4*)(R + tau_a * 64 + 4 * c4) = make_float4(o[0], o[1], o[2], o[3]);
        else if (v == 1) *(float4*)(KP + tau_a * 64 + 4 * c4) = make_float4(o[0], o[1], o[2], o[3]);
        else if (v == 2) *(float4*)(V + tau_a * 64 + 4 * c4) = make_float4(o[0], o[1], o[2], o[3]);
        else if (v == 3) {
          float th[4];
#pragma unroll
          for (int e = 0; e < 4; ++e) th[e] = 1.f - 2.f / (1.f + __expf(2.f * o[e]));
          *(uint2*)(TW + tau_a * 144 + 8 * c4) = make_uint2(pack2(th[0], th[1]), pack2(th[2], th[3]));
        } else if (v == 4) {
          *(uint2*)(AL + tau_a * 144 + 8 * c4) = make_uint2(pack2(o[0], o[1]), pack2(o[2], o[3]));
        } else {
          *(uint2*)(SG + tau_a * 272 + (v - 5) * 128 + 8 * c4) =
              make_uint2(pack2(sigm(o[0]), sigm(o[1])), pack2(sigm(o[2]), sigm(o[3])));
        }
      }
    }
    __syncthreads();
    {
      f32x4 cw = {0.f, 0.f, 0.f, 0.f}, ca = cw, cgt = cw;
#pragma unroll
      for (int s = 0; s < 2; ++s) {
        bf16x8 tf = *(const bf16x8*)(TW + c16 * 144 + (32 * s + 8 * q4) * 2);
        bf16x8 af = *(const bf16x8*)(AL + c16 * 144 + (32 * s + 8 * q4) * 2);
        cw = __builtin_amdgcn_mfma_f32_16x16x32_bf16(tf, w2f[s], cw, 0, 0, 0);
        ca = __builtin_amdgcn_mfma_f32_16x16x32_bf16(af, a2f[s], ca, 0, 0, 0);
      }
#pragma unroll
      for (int s = 0; s < 4; ++s) {
        bf16x8 sf = *(const bf16x8*)(SG + c16 * 272 + (32 * s + 8 * q4) * 2);
        cgt = __builtin_amdgcn_mfma_f32_16x16x32_bf16(sf, g2f[s], cgt, 0, 0, 0);
      }
#pragma unroll
      for (int r = 0; r < 4; ++r) {
        int tau = 4 * q4 + r, cc = 16 * gw + c16;
        W[tau * 64 + cc] = __expf(-0.60653066f * sigm(cw[r] + w0c));
        AA[tau * 64 + cc] = sigm(ca[r] + a0c);
        G[tau * 64 + cc] = cgt[r];
      }
    }
    __syncthreads();
    {
      float4 k4 = *(const float4*)(KP + tau_a * 64 + 4 * c4);
      float4 a4 = *(const float4*)(AA + tau_a * 64 + 4 * c4);
      float4 r4 = *(const float4*)(R + tau_a * 64 + 4 * c4);
      float kk[4] = {k4.x * kkc[0], k4.y * kkc[1], k4.z * kkc[2], k4.w * kkc[3]};
      float kx[4] = {k4.x, k4.y, k4.z, k4.w}, ax[4] = {a4.x, a4.y, a4.z, a4.w}, rx[4] = {r4.x, r4.y, r4.z, r4.w};
      float ss = kk[0] * kk[0] + kk[1] * kk[1] + kk[2] * kk[2] + kk[3] * kk[3];
      float bn = rx[0] * kx[0] * rkc[0] + rx[1] * kx[1] * rkc[1] + rx[2] * kx[2] * rkc[2] + rx[3] * kx[3] * rkc[3];
#pragma unroll
      for (int m = 1; m <= 8; m <<= 1) { ss += __shfl_xor(ss, m); bn += __shfl_xor(bn, m); }
      float inv = 1.f / fmaxf(sqrtf(ss), 1e-12f);
      float nk[4], ka[4], kd[4];
#pragma unroll
      for (int e = 0; e < 4; ++e) {
        float k1 = kk[e] * inv;
        nk[e] = -k1;
        ka[e] = k1 * ax[e];
        kd[e] = kx[e] * (1.f + (ax[e] - 1.f) * kac[e]);
      }
      *(float4*)(NKK + tau_a * 64 + 4 * c4) = make_float4(nk[0], nk[1], nk[2], nk[3]);
      *(float4*)(KKA + tau_a * 64 + 4 * c4) = make_float4(ka[0], ka[1], ka[2], ka[3]);
      *(float4*)(KP + tau_a * 64 + 4 * c4) = make_float4(kd[0], kd[1], kd[2], kd[3]);
      if (c4 == 0) BON[tau_a] = bn;
    }
    __syncthreads();
    {
#pragma unroll 2
      for (int s = 0; s < 16; ++s) {
        const int tau = d ? 15 - s : s;
        const int o = tau * 64 + 16 * jq;
        float wv[16], nk[16], ka[16], kd[16], rv[16];
#pragma unroll
        for (int i = 0; i < 4; ++i) {
          float4 a = *(const float4*)(W + o + 4 * i);   wv[4 * i] = a.x; wv[4 * i + 1] = a.y; wv[4 * i + 2] = a.z; wv[4 * i + 3] = a.w;
          float4 b = *(const float4*)(NKK + o + 4 * i); nk[4 * i] = b.x; nk[4 * i + 1] = b.y; nk[4 * i + 2] = b.z; nk[4 * i + 3] = b.w;
          float4 c = *(const float4*)(KKA + o + 4 * i); ka[4 * i] = c.x; ka[4 * i + 1] = c.y; ka[4 * i + 2] = c.z; ka[4 * i + 3] = c.w;
          float4 e = *(const float4*)(KP + o + 4 * i);  kd[4 * i] = e.x; kd[4 * i + 1] = e.y; kd[4 * i + 2] = e.z; kd[4 * i + 3] = e.w;
          float4 f = *(const float4*)(R + o + 4 * i);   rv[4 * i] = f.x; rv[4 * i + 1] = f.y; rv[4 * i + 2] = f.z; rv[4 * i + 3] = f.w;
        }
        const float vi = V[tau * 64 + irow];
        float sa = 0.f;
#pragma unroll
        for (int j = 0; j < 16; ++j) sa += S[j] * nk[j];
        sa += dpp_xor1(sa);
        sa += dpp_xor2(sa);
        float y = 0.f;
#pragma unroll
        for (int j = 0; j < 16; ++j) {
          S[j] = S[j] * wv[j] + (sa * ka[j] + vi * kd[j]);
          y += S[j] * rv[j];
        }
        y += dpp_xor1(y);
        y += dpp_xor2(y);
        if (jq == 0) YO[tau * 64 + irow] = y;
      }
    }
    __syncthreads();
    {
      float4 y4 = *(const float4*)(YO + tau_a * 64 + 4 * c4);
      float yv[4] = {y4.x, y4.y, y4.z, y4.w};
      u16* yp = RY + (tb + tau_a) * 512 + 64 * head + 4 * c4;
      if (ci < (NC >> 1)) {
        *(uint2*)yp = make_uint2(pack2(yv[0], yv[1]), pack2(yv[2], yv[3]));
        __threadfence_block();
      } else {
        u64 st = __hip_atomic_load((u64*)yp, __ATOMIC_RELAXED, __HIP_MEMORY_SCOPE_AGENT);
        u32 s0 = (u32)st, s1 = (u32)(st >> 32);
        yv[0] += bflo(s0); yv[1] += bfhi(s0); yv[2] += bflo(s1); yv[3] += bfhi(s1);
        float sm1 = yv[0] + yv[1] + yv[2] + yv[3];
#pragma unroll
        for (int m = 1; m <= 8; m <<= 1) sm1 += __shfl_xor(sm1, m);
        float mean = sm1 * (1.f / 64.f);
        float vs = 0.f;
#pragma unroll
        for (int e = 0; e < 4; ++e) { float dd = yv[e] - mean; vs += dd * dd; }
#pragma unroll
        for (int m = 1; m <= 8; m <<= 1) vs += __shfl_xor(vs, m);
        float rstd = rsqrtf(vs * (1.f / 64.f) + 64e-5f);
        float4 v4 = *(const float4*)(V + tau_a * 64 + 4 * c4);
        float4 g4 = *(const float4*)(G + tau_a * 64 + 4 * c4);
        float vv[4] = {v4.x, v4.y, v4.z, v4.w}, gg[4] = {g4.x, g4.y, g4.z, g4.w};
        float bn = BON[tau_a];
        float o[4];
#pragma unroll
        for (int e = 0; e < 4; ++e) o[e] = ((yv[e] - mean) * rstd * lnw[e] + lnb[e] + bn * vv[e]) * gg[e];
        *(uint2*)yp = make_uint2(pack2(o[0], o[1]), pack2(o[2], o[3]));
      }
    }
    __syncthreads();
  }
}

#define N_ATT_ITEMS 1024
#define N_S5_ITEMS 2048
__device__ void phase_mixer1(const Params& p, int layer, char* smem) {
#ifndef NO_RW
  for (int pr = blockIdx.x; pr < 192; pr += gridDim.x) rwkv_pair(p, layer, pr, smem);
#endif
  int* ctr = (int*)(p.ws + OFF_CTR) + layer;
  int* sitem = (int*)(smem + MISC_OFF + 2048);
  const int w = tid_() >> 6;
  while (true) {
    __syncthreads();
    if (tid_() == 0) *sitem = atomicAdd(ctr, 1);
    __syncthreads();
    int it = *sitem;
    if (it >= N_ATT_ITEMS + N_S5_ITEMS) break;
    if (it < N_ATT_ITEMS) {
#ifndef NO_ATT
      attn_item(p, layer, it, smem);
#endif
    } else {
#ifndef NO_S5
      s5_unit<false>(p, layer, (it - N_ATT_ITEMS) * 8 + w, smem + w * 12544);
#endif
    }
  }
}

__device__ void phase_s5p2(const Params& p, int layer, char* smem) {
  const int w = tid_() >> 6;
  for (int it = blockIdx.x; it < N_S5_ITEMS; it += gridDim.x) s5_unit<true>(p, layer, it * 8 + w, smem + w * 12544);
}

__global__ void __launch_bounds__(NTHREADS) mega(Params p, int ph_lo, int ph_hi) {
  extern __shared__ __attribute__((aligned(16))) char smem[];
  cg::grid_group grid = cg::this_grid();
  for (int ph = ph_lo; ph < ph_hi; ++ph) {
    const int layer = ph / 12, sp = ph - layer * 12;
#ifndef ONLY_PH
#define PH_ON(x) 1
#else
#define PH_ON(x) ((x) == ONLY_PH)
#endif
    switch (sp) {
      case 0:
        if (!PH_ON(0)) break;
        if (blockIdx.x == 0 && tid_() == 0) ((int*)(p.ws + OFF_CTR))[layer] = 0;
        phase_norm(p, layer == 0, p.in[2] + layer * 1024);
        conv_ffn(p, layer, 0, smem);
        break;
      case 1: if (PH_ON(1)) phase_ffn_a(p, smem); break;
      case 2:
        if (!PH_ON(2)) break;
        phase_ffn_b(p, layer == 0, smem);
        conv_mix(p, layer, smem);
        break;
      case 3: if (PH_ON(3)) phase_proj(p, smem); break;
      case 4: if (PH_ON(4)) phase_mixer1(p, layer, smem); break;
      case 5: if (PH_ON(5)) phase_s5p2(p, layer, smem); break;
      case 6: if (PH_ON(6)) phase_glu(p, smem); break;
      case 7: if (PH_ON(7)) phase_m(p, smem); break;
      case 8:
        if (!PH_ON(8)) break;
        phase_out(p, smem);
        conv_ffn(p, layer, 1, smem);
        break;
      case 9: if (PH_ON(9)) phase_norm(p, false, p.in[33] + layer * 1024); break;
      case 10: if (PH_ON(10)) phase_ffn_a(p, smem); break;
      case 11: if (PH_ON(11)) phase_ffn_b(p, false, smem); break;
    }
    if (ph + 1 < ph_hi) grid.sync();
  }
}

extern "C" void kernel_launch(void* const* d_in, const int* in_sizes, int n_in, void* d_out, int out_size, void* d_ws,
                              size_t ws_size, hipStream_t stream) {
  static int grid_blocks = 0;
  if (!grid_blocks) {
    int dev = 0, cus = 0, per_cu = 0;
    hipGetDevice(&dev);
    hipDeviceGetAttribute(&cus, hipDeviceAttributeMultiprocessorCount, dev);
    hipFuncSetAttribute((const void*)mega, hipFuncAttributeMaxDynamicSharedMemorySize, SMEM_BYTES);
    hipOccupancyMaxActiveBlocksPerMultiprocessor(&per_cu, mega, NTHREADS, SMEM_BYTES);
    if (per_cu < 1) per_cu = 1;
    grid_blocks = cus * per_cu;
  }
  if (ws_size < (size_t)WS_NEED) {
    fprintf(stderr, "workspace too small: %zu\n", ws_size);
    return;
  }
  Params p{};
  for (int i = 0; i < 37; ++i) p.in[i] = (const float*)d_in[i];
  p.out = (float*)d_out;
  p.ws = (char*)d_ws;
#ifndef ONE_LAUNCH
  for (int ph = 0; ph < 24; ++ph) {
    hipLaunchKernelGGL(mega, dim3(grid_blocks), dim3(NTHREADS), SMEM_BYTES, stream, p, ph, ph + 1);
  }
#else
  int lo = 0, hi = 24;
  void* args[] = {&p, &lo, &hi};
  hipError_t e = hipLaunchCooperativeKernel((const void*)mega, dim3(grid_blocks), dim3(NTHREADS), args, SMEM_BYTES, stream);
  if (e != hipSuccess) fprintf(stderr, "cooperative launch failed: %s (grid %d)\n", hipGetErrorString(e), grid_blocks);
#endif
}
```

```cpp
#include <hip/hip_runtime.h>
#include <hip/hip_cooperative_groups.h>
#include <cstdio>
namespace cg = cooperative_groups;

typedef unsigned short u16;
typedef unsigned int u32;
typedef unsigned long long u64;
typedef __attribute__((ext_vector_type(8))) short bf16x8;
typedef __attribute__((ext_vector_type(16))) float f32x16;
typedef __attribute__((ext_vector_type(4))) float f32x4;
typedef __bf16 bf2_t __attribute__((ext_vector_type(2)));
typedef float f2_t __attribute__((ext_vector_type(2)));

#define ONE_LAUNCH 1
#define NTOK 65536
#define NTHREADS 512
#define SMEM_BYTES 114688
#define AS_BYTES 36864
#define BS_BYTES 18432
#define MISC_OFF 110592

#define OFF_A 0L
#define OFF_Z 167772160L
#define OFF_Y 419430400L
#define OFF_H 0L
#define OFF_YA OFF_Z
#define OFF_M 234881024L
#define OFF_F 369098752L
#define OFF_FD (OFF_F + 11534336L)
#define OFF_HN 386400256L
#define OFF_WM 486539264L
#define OFF_WIN OFF_WM
#define OFF_WGLU (OFF_WM + 12845056L)
#define OFF_WB (OFF_WGLU + 524288L)
#define OFF_WOUT (OFF_WB + 3145728L)
#define OFF_CAR 505151488L
#define OFF_CTR 521928704L
#define WS_NEED 521932800L

struct Params {
  const float* in[37];
  float* out;
  char* ws;
};

__device__ __forceinline__ int tid_() {
  int t = threadIdx.x;
  asm volatile("" : "+v"(t));
  return t;
}
__device__ __forceinline__ u32 pack2(float a, float b) {
  f2_t v = {a, b};
  bf2_t r = __builtin_convertvector(v, bf2_t);
  return *(u32*)&r;
}
__device__ __forceinline__ u16 f2bf(float a) { return (u16)(pack2(a, 0.f) & 0xffffu); }
__device__ __forceinline__ float bflo(u32 v) { return __uint_as_float(v << 16); }
__device__ __forceinline__ float bfhi(u32 v) { return __uint_as_float(v & 0xffff0000u); }
__device__ __forceinline__ float sigm(float x) { return 1.f / (1.f + __expf(-x)); }
__device__ __forceinline__ float dpp_xor1(float v) {
  return __int_as_float(__builtin_amdgcn_mov_dpp(__float_as_int(v), 0xB1, 0xF, 0xF, true));
}
__device__ __forceinline__ float dpp_xor2(float v) {
  return __int_as_float(__builtin_amdgcn_mov_dpp(__float_as_int(v), 0x4E, 0xF, 0xF, true));
}

template <bool AF32, int NI>
__device__ __forceinline__ void gemm_loop(const void* Aptr, long lda, const u16* Bt, long ldb, int K,
                                          f32x16 (&acc)[2][NI], float& ss, char* smem) {
  const int tid = tid_(), lane = tid & 63, w = tid >> 6;
  const int wm = w >> 1, wn = w & 1, lr = lane & 31, lh = lane >> 5;
  const int arow = tid >> 1, ahalf = tid & 1;
  const int brow = (NI == 2) ? (tid >> 2) : (tid >> 3), bq = (NI == 2) ? (tid & 3) : (tid & 7);
  const int nk = K >> 6;
  float4 raf[8];
  uint4 rab[4];
  uint4 rb[2];
  const float* Af = (const float*)Aptr + (long)arow * lda + 32 * ahalf;
  const u16* Ab = (const u16*)Aptr + (long)arow * lda + 32 * ahalf;
  const u16* Bp = Bt + (long)brow * ldb + 8 * NI * bq;
  char* a_dst = smem + arow * 144 + ahalf * 64;
  char* b_dst = smem + AS_BYTES + brow * 144 + bq * 16 * NI;
  const char* a_src = smem + (wm * 64 + lr) * 144 + lh * 16;
  const char* b_src = smem + AS_BYTES + (wn * 32 * NI + lr) * 144 + lh * 16;

#define G_LOAD(kt)                                                                       \
  {                                                                                      \
    if (AF32) {                                                                          \
      _Pragma("unroll") for (int i = 0; i < 8; ++i) raf[i] = *(const float4*)(Af + (kt) * 64 + 4 * i); \
    } else {                                                                             \
      _Pragma("unroll") for (int i = 0; i < 4; ++i) rab[i] = *(const uint4*)(Ab + (kt) * 64 + 8 * i); \
    }                                                                                    \
    rb[0] = *(const uint4*)(Bp + (kt) * 64);                                             \
    if (NI == 2) rb[1] = *(const uint4*)(Bp + (kt) * 64 + 8);                            \
  }
#define G_STORE(buf)                                                                     \
  {                                                                                      \
    char* ad = a_dst + (buf) * (AS_BYTES + BS_BYTES);                                    \
    char* bd = b_dst + (buf) * (AS_BYTES + BS_BYTES);                                    \
    if (AF32) {                                                                          \
      _Pragma("unroll") for (int i = 0; i < 4; ++i) {                                    \
        float4 x0 = raf[2 * i], x1 = raf[2 * i + 1];                                     \
        ss += x0.x * x0.x + x0.y * x0.y + x0.z * x0.z + x0.w * x0.w;                     \
        ss += x1.x * x1.x + x1.y * x1.y + x1.z * x1.z + x1.w * x1.w;                     \
        uint4 o;                                                                         \
        o.x = pack2(x0.x, x0.y); o.y = pack2(x0.z, x0.w);                                \
        o.z = pack2(x1.x, x1.y); o.w = pack2(x1.z, x1.w);                                \
        *(uint4*)(ad + 16 * i) = o;                                                      \
      }                                                                                  \
    } else {                                                                             \
      _Pragma("unroll") for (int i = 0; i < 4; ++i) *(uint4*)(ad + 16 * i) = rab[i];     \
    }                                                                                    \
    *(uint4*)(bd) = rb[0];                                                               \
    if (NI == 2) *(uint4*)(bd + 16) = rb[1];                                             \
  }

  G_LOAD(0);
  G_STORE(0);
  __syncthreads();
  for (int kt = 0; kt < nk; ++kt) {
    const int buf = kt & 1;
    if (kt + 1 < nk) G_LOAD(kt + 1);
    const char* as = a_src + buf * (AS_BYTES + BS_BYTES);
    const char* bs = b_src + buf * (AS_BYTES + BS_BYTES);
#pragma unroll
    for (int kk = 0; kk < 4; ++kk) {
      bf16x8 a0 = *(const bf16x8*)(as + kk * 32);
      bf16x8 a1 = *(const bf16x8*)(as + 32 * 144 + kk * 32);
      bf16x8 b0 = *(const bf16x8*)(bs + kk * 32);
      acc[0][0] = __builtin_amdgcn_mfma_f32_32x32x16_bf16(a0, b0, acc[0][0], 0, 0, 0);
      acc[1][0] = __builtin_amdgcn_mfma_f32_32x32x16_bf16(a1, b0, acc[1][0], 0, 0, 0);
      if (NI == 2) {
        bf16x8 b1 = *(const bf16x8*)(bs + 32 * 144 + kk * 32);
        acc[0][NI - 1] = __builtin_amdgcn_mfma_f32_32x32x16_bf16(a0, b1, acc[0][NI - 1], 0, 0, 0);
        acc[1][NI - 1] = __builtin_amdgcn_mfma_f32_32x32x16_bf16(a1, b1, acc[1][NI - 1], 0, 0, 0);
      }
    }
    if (kt + 1 < nk) G_STORE(buf ^ 1);
    __syncthreads();
  }
#undef G_LOAD
#undef G_STORE
}

template <int NI>
__device__ __forceinline__ void zero_acc(f32x16 (&acc)[2][NI]) {
#pragma unroll
  for (int i = 0; i < 2; ++i)
#pragma unroll
    for (int j = 0; j < NI; ++j)
#pragma unroll
      for (int r = 0; r < 16; ++r) acc[i][j][r] = 0.f;
}

__device__ __forceinline__ void publish_rstd(float ss, char* smem) {
  float tot = ss + __shfl_xor(ss, 1);
  float* rs = (float*)(smem + MISC_OFF);
  if ((tid_() & 1) == 0) rs[tid_() >> 1] = rsqrtf(tot * (1.f / 1024.f) + 1e-6f);
  __syncthreads();
}

__device__ __forceinline__ void decode_tile(int id, int NT, int& mt, int& nt) {
  int grp = id / (8 * NT);
  int loc = id - grp * 8 * NT;
  mt = grp * 8 + (loc & 7);
  nt = loc >> 3;
}

__device__ __forceinline__ const float* xin_row(const Params& p, long t) {
  return t < 32768 ? p.in[0] + t * 1024 : p.in[1] + (t - 32768) * 1024;
}

__device__ void conv_tile(const float* src, int N, int K, u16* dst, int rs, int off, int tile, char* smem,
                          const float* gain = nullptr) {
  const int tid = tid_();
  float* tl = (float*)smem;
  int ntn = N >> 6;
  int kt = tile / ntn, nt = tile - kt * ntn;
  int k0 = kt * 64, n0 = nt * 64;
  __syncthreads();
  {
    int ty = tid >> 6, tx = tid & 63;
#pragma unroll
    for (int i = 0; i < 8; ++i) {
      int k = ty + 8 * i;
      float gv = gain ? gain[k0 + k] : 1.f;
      tl[k * 65 + tx] = src[(long)(k0 + k) * N + n0 + tx] * gv;
    }
  }
  __syncthreads();
  {
    int n = tid >> 3, kq = tid & 7;
    float v[8];
#pragma unroll
    for (int j = 0; j < 8; ++j) v[j] = tl[(8 * kq + j) * 65 + n];
    int nn = n0 + n;
    long drow = (long)(nn >> 5) * rs + (nn & 31) + off;
    uint4 o;
    o.x = pack2(v[0], v[1]); o.y = pack2(v[2], v[3]); o.z = pack2(v[4], v[5]); o.w = pack2(v[6], v[7]);
    *(uint4*)(dst + drow * K + k0 + 8 * kq) = o;
  }
}

__device__ void conv_ffn(const Params& p, int layer, int which, char* smem) {
  const float* wg = p.in[which ? 34 : 3] + (long)layer * 1024 * 2816;
  const float* wu = p.in[which ? 35 : 4] + (long)layer * 1024 * 2816;
  const float* wd = p.in[which ? 36 : 5] + (long)layer * 1024 * 2816;
  u16* dgu = (u16*)(p.ws + OFF_F);
  u16* dd = (u16*)(p.ws + OFF_FD);
  for (int j = blockIdx.x; j < 2112; j += gridDim.x) {
    if (j < 704) conv_tile(wg, 2816, 1024, dgu, 64, 0, j, smem);
    else if (j < 1408) conv_tile(wu, 2816, 1024, dgu, 64, 32, j - 704, smem);
    else conv_tile(wd, 1024, 2816, dd, 32, 0, j - 1408, smem);
  }
}
__device__ void conv_mix(const Params& p, int layer, char* smem) {
  const float* win = p.in[7] + (long)layer * 1024 * 6272;
  const float* wglu = p.in[16] + (long)layer * 512 * 512;
  const float* wb = p.in[31] + (long)layer * 3 * 512 * 1024;
  const float* wout = p.in[32] + (long)layer * 1024 * 1024;
  for (int j = blockIdx.x; j < 2272; j += gridDim.x) {
    if (j < 1568) conv_tile(win, 6272, 1024, (u16*)(p.ws + OFF_WIN), 32, 0, j, smem, p.in[6] + layer * 1024);
    else if (j < 1632) conv_tile(wglu, 512, 512, (u16*)(p.ws + OFF_WGLU), 32, 0, j - 1568, smem);
    else if (j < 2016) {
      int jj = j - 1632, i = jj >> 7;
      conv_tile(wb + (long)i * 512 * 1024, 1024, 512, (u16*)(p.ws + OFF_WB) + (long)i * 1024 * 512, 32, 0, jj & 127, smem);
    } else conv_tile(wout, 1024, 1024, (u16*)(p.ws + OFF_WOUT), 32, 0, j - 2016, smem);
  }
}

__device__ void phase_norm(const Params& p, bool from_in, const float* gain) {
  const int lane = tid_() & 63, w = tid_() >> 6;
  u16* hn = (u16*)(p.ws + OFF_HN);
  for (long row = (long)blockIdx.x * 8 + w; row < NTOK; row += (long)gridDim.x * 8) {
    const float* src = from_in ? xin_row(p, row) : p.out + row * 1024;
    float4 v[4];
    float ss = 0.f;
#pragma unroll
    for (int i = 0; i < 4; ++i) {
      v[i] = *(const float4*)(src + 4 * (i * 64 + lane));
      ss += v[i].x * v[i].x + v[i].y * v[i].y + v[i].z * v[i].z + v[i].w * v[i].w;
    }
#pragma unroll
    for (int m = 32; m >= 1; m >>= 1) ss += __shfl_xor(ss, m);
    float rstd = rsqrtf(ss * (1.f / 1024.f) + 1e-6f);
#pragma unroll
    for (int i = 0; i < 4; ++i) {
      float4 g = *(const float4*)(gain + 4 * (i * 64 + lane));
      uint2 o;
      o.x = pack2(v[i].x * rstd * g.x, v[i].y * rstd * g.y);
      o.y = pack2(v[i].z * rstd * g.z, v[i].w * rstd * g.w);
      *(uint2*)(hn + row * 1024 + 4 * (i * 64 + lane)) = o;
    }
  }
}

__device__ void phase_ffn_a(const Params& p, char* smem) {
  const int lane = tid_() & 63, w = tid_() >> 6;
  const int wm = w >> 1, wn = w & 1, lr = lane & 31, lh = lane >> 5;
  const u16* hn = (const u16*)(p.ws + OFF_HN);
  const u16* wgu = (const u16*)(p.ws + OFF_F);
  u16* H = (u16*)(p.ws + OFF_H);
  const int NT = 44;
  for (int id = blockIdx.x; id < 256 * NT; id += gridDim.x) {
    int mt, nt;
    decode_tile(id, NT, mt, nt);
    f32x16 acc[2][2];
    zero_acc<2>(acc);
    float ss = 0.f;
    gemm_loop<false, 2>(hn + (long)mt * 256 * 1024, 1024, wgu + (long)nt * 128 * 1024, 1024, 1024, acc, ss, smem);
    int hc = ((nt * 128 + wn * 64) >> 1) + lr;
#pragma unroll
    for (int mi = 0; mi < 2; ++mi)
#pragma unroll
      for (int r = 0; r < 16; ++r) {
        long row = (long)mt * 256 + wm * 64 + mi * 32 + (r & 3) + 8 * (r >> 2) + 4 * lh;
        float g = acc[mi][0][r], u = acc[mi][1][r];
        H[row * 2816 + hc] = f2bf(g * sigm(g) * u);
      }
  }
}

__device__ void phase_ffn_b(const Params& p, bool from_in, char* smem) {
  const int lane = tid_() & 63, w = tid_() >> 6;
  const int wm = w >> 1, wn = w & 1, lr = lane & 31, lh = lane >> 5;
  const u16* H = (const u16*)(p.ws + OFF_H);
  const u16* wd = (const u16*)(p.ws + OFF_FD);
  const int NT = 8;
  for (int id = blockIdx.x; id < 256 * NT; id += gridDim.x) {
    int mt, nt;
    decode_tile(id, NT, mt, nt);
    f32x16 acc[2][2];
    zero_acc<2>(acc);
    float ss = 0.f;
    gemm_loop<false, 2>(H + (long)mt * 256 * 2816, 2816, wd + (long)nt * 128 * 2816, 2816, 2816, acc, ss, smem);
#pragma unroll
    for (int mi = 0; mi < 2; ++mi)
#pragma unroll
      for (int ni = 0; ni < 2; ++ni)
#pragma unroll
        for (int r = 0; r < 16; ++r) {
          long row = (long)mt * 256 + wm * 64 + mi * 32 + (r & 3) + 8 * (r >> 2) + 4 * lh;
          int col = nt * 128 + wn * 64 + ni * 32 + lr;
          const float* xi = from_in ? xin_row(p, row) : p.out + row * 1024;
          p.out[row * 1024 + col] = xi[col] + 0.5f * acc[mi][ni][r];
        }
  }
}

__device__ void phase_proj(const Params& p, char* smem) {
  const int lane = tid_() & 63, w = tid_() >> 6;
  const int wm = w >> 1, wn = w & 1, lr = lane & 31, lh = lane >> 5;
  const u16* win = (const u16*)(p.ws + OFF_WIN);
  u16* RA = (u16*)(p.ws + OFF_A);
  u16* RZ = (u16*)(p.ws + OFF_Z);
  const float* rs = (const float*)(smem + MISC_OFF);
  const int NT = 25;
  for (int id = blockIdx.x; id < 256 * NT; id += gridDim.x) {
    int mt, nt;
    decode_tile(id, NT, mt, nt);
    f32x16 acc[2][2];
    zero_acc<2>(acc);
    float ss = 0.f;
    gemm_loop<true, 2>(p.out + (long)mt * 256 * 1024, 1024, win + (long)nt * 128 * 1024, 1024, 1024, acc, ss, smem);
    publish_rstd(ss, smem);
#pragma unroll
    for (int mi = 0; mi < 2; ++mi)
#pragma unroll
      for (int ni = 0; ni < 2; ++ni)
#pragma unroll
        for (int r = 0; r < 16; ++r) {
          int lrow = wm * 64 + mi * 32 + (r & 3) + 8 * (r >> 2) + 4 * lh;
          long row = (long)mt * 256 + lrow;
          int col = nt * 128 + wn * 64 + ni * 32 + lr;
          u16 v = f2bf(acc[mi][ni][r] * rs[lrow]);
          if (nt < 10) RA[row * 1280 + col] = v;
          else RZ[row * 1920 + (col - 1280)] = v;
        }
  }
}

__device__ void phase_glu(const Params& p, char* smem) {
  const int lane = tid_() & 63, w = tid_() >> 6;
  const int wm = w >> 1, wn = w & 1, lr = lane & 31, lh = lane >> 5;
  const u16* RA = (const u16*)(p.ws + OFF_A);
  const u16* wg = (const u16*)(p.ws + OFF_WGLU);
  u16* YA = (u16*)(p.ws + OFF_YA);
  const int NT = 4;
  for (int id = blockIdx.x; id < 256 * NT; id += gridDim.x) {
    int mt, nt;
    decode_tile(id, NT, mt, nt);
    f32x16 acc[2][2];
    zero_acc<2>(acc);
    float ss = 0.f;
    gemm_loop<false, 2>(RA + (long)mt * 256 * 1280, 1280, wg + (long)nt * 128 * 512, 512, 512, acc, ss, smem);
#pragma unroll
    for (int mi = 0; mi < 2; ++mi)
#pragma unroll
      for (int ni = 0; ni < 2; ++ni)
#pragma unroll
        for (int r = 0; r < 16; ++r) {
          long row = (long)mt * 256 + wm * 64 + mi * 32 + (r & 3) + 8 * (r >> 2) + 4 * lh;
          int col = nt * 128 + wn * 64 + ni * 32 + lr;
          float y = bflo(RA[row * 1280 + col]);
          YA[row * 512 + col] = f2bf(y * sigm(acc[mi][ni][r]));
        }
  }
}

__device__ void phase_m(const Params& p, char* smem) {
  const int lane = tid_() & 63, w = tid_() >> 6;
  const int wm = w >> 1, wn = w & 1, lr = lane & 31, lh = lane >> 5;
  const u16* win = (const u16*)(p.ws + OFF_WIN);
  const u16* wb = (const u16*)(p.ws + OFF_WB);
  u16* Mo = (u16*)(p.ws + OFF_M);
  const float* rs = (const float*)(smem + MISC_OFF);
  const int NT = 16;
  for (int id = blockIdx.x; id < 256 * NT; id += gridDim.x) {
    int mt, nt;
    decode_tile(id, NT, mt, nt);
    f32x16 macc[2][1];
    zero_acc<1>(macc);
#pragma unroll 1
    for (int i = 0; i < 3; ++i) {
      f32x16 acc[2][1];
      zero_acc<1>(acc);
      float ss = 0.f;
      gemm_loop<true, 1>(p.out + (long)mt * 256 * 1024, 1024, win + (long)(3200 + 1024 * i + nt * 64) * 1024, 1024, 1024,
                         acc, ss, smem);
      if (i == 0) publish_rstd(ss, smem);
      u32 gp[2][8];
#pragma unroll
      for (int mi = 0; mi < 2; ++mi)
#pragma unroll
        for (int r = 0; r < 16; r += 2) {
          int lrow = wm * 64 + mi * 32 + (r & 3) + 8 * (r >> 2) + 4 * lh;
          float g0 = sigm(acc[mi][0][r] * rs[lrow]);
          float g1 = sigm(acc[mi][0][r + 1] * rs[lrow + 1]);
          gp[mi][r >> 1] = pack2(g0, g1);
        }
      zero_acc<1>(acc);
      const u16* ya;
      long lda;
      if (i == 0) { ya = (const u16*)(p.ws + OFF_YA) + (long)mt * 256 * 512; lda = 512; }
      else if (i == 1) { ya = (const u16*)(p.ws + OFF_A) + (long)mt * 256 * 1280 + 512; lda = 1280; }
      else { ya = (const u16*)(p.ws + OFF_Y) + (long)mt * 256 * 512; lda = 512; }
      gemm_loop<false, 1>(ya, lda, wb + (long)i * 1024 * 512 + (long)nt * 64 * 512, 512, 512, acc, ss, smem);
#pragma unroll
      for (int mi = 0; mi < 2; ++mi)
#pragma unroll
        for (int r = 0; r < 16; r += 2) {
          u32 g = gp[mi][r >> 1];
          macc[mi][0][r] += bflo(g) * acc[mi][0][r];
          macc[mi][0][r + 1] += bfhi(g) * acc[mi][0][r + 1];
        }
    }
#pragma unroll
    for (int mi = 0; mi < 2; ++mi)
#pragma unroll
      for (int r = 0; r < 16; ++r) {
        long row = (long)mt * 256 + wm * 64 + mi * 32 + (r & 3) + 8 * (r >> 2) + 4 * lh;
        int col = nt * 64 + wn * 32 + lr;
        Mo[row * 1024 + col] = f2bf(macc[mi][0][r]);
      }
  }
}

__device__ void phase_out(const Params& p, char* smem) {
  const int lane = tid_() & 63, w = tid_() >> 6;
  const int wm = w >> 1, wn = w & 1, lr = lane & 31, lh = lane >> 5;
  const u16* Mi = (const u16*)(p.ws + OFF_M);
  const u16* wo = (const u16*)(p.ws + OFF_WOUT);
  const int NT = 8;
  for (int id = blockIdx.x; id < 256 * NT; id += gridDim.x) {
    int mt, nt;
    decode_tile(id, NT, mt, nt);
    f32x16 acc[2][2];
    zero_acc<2>(acc);
    float ss = 0.f;
    gemm_loop<false, 2>(Mi + (long)mt * 256 * 1024, 1024, wo + (long)nt * 128 * 1024, 1024, 1024, acc, ss, smem);
#pragma unroll
    for (int mi = 0; mi < 2; ++mi)
#pragma unroll
      for (int ni = 0; ni < 2; ++ni)
#pragma unroll
        for (int r = 0; r < 16; ++r) {
          long row = (long)mt * 256 + wm * 64 + mi * 32 + (r & 3) + 8 * (r >> 2) + 4 * lh;
          int col = nt * 128 + wn * 64 + ni * 32 + lr;
          p.out[row * 1024 + col] += acc[mi][ni][r];
        }
  }
}

#define KS_PITCH 144
#define VT_PITCH 784
__device__ void attn_item(const Params& p, int layer, int item, char* smem) {
  const int tid = tid_(), lane = tid & 63, w = tid >> 6;
  const int lr = lane & 31, lh = lane >> 5;
  const int qb = item >> 1, kvh = item & 1;
  const long t0 = (long)qb * 128;
  int L, pos0;
  if (t0 < 32768) { L = 2048; pos0 = (int)(t0 & 2047); } else { L = 4096; pos0 = (int)((t0 - 32768) & 4095); }
  u16* RA = (u16*)(p.ws + OFF_A);
  char* Ks = smem;
  char* Vt = smem + 384 * KS_PITCH;
  float* gq = (float*)(smem + MISC_OFF);
  float* gk = gq + 64;
  __syncthreads();
  if (tid < 64) gq[tid] = p.in[17][layer * 64 + tid];
  else if (tid < 128) gk[tid - 64] = p.in[18][layer * 64 + tid - 64];
  __syncthreads();
  {
    const int q4 = tid & 3;
    for (int pass = 0; pass < 3; ++pass) {
      int r = pass * 128 + (tid >> 2);
      int kpos = pos0 - 128 + r;
      bool valid = (kpos >= 0) && (kpos < L);
      float kv[16], vv[16];
      if (valid) {
        const u16* kp = RA + (t0 - 128 + r) * 1280 + 1024 + kvh * 64 + 16 * q4;
        uint4 a = *(const uint4*)kp, b = *(const uint4*)(kp + 8);
        uint4 c = *(const uint4*)(kp + 128), d = *(const uint4*)(kp + 136);
        u32 ka[8] = {a.x, a.y, a.z, a.w, b.x, b.y, b.z, b.w};
        u32 va[8] = {c.x, c.y, c.z, c.w, d.x, d.y, d.z, d.w};
#pragma unroll
        for (int i = 0; i < 8; ++i) {
          kv[2 * i] = bflo(ka[i]); kv[2 * i + 1] = bfhi(ka[i]);
          vv[2 * i] = bflo(va[i]); vv[2 * i + 1] = bfhi(va[i]);
        }
      } else {
#pragma unroll
        for (int i = 0; i < 16; ++i) { kv[i] = 0.f; vv[i] = 0.f; }
      }
      float ss = 0.f;
#pragma unroll
      for (int i = 0; i < 16; ++i) ss += kv[i] * kv[i];
      ss += __shfl_xor(ss, 1);
      ss += __shfl_xor(ss, 2);
      float rstd = rsqrtf(ss * (1.f / 64.f) + 1e-6f);
#pragma unroll
      for (int i = 0; i < 16; ++i) kv[i] = kv[i] * rstd * gk[16 * q4 + i];
      if (q4 == 0) {
#pragma unroll
        for (int i = 0; i < 8; ++i) {
          float invf = __expf(-1.6402954f * (float)i);
          float rev = (float)kpos * invf * 0.15915494f;
          rev -= floorf(rev);
          float cs = __builtin_amdgcn_cosf(rev), sn = __builtin_amdgcn_sinf(rev);
          float t1 = kv[i], t2 = kv[8 + i];
          kv[i] = t1 * cs - t2 * sn;
          kv[8 + i] = t2 * cs + t1 * sn;
        }
      }
      uint4 o0, o1;
      o0.x = pack2(kv[0], kv[1]); o0.y = pack2(kv[2], kv[3]); o0.z = pack2(kv[4], kv[5]); o0.w = pack2(kv[6], kv[7]);
      o1.x = pack2(kv[8], kv[9]); o1.y = pack2(kv[10], kv[11]); o1.z = pack2(kv[12], kv[13]); o1.w = pack2(kv[14], kv[15]);
      *(uint4*)(Ks + r * KS_PITCH + q4 * 32) = o0;
      *(uint4*)(Ks + r * KS_PITCH + q4 * 32 + 16) = o1;
#pragma unroll
      for (int i = 0; i < 16; ++i) *(u16*)(Vt + (16 * q4 + i) * VT_PITCH + r * 2) = f2bf(vv[i]);
    }
  }
  __syncthreads();
  float gqm = 0.f, gkm = 0.f;
  for (int i = 0; i < 64; ++i) { gqm = fmaxf(gqm, fabsf(gq[i])); gkm = fmaxf(gkm, fabsf(gk[i])); }
  const float mb = 8.f * gqm * gkm;
  for (int uu = 0; uu < 2; ++uu) {
    const int u = 2 * w + uu;
    const int hl = u >> 2, qt = u & 3;
    const int head = kvh * 4 + hl;
    const long tq = t0 + 32 * qt + lr;
    const int qpos = pos0 + 32 * qt + lr;
    u16* qrow = RA + tq * 1280 + 512 + head * 64;
    bf16x8 qf[4];
    {
      uint4 qraw[8];
      float ss = 0.f;
#pragma unroll
      for (int i = 0; i < 8; ++i) {
        uint4 a = *(const uint4*)(qrow + 8 * i);
        qraw[i] = a;
        float f0 = bflo(a.x), f1 = bfhi(a.x), f2 = bflo(a.y), f3 = bfhi(a.y);
        float f4 = bflo(a.z), f5 = bfhi(a.z), f6 = bflo(a.w), f7 = bfhi(a.w);
        ss += f0 * f0 + f1 * f1 + f2 * f2 + f3 * f3 + f4 * f4 + f5 * f5 + f6 * f6 + f7 * f7;
      }
      const float rstd = rsqrtf(ss * (1.f / 64.f) + 1e-6f) * 0.125f;
      {
        uint4 lo = qraw[0], hi = qraw[1];
        float t1[8] = {bflo(lo.x), bfhi(lo.x), bflo(lo.y), bfhi(lo.y), bflo(lo.z), bfhi(lo.z), bflo(lo.w), bfhi(lo.w)};
        float t2[8] = {bflo(hi.x), bfhi(hi.x), bflo(hi.y), bfhi(hi.y), bflo(hi.z), bfhi(hi.z), bflo(hi.w), bfhi(hi.w)};
        float f[8];
#pragma unroll
        for (int i = 0; i < 8; ++i) {
          float invf = __expf(-1.6402954f * (float)i);
          float rev = (float)qpos * invf * 0.15915494f;
          rev -= floorf(rev);
          float cs = __builtin_amdgcn_cosf(rev), sn = __builtin_amdgcn_sinf(rev);
          float x1 = t1[i] * rstd * gq[i], x2 = t2[i] * rstd * gq[8 + i];
          float a = lh ? x2 : x1;
          float b = lh ? x1 : -x2;
          f[i] = a * cs + b * sn;
        }
        u32 pk[4] = {pack2(f[0], f[1]), pack2(f[2], f[3]), pack2(f[4], f[5]), pack2(f[6], f[7])};
        qf[0] = *(bf16x8*)pk;
      }
#pragma unroll
      for (int s = 1; s < 4; ++s) {
        uint4 lo = qraw[2 * s], hi = qraw[2 * s + 1];
        uint4 sel;
        sel.x = lh ? hi.x : lo.x; sel.y = lh ? hi.y : lo.y; sel.z = lh ? hi.z : lo.z; sel.w = lh ? hi.w : lo.w;
        const float* gp = gq + 16 * s + 8 * lh;
        float f[8] = {bflo(sel.x), bfhi(sel.x), bflo(sel.y), bfhi(sel.y), bflo(sel.z), bfhi(sel.z), bflo(sel.w), bfhi(sel.w)};
#pragma unroll
        for (int i = 0; i < 8; ++i) f[i] = f[i] * rstd * gp[i];
        u32 pk2[4] = {pack2(f[0], f[1]), pack2(f[2], f[3]), pack2(f[4], f[5]), pack2(f[6], f[7])};
        qf[s] = *(bf16x8*)pk2;
      }
    }
    f32x16 o0, o1;
#pragma unroll
    for (int r = 0; r < 16; ++r) { o0[r] = 0.f; o1[r] = 0.f; }
    float lsum = 0.f;
    for (int kt = qt; kt < qt + 9; ++kt) {
      f32x16 s;
#pragma unroll
      for (int r = 0; r < 16; ++r) s[r] = 0.f;
      const char* kb = Ks + (kt * 32 + lr) * KS_PITCH + lh * 16;
#pragma unroll
      for (int ks = 0; ks < 4; ++ks) {
        bf16x8 kf = *(const bf16x8*)(kb + ks * 32);
        s = __builtin_amdgcn_mfma_f32_32x32x16_bf16(kf, qf[ks], s, 0, 0, 0);
      }
      float pv[16];
#pragma unroll
      for (int r = 0; r < 16; ++r) {
        int kw = kt * 32 + (r & 3) + 8 * (r >> 2) + 4 * lh;
        int kpos = pos0 - 128 + kw;
        int dlt = kpos - qpos;
        bool ok = (dlt <= 128) && (dlt >= -128) && (kpos >= 0) && (kpos < L);
        float e = ok ? __expf(s[r] - mb) : 0.f;
        pv[r] = e;
        lsum += e;
      }
#pragma unroll
      for (int sk = 0; sk < 2; ++sk) {
        u32 pk[4] = {pack2(pv[8 * sk + 0], pv[8 * sk + 1]), pack2(pv[8 * sk + 2], pv[8 * sk + 3]),
                     pack2(pv[8 * sk + 4], pv[8 * sk + 5]), pack2(pv[8 * sk + 6], pv[8 * sk + 7])};
        bf16x8 pf = *(bf16x8*)pk;
        const char* vb = Vt + lr * VT_PITCH + (kt * 32 + 16 * sk + 4 * lh) * 2;
        uint2 va = *(const uint2*)(vb), vb2 = *(const uint2*)(vb + 16);
        u32 vk[4] = {va.x, va.y, vb2.x, vb2.y};
        bf16x8 vf0 = *(bf16x8*)vk;
        uint2 vc = *(const uint2*)(vb + 32 * VT_PITCH), vd = *(const uint2*)(vb + 32 * VT_PITCH + 16);
        u32 vk1[4] = {vc.x, vc.y, vd.x, vd.y};
        bf16x8 vf1 = *(bf16x8*)vk1;
        o0 = __builtin_amdgcn_mfma_f32_32x32x16_bf16(vf0, pf, o0, 0, 0, 0);
        o1 = __builtin_amdgcn_mfma_f32_32x32x16_bf16(vf1, pf, o1, 0, 0, 0);
      }
    }
    lsum += __shfl_xor(lsum, 32);
    lsum += __expf(p.in[19][layer * 8 + head] - mb);
    float inv = 1.f / lsum;
#pragma unroll
    for (int g = 0; g < 4; ++g) {
      uint2 a, b;
      a.x = pack2(o0[4 * g] * inv, o0[4 * g + 1] * inv); a.y = pack2(o0[4 * g + 2] * inv, o0[4 * g + 3] * inv);
      b.x = pack2(o1[4 * g] * inv, o1[4 * g + 1] * inv); b.y = pack2(o1[4 * g + 2] * inv, o1[4 * g + 3] * inv);
      *(uint2*)(qrow + 8 * g + 4 * lh) = a;
      *(uint2*)(qrow + 32 + 8 * g + 4 * lh) = b;
    }
  }
}

template <bool PASS2>
__device__ void s5_unit(const Params& p, int layer, int unit, char* wsm) {
  const int lane = tid_() & 63;
  const int c = unit >> 5, g = unit & 31;
  const long t0 = (long)c * 128;
  float* U = (float*)wsm;
  char* ST = wsm + 8192;
  u16* RA = (u16*)(p.ws + OFF_A);
  float* CAR = (float*)(p.ws + OFF_CAR);
  __builtin_amdgcn_wave_barrier();
#pragma unroll
  for (int i = 0; i < 2; ++i) {
    int tau = lane + 64 * i;
    const u16* src = RA + (t0 + tau) * 1280 + 16 * g;
    uint4 a = *(const uint4*)src, b = *(const uint4*)(src + 8);
    float4 f0 = {bflo(a.x), bfhi(a.x), bflo(a.y), bfhi(a.y)};
    float4 f1 = {bflo(a.z), bfhi(a.z), bflo(a.w), bfhi(a.w)};
    float4 f2 = {bflo(b.x), bfhi(b.x), bflo(b.y), bfhi(b.y)};
    float4 f3 = {bflo(b.z), bfhi(b.z), bflo(b.w), bfhi(b.w)};
    float4* d = (float4*)(U + tau * 16);
    d[0] = f0; d[1] = f1; d[2] = f2; d[3] = f3;
  }
  __builtin_amdgcn_wave_barrier();
  f32x4 acc[8];
#pragma unroll
  for (int i = 0; i < 8; ++i) acc[i] = (f32x4){0.f, 0.f, 0.f, 0.f};
  int clo, chi;
  if (c < 256) { clo = c & ~15; chi = clo + 16; } else { clo = c & ~31; chi = clo + 32; }

#pragma unroll
  for (int d = 0; d < 2; ++d) {
    const long pg = ((long)(layer * 2 + d) * 32 + g);
    float lre = fminf(p.in[8][pg * 64 + lane], -1e-4f);
    float lim = p.in[9][pg * 64 + lane];
    float dt = expf(p.in[10][pg]);
    float er = expf(lre * dt);
    float ang = lim * dt;
    float nrev = rintf(ang * 0.15915494f);
    float rr = fmaf(-nrev, 6.28125f, ang);
    rr = fmaf(-nrev, 1.9353071795864769e-3f, rr);
    float ar = er * cosf(rr), ai = er * sinf(rr);
    float den = 1.f / (lre * lre + lim * lim);
    float nr = ar - 1.f;
    float c0r = (nr * lre + ai * lim) * den, c0i = (ai * lre - nr * lim) * den;
    float Br[16], Bi[16];
    {
      const float4* br = (const float4*)(p.in[11] + (pg * 64 + lane) * 16);
      const float4* bi = (const float4*)(p.in[12] + (pg * 64 + lane) * 16);
#pragma unroll
      for (int i = 0; i < 4; ++i) {
        float4 x = br[i], y = bi[i];
        Br[4 * i + 0] = c0r * x.x - c0i * y.x; Bi[4 * i + 0] = c0r * y.x + c0i * x.x;
        Br[4 * i + 1] = c0r * x.y - c0i * y.y; Bi[4 * i + 1] = c0r * y.y + c0i * x.y;
        Br[4 * i + 2] = c0r * x.z - c0i * y.z; Bi[4 * i + 2] = c0r * y.z + c0i * x.z;
        Br[4 * i + 3] = c0r * x.w - c0i * y.w; Bi[4 * i + 3] = c0r * y.w + c0i * x.w;
      }
    }
    float sr = 0.f, si = 0.f;
    bf16x8 cf[4];
    if (PASS2) {
      float pr = ar, pi = ai;
#pragma unroll
      for (int i = 0; i < 7; ++i) { float t = pr * pr - pi * pi; pi = 2.f * pr * pi; pr = t; }
      if (d == 0) {
        for (int cc = clo; cc < c; ++cc) {
          float2 e = *(const float2*)(CAR + (((long)cc * 32 + g) * 2 + 0) * 128 + 2 * lane);
          float t = pr * sr - pi * si + e.x; si = pr * si + pi * sr + e.y; sr = t;
        }
      } else {
        for (int cc = chi - 1; cc > c; --cc) {
          float2 e = *(const float2*)(CAR + (((long)cc * 32 + g) * 2 + 1) * 128 + 2 * lane);
          float t = pr * sr - pi * si + e.x; si = pr * si + pi * sr + e.y; sr = t;
        }
      }
      const int h = lane & 15, q = lane >> 4;
      const float* cre = p.in[13] + (pg * 16 + h) * 64;
      const float* cim = p.in[14] + (pg * 16 + h) * 64;
#pragma unroll
      for (int ks = 0; ks < 4; ++ks) {
        float4 x = *(const float4*)(cre + 16 * ks + 4 * q);
        float4 y = *(const float4*)(cim + 16 * ks + 4 * q);
        u32 pk[4] = {pack2(x.x, -y.x), pack2(x.y, -y.y), pack2(x.z, -y.z), pack2(x.w, -y.w)};
        cf[ks] = *(bf16x8*)pk;
      }
    }
#pragma unroll
    for (int sbi = 0; sbi < 8; ++sbi) {
      const int sb = d ? 7 - sbi : sbi;
#pragma unroll 4
      for (int s = 0; s < 16; ++s) {
        const int tl = d ? 15 - s : s;
        const int tau = sb * 16 + tl;
        const float4* up = (const float4*)(U + tau * 16);
        float4 u0 = up[0], u1 = up[1], u2 = up[2], u3 = up[3];
        float uu[16] = {u0.x, u0.y, u0.z, u0.w, u1.x, u1.y, u1.z, u1.w, u2.x, u2.y, u2.z, u2.w, u3.x, u3.y, u3.z, u3.w};
        float bur = 0.f, bui = 0.f;
#pragma unroll
        for (int hh = 0; hh < 16; ++hh) { bur += Br[hh] * uu[hh]; bui += Bi[hh] * uu[hh]; }
        float t = ar * sr - ai * si + bur;
        si = ar * si + ai * sr + bui;
        sr = t;
        if (PASS2) *(u32*)(ST + tl * 272 + 4 * lane) = pack2(sr, si);
      }
      if (PASS2) {
        __builtin_amdgcn_wave_barrier();
        const char* ab = ST + (lane & 15) * 272 + (lane >> 4) * 16;
#pragma unroll
        for (int ks = 0; ks < 4; ++ks) {
          bf16x8 af = *(const bf16x8*)(ab + ks * 64);
          acc[sb] = __builtin_amdgcn_mfma_f32_16x16x32_bf16(af, cf[ks], acc[sb], 0, 0, 0);
        }
        __builtin_amdgcn_wave_barrier();
      }
    }
    if (!PASS2) {
      float2 e = {sr, si};
      *(float2*)(CAR + (((long)c * 32 + g) * 2 + d) * 128 + 2 * lane) = e;
    }
  }
  if (PASS2) {
    const int h = lane & 15, q = lane >> 4;
    const float dsk = p.in[15][(layer * 32 + g) * 16 + h];
#pragma unroll
    for (int sb = 0; sb < 8; ++sb)
#pragma unroll
      for (int r = 0; r < 4; ++r) {
        int tau = sb * 16 + 4 * q + r;
        float y = acc[sb][r] + dsk * U[tau * 16 + h];
        float t = tanhf(0.7978845608f * (y + 0.044715f * y * y * y));
        y = 0.5f * y * (1.f + t);
        RA[(t0 + tau) * 1280 + 16 * g + h] = f2bf(y);
      }
  }
}

#define RW_GRP 49664
__device__ void rwkv_pair(const Params& p, int layer, int pr, char* smem) {
  const int tid = tid_(), d = tid >> 8, gt = tid & 255, gw = gt >> 6, lane = tid & 63;
  int head, L;
  long tok0;
  if (pr < 64) { head = pr & 7; L = 4096; tok0 = 32768 + (long)(pr >> 3) * 4096; }
  else { int q = pr - 64; head = q & 7; L = 2048; tok0 = (long)(q >> 3) * 2048; }
  char* sm = smem + d * RW_GRP;
  float* R = (float*)sm;
  float* KP = R + 1024; float* V = KP + 1024; float* W = V + 1024; float* NKK = W + 1024; float* KKA = NKK + 1024;
  float* AA = KKA + 1024; float* G = AA + 1024; float* YO = G + 1024;
  char* TW = sm + 36864; char* AL = TW + 2304; char* SG = AL + 2304;
  float* BON = (float*)(SG + 4352);
  float* MU = BON + 16;
  const u16* RZ = (const u16*)(p.ws + OFF_Z);
  u16* RY = (u16*)(p.ws + OFF_Y);
  const float* mu = p.in[20] + (long)layer * 2 * 1920;
  const float* w0 = p.in[21] + (long)(layer * 2 + d) * 512;
  const float* w2 = p.in[22] + (long)(layer * 2 + d) * 64 * 512;
  const float* a0 = p.in[23] + (long)(layer * 2 + d) * 512;
  const float* a2 = p.in[24] + (long)(layer * 2 + d) * 64 * 512;
  const float* g2 = p.in[25] + (long)layer * 128 * 512;
  __syncthreads();
  for (int idx = gt; idx < 896; idx += 256) {
    int m = idx / 448, rem = idx - m * 448, v = rem >> 6, cc = rem & 63;
    int zb = (v == 0) ? 64 * head : (v == 1) ? 512 + 64 * head : (v == 2) ? 1024 + 64 * head
           : (v == 3) ? 1536 + 64 * d : (v == 4) ? 1664 + 64 * d : (v == 5) ? 1792 : 1856;
    MU[idx] = mu[m * 1920 + zb + cc];
  }
  const int tau_a = gt >> 4, c4 = gt & 15;
  float kkc[4], kac[4], rkc[4], lnw[4], lnb[4];
#pragma unroll
  for (int e = 0; e < 4; ++e) {
    int cc = 64 * head + 4 * c4 + e;
    kkc[e] = p.in[26][layer * 512 + cc];
    kac[e] = p.in[27][layer * 512 + cc];
    rkc[e] = p.in[28][layer * 512 + cc];
    lnw[e] = p.in[29][layer * 512 + cc];
    lnb[e] = p.in[30][layer * 512 + cc];
  }
  const int c16 = lane & 15, q4 = lane >> 4;
  const int colb = 64 * head + 16 * gw + c16;
  bf16x8 w2f[2], a2f[2], g2f[4];
#pragma unroll
  for (int s = 0; s < 4; ++s) {
    float fw[8], fa[8], fg[8];
#pragma unroll
    for (int j = 0; j < 8; ++j) {
      int m = 32 * s + 8 * q4 + j;
      fg[j] = g2[(long)m * 512 + colb];
      if (s < 2) { fw[j] = w2[(long)m * 512 + colb]; fa[j] = a2[(long)m * 512 + colb]; }
    }
    u32 pg[4] = {pack2(fg[0], fg[1]), pack2(fg[2], fg[3]), pack2(fg[4], fg[5]), pack2(fg[6], fg[7])};
    g2f[s] = *(bf16x8*)pg;
    if (s < 2) {
      u32 pw[4] = {pack2(fw[0], fw[1]), pack2(fw[2], fw[3]), pack2(fw[4], fw[5]), pack2(fw[6], fw[7])};
      u32 pa[4] = {pack2(fa[0], fa[1]), pack2(fa[2], fa[3]), pack2(fa[4], fa[5]), pack2(fa[6], fa[7])};
      w2f[s] = *(bf16x8*)pw;
      a2f[s] = *(bf16x8*)pa;
    }
  }
  const float w0c = w0[colb], a0c = a0[colb];
  float S[16];
#pragma unroll
  for (int j = 0; j < 16; ++j) S[j] = 0.f;
  const int irow = 16 * gw + (lane >> 2), jq = lane & 3;
  const int NC = L >> 4;
  __syncthreads();

  for (int ci = 0; ci < NC; ++ci) {
    const int chunk = d ? NC - 1 - ci : ci;
    const long tb = tok0 + (long)chunk * 16;
    {
      const long t = tb + tau_a;
      const int pos = chunk * 16 + tau_a;
      const bool hp = pos > 0, hn = pos < L - 1;
#pragma unroll
      for (int v = 0; v < 7; ++v) {
        int zb = (v == 0) ? 64 * head : (v == 1) ? 512 + 64 * head : (v == 2) ? 1024 + 64 * head
               : (v == 3) ? 1536 + 64 * d : (v == 4) ? 1664 + 64 * d : (v == 5) ? 1792 : 1856;
        const u16* zp = RZ + t * 1920 + zb + 4 * c4;
        uint2 zc = *(const uint2*)zp;
        uint2 zpv = hp ? *(const uint2*)(zp - 1920) : make_uint2(0u, 0u);
        uint2 znv = hn ? *(const uint2*)(zp + 1920) : make_uint2(0u, 0u);
        float4 m0 = *(const float4*)(MU + v * 64 + 4 * c4);
        float4 m1 = *(const float4*)(MU + 448 + v * 64 + 4 * c4);
        float zc4[4] = {bflo(zc.x), bfhi(zc.x), bflo(zc.y), bfhi(zc.y)};
        float zp4[4] = {bflo(zpv.x), bfhi(zpv.x), bflo(zpv.y), bfhi(zpv.y)};
        float zn4[4] = {bflo(znv.x), bfhi(znv.x), bflo(znv.y), bfhi(znv.y)};
        float mm0[4] = {m0.x, m0.y, m0.z, m0.w}, mm1[4] = {m1.x, m1.y, m1.z, m1.w};
        float o[4];
#pragma unroll
        for (int e = 0; e < 4; ++e) o[e] = zc4[e] + mm0[e] * (zp4[e] - zc4[e]) + mm1[e] * (zn4[e] - zc4[e]);
        if (v == 0) *(float4*)(R + tau_a * 64 + 4 * c4) = make_float4(o[0], o[1], o[2], o[3]);
        else if (v == 1) *(float4*)(KP + tau_a * 64 + 4 * c4) = make_float4(o[0], o[1], o[2], o[3]);
        else if (v == 2) *(float4*)(V + tau_a * 64 + 4 * c4) = make_float4(o[0], o[1], o[2], o[3]);
        else if (v == 3) {
          float th[4];
#pragma unroll
          for (int e = 0; e < 4; ++e) th[e] = 1.f - 2.f / (1.f + __expf(2.f * o[e]));
          *(uint2*)(TW + tau_a * 144 + 8 * c4) = make_uint2(pack2(th[0], th[1]), pack2(th[2], th[3]));
        } else if (v == 4) {
          *(uint2*)(AL + tau_a * 144 + 8 * c4) = make_uint2(pack2(o[0], o[1]), pack2(o[2], o[3]));
        } else {
          *(uint2*)(SG + tau_a * 272 + (v - 5) * 128 + 8 * c4) =
              make_uint2(pack2(sigm(o[0]), sigm(o[1])), pack2(sigm(o[2]), sigm(o[3])));
        }
      }
    }
    __syncthreads();
    {
      f32x4 cw = {0.f, 0.f, 0.f, 0.f}, ca = cw, cgt = cw;
#pragma unroll
      for (int s = 0; s < 2; ++s) {
        bf16x8 tf = *(const bf16x8*)(TW + c16 * 144 + (32 * s + 8 * q4) * 2);
        bf16x8 af = *(const bf16x8*)(AL + c16 * 144 + (32 * s + 8 * q4) * 2);
        cw = __builtin_amdgcn_mfma_f32_16x16x32_bf16(tf, w2f[s], cw, 0, 0, 0);
        ca = __builtin_amdgcn_mfma_f32_16x16x32_bf16(af, a2f[s], ca, 0, 0, 0);
      }
#pragma unroll
      for (int s = 0; s < 4; ++s) {
        bf16x8 sf = *(const bf16x8*)(SG + c16 * 272 + (32 * s + 8 * q4) * 2);
        cgt = __builtin_amdgcn_mfma_f32_16x16x32_bf16(sf, g2f[s], cgt, 0, 0, 0);
      }
#pragma unroll
      for (int r = 0; r < 4; ++r) {
        int tau = 4 * q4 + r, cc = 16 * gw + c16;
        W[tau * 64 + cc] = __expf(-0.60653066f * sigm(cw[r] + w0c));
        AA[tau * 64 + cc] = sigm(ca[r] + a0c);
        G[tau * 64 + cc] = cgt[r];
      }
    }
    __syncthreads();
    {
      float4 k4 = *(const float4*)(KP + tau_a * 64 + 4 * c4);
      float4 a4 = *(const float4*)(AA + tau_a * 64 + 4 * c4);
      float4 r4 = *(const float4*)(R + tau_a * 64 + 4 * c4);
      float kk[4] = {k4.x * kkc[0], k4.y * kkc[1], k4.z * kkc[2], k4.w * kkc[3]};
      float kx[4] = {k4.x, k4.y, k4.z, k4.w}, ax[4] = {a4.x, a4.y, a4.z, a4.w}, rx[4] = {r4.x, r4.y, r4.z, r4.w};
      float ss = kk[0] * kk[0] + kk[1] * kk[1] + kk[2] * kk[2] + kk[3] * kk[3];
      float bn = rx[0] * kx[0] * rkc[0] + rx[1] * kx[1] * rkc[1] + rx[2] * kx[2] * rkc[2] + rx[3] * kx[3] * rkc[3];
#pragma unroll
      for (int m = 1; m <= 8; m <<= 1) { ss += __shfl_xor(ss, m); bn += __shfl_xor(bn, m); }
      float inv = 1.f / fmaxf(sqrtf(ss), 1e-12f);
      float nk[4], ka[4], kd[4];
#pragma unroll
      for (int e = 0; e < 4; ++e) {
        float k1 = kk[e] * inv;
        nk[e] = -k1;
        ka[e] = k1 * ax[e];
        kd[e] = kx[e] * (1.f + (ax[e] - 1.f) * kac[e]);
      }
      *(float4*)(NKK + tau_a * 64 + 4 * c4) = make_float4(nk[0], nk[1], nk[2], nk[3]);
      *(float4*)(KKA + tau_a * 64 + 4 * c4) = make_float4(ka[0], ka[1], ka[2], ka[3]);
      *(float4*)(KP + tau_a * 64 + 4 * c4) = make_float4(kd[0], kd[1], kd[2], kd[3]);
      if (c4 == 0) BON[tau_a] = bn;
    }
    __syncthreads();
    {
#pragma unroll 2
      for (int s = 0; s < 16; ++s) {
        const int tau = d ? 15 - s : s;
        const int o = tau * 64 + 16 * jq;
        float wv[16], nk[16], ka[16], kd[16], rv[16];
#pragma unroll
        for (int i = 0; i < 4; ++i) {
          float4 a = *(const float4*)(W + o + 4 * i);   wv[4 * i] = a.x; wv[4 * i + 1] = a.y; wv[4 * i + 2] = a.z; wv[4 * i + 3] = a.w;
          float4 b = *(const float4*)(NKK + o + 4 * i); nk[4 * i] = b.x; nk[4 * i + 1] = b.y; nk[4 * i + 2] = b.z; nk[4 * i + 3] = b.w;
          float4 c = *(const float4*)(KKA + o + 4 * i); ka[4 * i] = c.x; ka[4 * i + 1] = c.y; ka[4 * i + 2] = c.z; ka[4 * i + 3] = c.w;
          float4 e = *(const float4*)(KP + o + 4 * i);  kd[4 * i] = e.x; kd[4 * i + 1] = e.y; kd[4 * i + 2] = e.z; kd[4 * i + 3] = e.w;
          float4 f = *(const float4*)(R + o + 4 * i);   rv[4 * i] = f.x; rv[4 * i + 1] = f.y; rv[4 * i + 2] = f.z; rv[4 * i + 3] = f.w;
        }
        const float vi = V[tau * 64 + irow];
        float sa = 0.f;
#pragma unroll
        for (int j = 0; j < 16; ++j) sa += S[j] * nk[j];
        sa += dpp_xor1(sa);
        sa += dpp_xor2(sa);
        float y = 0.f;
#pragma unroll
        for (int j = 0; j < 16; ++j) {
          S[j] = S[j] * wv[j] + (sa * ka[j] + vi * kd[j]);
          y += S[j] * rv[j];
        }
        y += dpp_xor1(y);
        y += dpp_xor2(y);
        if (jq == 0) YO[tau * 64 + irow] = y;
      }
    }
    __syncthreads();
    {
      float4 y4 = *(const float4*)(YO + tau_a * 64 + 4 * c4);
      float yv[4] = {y4.x, y4.y, y4.z, y4.w};
      u16* yp = RY + (tb + tau_a) * 512 + 64 * head + 4 * c4;
      if (ci < (NC >> 1)) {
        *(uint2*)yp = make_uint2(pack2(yv[0], yv[1]), pack2(yv[2], yv[3]));
        __threadfence_block();
      } else {
        u64 st = __hip_atomic_load((u64*)yp, __ATOMIC_RELAXED, __HIP_MEMORY_SCOPE_AGENT);
        u32 s0 = (u32)st, s1 = (u32)(st >> 32);
        yv[0] += bflo(s0); yv[1] += bfhi(s0); yv[2] += bflo(s1); yv[3] += bfhi(s1);
        float sm1 = yv[0] + yv[1] + yv[2] + yv[3];
#pragma unroll
        for (int m = 1; m <= 8; m <<= 1) sm1 += __shfl_xor(sm1, m);
        float mean = sm1 * (1.f / 64.f);
        float vs = 0.f;
#pragma unroll
        for (int e = 0; e < 4; ++e) { float dd = yv[e] - mean; vs += dd * dd; }
#pragma unroll
        for (int m = 1; m <= 8; m <<= 1) vs += __shfl_xor(vs, m);
        float rstd = rsqrtf(vs * (1.f / 64.f) + 64e-5f);
        float4 v4 = *(const float4*)(V + tau_a * 64 + 4 * c4);
        float4 g4 = *(const float4*)(G + tau_a * 64 + 4 * c4);
        float vv[4] = {v4.x, v4.y, v4.z, v4.w}, gg[4] = {g4.x, g4.y, g4.z, g4.w};
        float bn = BON[tau_a];
        float o[4];
#pragma unroll
        for (int e = 0; e < 4; ++e) o[e] = ((yv[e] - mean) * rstd * lnw[e] + lnb[e] + bn * vv[e]) * gg[e];
        *(uint2*)yp = make_uint2(pack2(o[0], o[1]), pack2(o[2], o[3]));
      }
    }
    __syncthreads();
  }
}

#define N_ATT_ITEMS 1024
#define N_S5_ITEMS 2048
__device__ void phase_mixer1(const Params& p, int layer, char* smem) {
#ifndef NO_RW
  for (int pr = blockIdx.x; pr < 192; pr += gridDim.x) rwkv_pair(p, layer, pr, smem);
#endif
  int* ctr = (int*)(p.ws + OFF_CTR) + layer;
  int* sitem = (int*)(smem + MISC_OFF + 2048);
  const int w = tid_() >> 6;
  while (true) {
    __syncthreads();
    if (tid_() == 0) *sitem = atomicAdd(ctr, 1);
    __syncthreads();
    int it = *sitem;
    if (it >= N_ATT_ITEMS + N_S5_ITEMS) break;
    if (it < N_ATT_ITEMS) {
#ifndef NO_ATT
      attn_item(p, layer, it, smem);
#endif
    } else {
#ifndef NO_S5
      s5_unit<false>(p, layer, (it - N_ATT_ITEMS) * 8 + w, smem + w * 12544);
#endif
    }
  }
}

__device__ void phase_s5p2(const Params& p, int layer, char* smem) {
  const int w = tid_() >> 6;
  for (int it = blockIdx.x; it < N_S5_ITEMS; it += gridDim.x) s5_unit<true>(p, layer, it * 8 + w, smem + w * 12544);
}

__global__ void __launch_bounds__(NTHREADS) mega(Params p, int ph_lo, int ph_hi) {
  extern __shared__ __attribute__((aligned(16))) char smem[];
  cg::grid_group grid = cg::this_grid();
  for (int ph = ph_lo; ph < ph_hi; ++ph) {
    const int layer = ph / 12, sp = ph - layer * 12;
#ifndef ONLY_PH
#define PH_ON(x) 1
#else
#define PH_ON(x) ((x) == ONLY_PH)
#endif
    switch (sp) {
      case 0:
        if (!PH_ON(0)) break;
        if (blockIdx.x == 0 && tid_() == 0) ((int*)(p.ws + OFF_CTR))[layer] = 0;
        phase_norm(p, layer == 0, p.in[2] + layer * 1024);
        conv_ffn(p, layer, 0, smem);
        break;
      case 1: if (PH_ON(1)) phase_ffn_a(p, smem); break;
      case 2:
        if (!PH_ON(2)) break;
        phase_ffn_b(p, layer == 0, smem);
        conv_mix(p, layer, smem);
        break;
      case 3: if (PH_ON(3)) phase_proj(p, smem); break;
      case 4: if (PH_ON(4)) phase_mixer1(p, layer, smem); break;
      case 5: if (PH_ON(5)) phase_s5p2(p, layer, smem); break;
      case 6: if (PH_ON(6)) phase_glu(p, smem); break;
      case 7: if (PH_ON(7)) phase_m(p, smem); break;
      case 8:
        if (!PH_ON(8)) break;
        phase_out(p, smem);
        conv_ffn(p, layer, 1, smem);
        break;
      case 9: if (PH_ON(9)) phase_norm(p, false, p.in[33] + layer * 1024); break;
      case 10: if (PH_ON(10)) phase_ffn_a(p, smem); break;
      case 11: if (PH_ON(11)) phase_ffn_b(p, false, smem); break;
    }
    if (ph + 1 < ph_hi) grid.sync();
  }
}

extern "C" void kernel_launch(void* const* d_in, const int* in_sizes, int n_in, void* d_out, int out_size, void* d_ws,
                              size_t ws_size, hipStream_t stream) {
  static int grid_blocks = 0;
  if (!grid_blocks) {
    int dev = 0, cus = 0, per_cu = 0;
    hipGetDevice(&dev);
    hipDeviceGetAttribute(&cus, hipDeviceAttributeMultiprocessorCount, dev);
    hipFuncSetAttribute((const void*)mega, hipFuncAttributeMaxDynamicSharedMemorySize, SMEM_BYTES);
    hipOccupancyMaxActiveBlocksPerMultiprocessor(&per_cu, mega, NTHREADS, SMEM_BYTES);
    if (per_cu < 1) per_cu = 1;
    grid_blocks = cus * per_cu;
  }
  if (ws_size < (size_t)WS_NEED) {
    fprintf(stderr, "workspace too small: %zu\n", ws_size);
    return;
  }
  Params p{};
  for (int i = 0; i < 37; ++i) p.in[i] = (const float*)d_in[i];
  p.out = (float*)d_out;
  p.ws = (char*)d_ws;
#ifndef ONE_LAUNCH
  for (int ph = 0; ph < 24; ++ph) {
    hipLaunchKernelGGL(mega, dim3(grid_blocks), dim3(NTHREADS), SMEM_BYTES, stream, p, ph, ph + 1);
  }
#else
  int lo = 0, hi = 24;
  void* args[] = {&p, &lo, &hi};
  hipError_t e = hipLaunchCooperativeKernel((const void*)mega, dim3(grid_blocks), dim3(NTHREADS), args, SMEM_BYTES, stream);
  if (e != hipSuccess) fprintf(stderr, "cooperative launch failed: %s (grid %d)\n", hipGetErrorString(e), grid_blocks);
#endif
}
```

```cpp
#include <hip/hip_runtime.h>
#include <hip/hip_cooperative_groups.h>
#include <cstdio>
namespace cg = cooperative_groups;

typedef unsigned short u16;
typedef unsigned int u32;
typedef unsigned long long u64;
typedef __attribute__((ext_vector_type(8))) short bf16x8;
typedef __attribute__((ext_vector_type(16))) float f32x16;
typedef __attribute__((ext_vector_type(4))) float f32x4;
typedef __bf16 bf2_t __attribute__((ext_vector_type(2)));
typedef float f2_t __attribute__((ext_vector_type(2)));

#define ONE_LAUNCH 1
#define NTOK 65536
#define NTHREADS 512
#define SMEM_BYTES 135168
#define AS_BYTES 36864
#define BS_BYTES 18432
#define MISC_OFF 110592

#define OFF_A 0L
#define OFF_Z 167772160L
#define OFF_Y 419430400L
#define OFF_H 0L
#define OFF_HN2 0L
#define OFF_M 134217728L
#define OFF_YA 268435456L
#define OFF_YB 335544320L
#define OFF_SCR0 402653184L
#define OFF_F 369098752L
#define OFF_FD (OFF_F + 11534336L)
#define OFF_HN 386400256L
#define OFF_WM 486539264L
#define OFF_WIN OFF_WM
#define OFF_WGLU (OFF_WM + 12845056L)
#define OFF_WB (OFF_WGLU + 524288L)
#define OFF_WOUT (OFF_WB + 3145728L)
#define OFF_CAR 505151488L
#define OFF_CTR 521928704L
#define OFF_BAR 521936896L
#define WS_NEED 521952256L

struct Params {
  const float* in[37];
  float* out;
  char* ws;
};

__device__ __forceinline__ int tid_() {
  int t = threadIdx.x;
  asm volatile("" : "+v"(t));
  return t;
}
__device__ __forceinline__ u32 pack2(float a, float b) {
  f2_t v = {a, b};
  bf2_t r = __builtin_convertvector(v, bf2_t);
  return *(u32*)&r;
}
__device__ __forceinline__ u16 f2bf(float a) { return (u16)(pack2(a, 0.f) & 0xffffu); }
__device__ __forceinline__ float bflo(u32 v) { return __uint_as_float(v << 16); }
__device__ __forceinline__ float bfhi(u32 v) { return __uint_as_float(v & 0xffff0000u); }
__device__ __forceinline__ float sigm(float x) { return 1.f / (1.f + __expf(-x)); }
__device__ __forceinline__ float dpp_xor1(float v) {
  return __int_as_float(__builtin_amdgcn_mov_dpp(__float_as_int(v), 0xB1, 0xF, 0xF, true));
}
__device__ __forceinline__ float frcp(float x) { return __builtin_amdgcn_rcpf(x); }
__device__ __forceinline__ float fsig(float x) { return __builtin_amdgcn_rcpf(1.f + __expf(-x)); }
__device__ __forceinline__ float dpp_ror1(float v) {
  return __int_as_float(__builtin_amdgcn_mov_dpp(__float_as_int(v), 0x121, 0xF, 0xF, true));
}
__device__ __forceinline__ float dpp_ror2(float v) {
  return __int_as_float(__builtin_amdgcn_mov_dpp(__float_as_int(v), 0x122, 0xF, 0xF, true));
}
__device__ __forceinline__ float dpp_ror4(float v) {
  return __int_as_float(__builtin_amdgcn_mov_dpp(__float_as_int(v), 0x124, 0xF, 0xF, true));
}
__device__ __forceinline__ float dpp_ror8(float v) {
  return __int_as_float(__builtin_amdgcn_mov_dpp(__float_as_int(v), 0x128, 0xF, 0xF, true));
}
__device__ __forceinline__ float dpp_xor2(float v) {
  return __int_as_float(__builtin_amdgcn_mov_dpp(__float_as_int(v), 0x4E, 0xF, 0xF, true));
}

namespace pg8 {
#define PG8_LAS __attribute__((address_space(3)))
typedef unsigned short bf16_t;
typedef short bf16x8 __attribute__((ext_vector_type(8)));
typedef float f32x4 __attribute__((ext_vector_type(4)));
typedef unsigned u32x4 __attribute__((ext_vector_type(4)));
constexpr int BM = 256, BK = 64, HALF = 128, HTB = HALF * BK * 2  , STAGE_BYTES = 8 * HTB, NXCD = 8, WGM = 8;

__host__ __device__ __forceinline__ int lds_byte(int r, int c) { const int st = (r >> 4) * 2 + (c >> 5), rr = r & 15, cc = c & 31, ob = rr * 64 + cc * 2; return st * 1024 + (ob ^ (((ob >> 9) & 1) << 5)); }
__host__ __device__ __forceinline__ void stage_rc(int b, int& R, int& C) { const int st = b / 1024, sb = b % 1024, swz = sb ^ (((sb >> 9) & 1) << 5); R = (st >> 1) * 16 + swz / 64; C = (st & 1) * 32 + (swz % 64) / 2; }
__host__ __device__ __forceinline__ int perm32(int rho) { const int n = rho >> 4, i = rho & 15; return 8 * (i >> 2) + 4 * n + (i & 3); }
struct Unit { int pm, pn; };
struct Gemm { const bf16_t* A; const bf16_t* Bt; int M, N, K, lda, ldb; };
struct StaticOrder {
    int nM, nN, nwg, G, c;
    __host__ __device__ void init(int M, int N, int G_, int c_) { nM = M / BM; nN = N / BM; nwg = nM * nN; G = G_; c = c_; }
    __host__ __device__ bool next(int i, Unit& u) const {
        const long L = (long)i * G + c; if (L >= nwg) return false;
        int wgid = (int)L; { const int q = nwg / NXCD, r = nwg % NXCD, xcd = wgid % NXCD, off = wgid / NXCD; wgid = (xcd < r ? xcd * (q + 1) : r * (q + 1) + (xcd - r) * q) + off; }
        const int nig = WGM * nN, gid = wgid / nig, fm = gid * WGM, gsz = (nM - fm) < WGM ? (nM - fm) : WGM;
        u.pm = fm + ((wgid % nig) % gsz); u.pn = (wgid % nig) / gsz; return true;
    }
    __device__ __forceinline__ void a_ready(const Unit&) const {}
    __device__ __forceinline__ void done(const Unit&) const {}
};
template <class Epi, class Sched, bool STAMP = false>
__device__ __forceinline__ void gemm_phase(PG8_LAS unsigned char* lds, const Gemm g, const Sched& S, const Epi& E, unsigned long long* stamps) {
    const int tid = tid_(), wid = __builtin_amdgcn_readfirstlane(tid >> 6), lane = tid & 63, wr = wid >> 2, wc = wid & 3, fr = lane & 15, fq = lane >> 4;
    const int K = g.K, nt = K / BK;
    int ts_lo = 0, ts_hi = 0, nts = 0; const unsigned long long rt_entry = STAMP ? 0ull : 0ull;
#define PG8_STAMP() do { if (STAMP && wid == 0 && nts < 64) { const unsigned long long _c = (unsigned long long)clock64(); \
        ts_lo = (lane == nts) ? (int)(unsigned)_c : ts_lo; ts_hi = (lane == nts) ? (int)(unsigned)(_c >> 32) : ts_hi; ++nts; } } while (0)
    PG8_STAMP();
    unsigned voffA[2], voffB[2];
#pragma unroll
    for (int i = 0; i < 2; ++i) { int R, C; stage_rc(tid * 16 + i * 8192, R, C); const int Rb = Epi::PERM ? ((R & ~31) + perm32(R & 31)) : R;
        voffA[i] = (unsigned)(R * g.lda + C) * 2u; voffB[i] = (unsigned)(Rb * g.ldb + C) * 2u; }
    const size_t kstep = (size_t)(BK * 2);
    const size_t hstepA = (size_t)HALF * g.lda * 2, hstepB = (size_t)HALF * g.ldb * 2;
    const size_t tstepA = 2 * hstepA, tstepB = 2 * hstepB;
    const unsigned ldsw = (unsigned)wid * 1024u;
    const int aoff = lds_byte(wr * 64 + fr, fq * 8), boff = lds_byte(wc * 32 + fr, fq * 8);
#define PG8_SA(b, h) (((b) * 2 + (h)) * HTB)
#define PG8_SB(b, h) ((4 + (b) * 2 + (h)) * HTB)
#define PG8_STAGE(bufoff, gbase, voff) do { _Pragma("unroll") for (int _i = 0; _i < 2; ++_i) \
        __builtin_amdgcn_global_load_lds((const unsigned*)((const char*)(gbase) + (voff)[_i]), (PG8_LAS unsigned*)(lds + (bufoff) + ldsw + _i * 8192), 16, 0, 0); } while (0)
#define PG8_LDA(dst, b, h) do { _Pragma("unroll") for (int m = 0; m < 4; ++m) _Pragma("unroll") for (int k = 0; k < 2; ++k) dst[m][k] = *(const PG8_LAS bf16x8*)(lds + PG8_SA(b, h) + aoff + m * 2048 + k * 1024); } while (0)
#define PG8_LDB(dst, b, h) do { _Pragma("unroll") for (int n = 0; n < 2; ++n) _Pragma("unroll") for (int k = 0; k < 2; ++k) dst[n][k] = *(const PG8_LAS bf16x8*)(lds + PG8_SB(b, h) + boff + n * 2048 + k * 1024); } while (0)
#define PG8_MMA(ai, bj, At, Bt) do { __builtin_amdgcn_s_setprio(1); _Pragma("unroll") for (int m = 0; m < 4; ++m) _Pragma("unroll") for (int n = 0; n < 2; ++n) _Pragma("unroll") for (int k = 0; k < 2; ++k) \
        acc[ai][bj][m][n] = __builtin_amdgcn_mfma_f32_16x16x32_bf16(Bt[n][k], At[m][k], acc[ai][bj][m][n], 0, 0, 0); __builtin_amdgcn_s_setprio(0); } while (0)
#define PG8_WAIT_V(n) asm volatile("s_waitcnt vmcnt(" #n ")" ::: "memory")
#define PG8_WAIT_L(n) asm volatile("s_waitcnt lgkmcnt(" #n ")" ::: "memory")
#define PG8_BAR __builtin_amdgcn_s_barrier()
#define PG8_SCHED __builtin_amdgcn_sched_barrier(0)
    Unit cur, nxt; int ui = 0;
    if (!S.next(0, cur)) return;
    f32x4 acc[2][2][4][2];
#pragma unroll
    for (int a = 0; a < 2; ++a)
#pragma unroll
        for (int b = 0; b < 2; ++b)
#pragma unroll
            for (int m = 0; m < 4; ++m)
#pragma unroll
                for (int n = 0; n < 2; ++n) acc[a][b][m][n] = (f32x4){0.f, 0.f, 0.f, 0.f};
    bf16x8 At[4][2], B0[2][2], B1[2][2];
    const char* cA = (const char*)g.A + (size_t)cur.pm * tstepA; const char* cB = (const char*)g.Bt + (size_t)cur.pn * tstepB;
    S.a_ready(cur);
    PG8_STAGE(PG8_SB(0, 0), cB, voffB); PG8_STAGE(PG8_SA(0, 0), cA, voffA); PG8_STAGE(PG8_SB(0, 1), cB + hstepB, voffB); PG8_STAGE(PG8_SA(0, 1), cA + hstepA, voffA);
    if (wr == 1) PG8_BAR;
    PG8_WAIT_V(4); PG8_BAR;
    PG8_STAGE(PG8_SB(1, 0), cB + kstep, voffB); PG8_STAGE(PG8_SA(1, 0), cA + kstep, voffA); PG8_STAGE(PG8_SB(1, 1), cB + hstepB + kstep, voffB);
    PG8_WAIT_V(6); PG8_BAR;
    PG8_STAMP();
    for (;;) {
        const bool has_next = S.next(ui + 1, nxt);
        const char* nA = has_next ? (const char*)g.A + (size_t)nxt.pm * tstepA : cA; const char* nB = has_next ? (const char*)g.Bt + (size_t)nxt.pn * tstepB : cB;
        for (int t = 0; t < nt; t += 2) {
            const bool last = (t == nt - 2);
            const char* a1 = cA + (size_t)(t + 1) * kstep;
            const char* a2 = last ? nA : cA + (size_t)(t + 2) * kstep; const char* b2 = last ? nB : cB + (size_t)(t + 2) * kstep;
            const char* a3 = a2 + kstep; const char* b3 = b2 + kstep;
            if (last && has_next) S.a_ready(nxt);
            PG8_LDB(B0, 0, 0); PG8_SCHED; PG8_LDA(At, 0, 0); PG8_STAGE(PG8_SA(1, 1), a1 + hstepA, voffA);
            PG8_WAIT_L(8); PG8_BAR; PG8_WAIT_L(0); PG8_MMA(0, 0, At, B0); PG8_BAR; PG8_SCHED;
            PG8_LDB(B1, 0, 1); PG8_STAGE(PG8_SB(0, 0), b2, voffB);
            PG8_BAR; PG8_WAIT_L(0); PG8_MMA(0, 1, At, B1); PG8_BAR;
            PG8_LDA(At, 0, 1); PG8_STAGE(PG8_SA(0, 0), a2, voffA);
            PG8_BAR; PG8_WAIT_L(0); PG8_MMA(1, 0, At, B0); PG8_BAR; PG8_SCHED;
            PG8_STAGE(PG8_SB(0, 1), b2 + hstepB, voffB);
            PG8_WAIT_V(6); PG8_BAR; PG8_MMA(1, 1, At, B1); PG8_BAR;
            PG8_LDB(B0, 1, 0); PG8_SCHED; PG8_LDA(At, 1, 0); PG8_STAGE(PG8_SA(0, 1), a2 + hstepA, voffA);
            PG8_WAIT_L(8); PG8_BAR; PG8_WAIT_L(0); PG8_MMA(0, 0, At, B0); PG8_BAR; PG8_SCHED;
            PG8_LDB(B1, 1, 1); PG8_STAGE(PG8_SB(1, 0), b3, voffB);
            PG8_BAR; PG8_WAIT_L(0); PG8_MMA(0, 1, At, B1); PG8_BAR;
            PG8_LDA(At, 1, 1); PG8_STAGE(PG8_SA(1, 0), a3, voffA);
            PG8_BAR; PG8_WAIT_L(0); PG8_MMA(1, 0, At, B0); PG8_BAR; PG8_SCHED;
            PG8_STAGE(PG8_SB(1, 1), b3 + hstepB, voffB);
            PG8_WAIT_V(6); PG8_BAR; PG8_MMA(1, 1, At, B1); PG8_BAR;
        }
        PG8_STAMP();
        if constexpr (!Epi::AFTER_DRAIN) { E(acc, cur, wr, wc, fr, fq); S.done(cur); }
        PG8_STAMP();
        if (!has_next) break;
#pragma unroll
        for (int a = 0; a < 2; ++a)
#pragma unroll
            for (int b = 0; b < 2; ++b)
#pragma unroll
                for (int m = 0; m < 4; ++m)
#pragma unroll
                    for (int n = 0; n < 2; ++n) acc[a][b][m][n] = (f32x4){0.f, 0.f, 0.f, 0.f};
        cur = nxt; cA = nA; cB = nB; ++ui;
    }
    PG8_WAIT_V(0);
    if (wr == 0) PG8_BAR;
    PG8_BAR;
    if constexpr (Epi::AFTER_DRAIN) { E.fused(acc, cur, wr, wc, fr, fq, lds, wid, lane); S.done(cur); }
    PG8_STAMP();
    if (STAMP && wid == 0) { stamps[lane] = lane < nts ? (((unsigned long long)(unsigned)ts_hi << 32) | (unsigned)ts_lo) : 0ull;
        if (lane == 62) stamps[62] = rt_entry; if (lane == 63) stamps[63] = 0ull; }
#undef PG8_STAMP
#undef PG8_SA
#undef PG8_SB
#undef PG8_STAGE
#undef PG8_LDA
#undef PG8_LDB
#undef PG8_MMA
#undef PG8_WAIT_V
#undef PG8_WAIT_L
#undef PG8_BAR
#undef PG8_SCHED
}
}

struct EpiSwiglu {
  static constexpr bool PERM = true, AFTER_DRAIN = false;
  u16* H;
  __device__ __forceinline__ void operator()(const pg8::f32x4 (&acc)[2][2][4][2], const pg8::Unit& u, int wr, int wc, int fr,
                                             int fq) const {
    const int row0 = u.pm * 256 + wr * 64 + fr, col0 = u.pn * 128 + wc * 32 + 8 * fq;
#pragma unroll
    for (int ai = 0; ai < 2; ++ai)
#pragma unroll
      for (int m = 0; m < 4; ++m) {
        u16* rowp = H + (size_t)(row0 + ai * 128 + m * 16) * 2816 + col0;
        float v[8];
#pragma unroll
        for (int n = 0; n < 2; ++n)
#pragma unroll
          for (int j = 0; j < 4; ++j) {
            float g = acc[ai][0][m][n][j], uu = acc[ai][1][m][n][j];
            v[4 * n + j] = g * fsig(g) * uu;
          }
        uint4 o;
        o.x = pack2(v[0], v[1]); o.y = pack2(v[2], v[3]); o.z = pack2(v[4], v[5]); o.w = pack2(v[6], v[7]);
        *(uint4*)rowp = o;
      }
  }
};
struct EpiRes {
  static constexpr bool PERM = false, AFTER_DRAIN = false;
  float* out; const float* r0; const float* r1; float scale;
  __device__ __forceinline__ void operator()(const pg8::f32x4 (&acc)[2][2][4][2], const pg8::Unit& u, int wr, int wc, int fr,
                                             int fq) const {
    const int row0 = u.pm * 256 + wr * 64 + fr, col0 = u.pn * 256 + wc * 32 + 4 * fq;
#pragma unroll
    for (int ai = 0; ai < 2; ++ai)
#pragma unroll
      for (int m = 0; m < 4; ++m) {
        const long row = row0 + ai * 128 + m * 16;
        const float* rp = (r1 != nullptr && row >= 32768) ? r1 + (row - 32768) * 1024 : r0 + row * 1024;
        float* op = out + row * 1024;
#pragma unroll
        for (int bj = 0; bj < 2; ++bj)
#pragma unroll
          for (int n = 0; n < 2; ++n) {
            const int c = col0 + bj * 128 + n * 16;
            float4 x = *(const float4*)(rp + c);
            pg8::f32x4 a = acc[ai][bj][m][n];
            float4 o = make_float4(x.x + scale * a[0], x.y + scale * a[1], x.z + scale * a[2], x.w + scale * a[3]);
            *(float4*)(op + c) = o;
          }
      }
  }
};
struct EpiGlu {
  static constexpr bool PERM = true, AFTER_DRAIN = false;
  const u16* RA; u16* YA;
  __device__ __forceinline__ void operator()(const pg8::f32x4 (&acc)[2][2][4][2], const pg8::Unit& u, int wr, int wc, int fr,
                                             int fq) const {
    const int row0 = u.pm * 256 + wr * 64 + fr, col0 = u.pn * 256 + wc * 32 + 8 * fq;
#pragma unroll
    for (int ai = 0; ai < 2; ++ai)
#pragma unroll
      for (int m = 0; m < 4; ++m) {
        const long row = row0 + ai * 128 + m * 16;
#pragma unroll
        for (int bj = 0; bj < 2; ++bj) {
          const int c = col0 + bj * 128;
          uint4 y = *(const uint4*)(RA + row * 1280 + c);
          pg8::f32x4 a0 = acc[ai][bj][m][0], a1 = acc[ai][bj][m][1];
          uint4 o;
          o.x = pack2(bflo(y.x) * fsig(a0[0]), bfhi(y.x) * fsig(a0[1]));
          o.y = pack2(bflo(y.y) * fsig(a0[2]), bfhi(y.y) * fsig(a0[3]));
          o.z = pack2(bflo(y.z) * fsig(a1[0]), bfhi(y.z) * fsig(a1[1]));
          o.w = pack2(bflo(y.w) * fsig(a1[2]), bfhi(y.w) * fsig(a1[3]));
          *(uint4*)(YA + row * 512 + c) = o;
        }
      }
  }
};
struct EpiProj {
  static constexpr bool PERM = true, AFTER_DRAIN = false;
  u16* RA; u16* RZ; int row_off;
  __device__ __forceinline__ void operator()(const pg8::f32x4 (&acc)[2][2][4][2], const pg8::Unit& u, int wr, int wc, int fr,
                                             int fq) const {
    const int row0 = row_off + u.pm * 256 + wr * 64 + fr, col0 = u.pn * 256 + wc * 32 + 8 * fq;
#pragma unroll
    for (int ai = 0; ai < 2; ++ai)
#pragma unroll
      for (int m = 0; m < 4; ++m) {
        const long row = row0 + ai * 128 + m * 16;
#pragma unroll
        for (int bj = 0; bj < 2; ++bj) {
          const int c = col0 + bj * 128;
          if (c >= 3200) continue;
          u16* dst = (c < 1280) ? RA + row * 1280 + c : RZ + row * 1920 + (c - 1280);
          pg8::f32x4 a0 = acc[ai][bj][m][0], a1 = acc[ai][bj][m][1];
          uint4 o;
          o.x = pack2(a0[0], a0[1]); o.y = pack2(a0[2], a0[3]); o.z = pack2(a1[0], a1[1]); o.w = pack2(a1[2], a1[3]);
          *(uint4*)dst = o;
        }
      }
  }
};
struct EpiGate {
  static constexpr bool PERM = true, AFTER_DRAIN = false;
  uint4* scr;
  __device__ __forceinline__ void operator()(const pg8::f32x4 (&acc)[2][2][4][2], const pg8::Unit& u, int wr, int wc, int fr,
                                             int fq) const {
    const int t = (wr * 4 + wc) * 64 + fq * 16 + fr;
#pragma unroll
    for (int ai = 0; ai < 2; ++ai)
#pragma unroll
      for (int m = 0; m < 4; ++m)
#pragma unroll
        for (int bj = 0; bj < 2; ++bj) {
          pg8::f32x4 a0 = acc[ai][bj][m][0], a1 = acc[ai][bj][m][1];
          uint4 o;
          o.x = pack2(fsig(a0[0]), fsig(a0[1])); o.y = pack2(fsig(a0[2]), fsig(a0[3]));
          o.z = pack2(fsig(a1[0]), fsig(a1[1])); o.w = pack2(fsig(a1[2]), fsig(a1[3]));
          scr[((ai * 4 + m) * 2 + bj) * 512 + t] = o;
        }
  }
};
struct EpiUp {
  static constexpr bool PERM = true, AFTER_DRAIN = false;
  const uint4* scr; u16* Mo; bool first;
  __device__ __forceinline__ void operator()(const pg8::f32x4 (&acc)[2][2][4][2], const pg8::Unit& u, int wr, int wc, int fr,
                                             int fq) const {
    const int t = (wr * 4 + wc) * 64 + fq * 16 + fr;
    const int row0 = u.pm * 256 + wr * 64 + fr, col0 = u.pn * 256 + wc * 32 + 8 * fq;
#pragma unroll
    for (int ai = 0; ai < 2; ++ai)
#pragma unroll
      for (int m = 0; m < 4; ++m) {
        const long row = row0 + ai * 128 + m * 16;
#pragma unroll
        for (int bj = 0; bj < 2; ++bj) {
          uint4 g = scr[((ai * 4 + m) * 2 + bj) * 512 + t];
          pg8::f32x4 a0 = acc[ai][bj][m][0], a1 = acc[ai][bj][m][1];
          float v[8] = {bflo(g.x) * a0[0], bfhi(g.x) * a0[1], bflo(g.y) * a0[2], bfhi(g.y) * a0[3],
                        bflo(g.z) * a1[0], bfhi(g.z) * a1[1], bflo(g.w) * a1[2], bfhi(g.w) * a1[3]};
          u16* mp = Mo + row * 1024 + col0 + bj * 128;
          if (!first) {
            uint4 o = *(const uint4*)mp;
            v[0] += bflo(o.x); v[1] += bfhi(o.x); v[2] += bflo(o.y); v[3] += bfhi(o.y);
            v[4] += bflo(o.z); v[5] += bfhi(o.z); v[6] += bflo(o.w); v[7] += bfhi(o.w);
          }
          uint4 w;
          w.x = pack2(v[0], v[1]); w.y = pack2(v[2], v[3]); w.z = pack2(v[4], v[5]); w.w = pack2(v[6], v[7]);
          *(uint4*)mp = w;
        }
      }
  }
};
struct OneUnit {
  int pm, pn;
  __device__ __forceinline__ bool next(int i, pg8::Unit& u) const { if (i) return false; u.pm = pm; u.pn = pn; return true; }
  __device__ __forceinline__ void a_ready(const pg8::Unit&) const {}
  __device__ __forceinline__ void done(const pg8::Unit&) const {}
};
template <class Epi>
__device__ __forceinline__ void run_gemm8(char* smem, const u16* A, const u16* Bt, int N, int K, int lda, int ldb, const Epi& E,
                                          int M = NTOK) {
  pg8::Gemm g{A, Bt, M, N, K, lda, ldb};
  pg8::StaticOrder S;
  S.init(M, N, (int)gridDim.x, (int)blockIdx.x);
  pg8::gemm_phase<Epi, pg8::StaticOrder, false>((PG8_LAS unsigned char*)smem, g, S, E, nullptr);
}

__device__ __forceinline__ float row16_sum(float v) {
  v += dpp_ror1(v);
  v += dpp_ror2(v);
  v += dpp_ror4(v);
  v += dpp_ror8(v);
  return v;
}
template <bool AF32, int NI>
__device__ __forceinline__ void gemm_loop(const void* Aptr, long lda, const u16* Bt, long ldb, int K,
                                          f32x16 (&acc)[2][NI], float& ss, char* smem) {
  const int tid = tid_(), lane = tid & 63, w = tid >> 6;
  const int wm = w >> 1, wn = w & 1, lr = lane & 31, lh = lane >> 5;
  const int arow = tid >> 1, ahalf = tid & 1;
  const int brow = (NI == 2) ? (tid >> 2) : (tid >> 3), bq = (NI == 2) ? (tid & 3) : (tid & 7);
  const int nk = K >> 6;
  float4 raf[8];
  uint4 rab[4];
  uint4 rb[2];
  const float* Af = (const float*)Aptr + (long)arow * lda + 32 * ahalf;
  const u16* Ab = (const u16*)Aptr + (long)arow * lda + 32 * ahalf;
  const u16* Bp = Bt + (long)brow * ldb + 8 * NI * bq;
  char* a_dst = smem + arow * 144 + ahalf * 64;
  char* b_dst = smem + AS_BYTES + brow * 144 + bq * 16 * NI;
  const char* a_src = smem + (wm * 64 + lr) * 144 + lh * 16;
  const char* b_src = smem + AS_BYTES + (wn * 32 * NI + lr) * 144 + lh * 16;

#define G_LOAD(kt)                                                                       \
  {                                                                                      \
    if (AF32) {                                                                          \
      _Pragma("unroll") for (int i = 0; i < 8; ++i) raf[i] = *(const float4*)(Af + (kt) * 64 + 4 * i); \
    } else {                                                                             \
      _Pragma("unroll") for (int i = 0; i < 4; ++i) rab[i] = *(const uint4*)(Ab + (kt) * 64 + 8 * i); \
    }                                                                                    \
    rb[0] = *(const uint4*)(Bp + (kt) * 64);                                             \
    if (NI == 2) rb[1] = *(const uint4*)(Bp + (kt) * 64 + 8);                            \
  }
#define G_STORE(buf)                                                                     \
  {                                                                                      \
    char* ad = a_dst + (buf) * (AS_BYTES + BS_BYTES);                                    \
    char* bd = b_dst + (buf) * (AS_BYTES + BS_BYTES);                                    \
    if (AF32) {                                                                          \
      _Pragma("unroll") for (int i = 0; i < 4; ++i) {                                    \
        float4 x0 = raf[2 * i], x1 = raf[2 * i + 1];                                     \
        ss += x0.x * x0.x + x0.y * x0.y + x0.z * x0.z + x0.w * x0.w;                     \
        ss += x1.x * x1.x + x1.y * x1.y + x1.z * x1.z + x1.w * x1.w;                     \
        uint4 o;                                                                         \
        o.x = pack2(x0.x, x0.y); o.y = pack2(x0.z, x0.w);                                \
        o.z = pack2(x1.x, x1.y); o.w = pack2(x1.z, x1.w);                                \
        *(uint4*)(ad + 16 * i) = o;                                                      \
      }                                                                                  \
    } else {                                                                             \
      _Pragma("unroll") for (int i = 0; i < 4; ++i) *(uint4*)(ad + 16 * i) = rab[i];     \
    }                                                                                    \
    *(uint4*)(bd) = rb[0];                                                               \
    if (NI == 2) *(uint4*)(bd + 16) = rb[1];                                             \
  }

  G_LOAD(0);
  G_STORE(0);
  __syncthreads();
  for (int kt = 0; kt < nk; ++kt) {
    const int buf = kt & 1;
    if (kt + 1 < nk) G_LOAD(kt + 1);
    const char* as = a_src + buf * (AS_BYTES + BS_BYTES);
    const char* bs = b_src + buf * (AS_BYTES + BS_BYTES);
#pragma unroll
    for (int kk = 0; kk < 4; ++kk) {
      bf16x8 a0 = *(const bf16x8*)(as + kk * 32);
      bf16x8 a1 = *(const bf16x8*)(as + 32 * 144 + kk * 32);
      bf16x8 b0 = *(const bf16x8*)(bs + kk * 32);
      acc[0][0] = __builtin_amdgcn_mfma_f32_32x32x16_bf16(a0, b0, acc[0][0], 0, 0, 0);
      acc[1][0] = __builtin_amdgcn_mfma_f32_32x32x16_bf16(a1, b0, acc[1][0], 0, 0, 0);
      if (NI == 2) {
        bf16x8 b1 = *(const bf16x8*)(bs + 32 * 144 + kk * 32);
        acc[0][NI - 1] = __builtin_amdgcn_mfma_f32_32x32x16_bf16(a0, b1, acc[0][NI - 1], 0, 0, 0);
        acc[1][NI - 1] = __builtin_amdgcn_mfma_f32_32x32x16_bf16(a1, b1, acc[1][NI - 1], 0, 0, 0);
      }
    }
    if (kt + 1 < nk) G_STORE(buf ^ 1);
    __syncthreads();
  }
#undef G_LOAD
#undef G_STORE
}

template <int NI>
__device__ __forceinline__ void zero_acc(f32x16 (&acc)[2][NI]) {
#pragma unroll
  for (int i = 0; i < 2; ++i)
#pragma unroll
    for (int j = 0; j < NI; ++j)
#pragma unroll
      for (int r = 0; r < 16; ++r) acc[i][j][r] = 0.f;
}

__device__ __forceinline__ void publish_rstd(float ss, char* smem) {
  float tot = ss + __shfl_xor(ss, 1);
  float* rs = (float*)(smem + MISC_OFF);
  if ((tid_() & 1) == 0) rs[tid_() >> 1] = rsqrtf(tot * (1.f / 1024.f) + 1e-6f);
  __syncthreads();
}

__device__ __forceinline__ void decode_tile(int id, int NT, int& mt, int& nt) {
  int grp = id / (8 * NT);
  int loc = id - grp * 8 * NT;
  mt = grp * 8 + (loc & 7);
  nt = loc >> 3;
}

__device__ __forceinline__ const float* xin_row(const Params& p, long t) {
  return t < 32768 ? p.in[0] + t * 1024 : p.in[1] + (t - 32768) * 1024;
}

__device__ void conv_tile(const float* src, int N, int K, u16* dst, int rs, int off, int tile, char* smem,
                          const float* gain = nullptr, int sh = 5) {
  const int tid = tid_();
  float* tl = (float*)smem;
  int ntn = N >> 6;
  int kt = tile / ntn, nt = tile - kt * ntn;
  int k0 = kt * 64, n0 = nt * 64;
  __syncthreads();
  {
    int ty = tid >> 6, tx = tid & 63;
#pragma unroll
    for (int i = 0; i < 8; ++i) {
      int k = ty + 8 * i;
      float gv = gain ? gain[k0 + k] : 1.f;
      tl[k * 65 + tx] = src[(long)(k0 + k) * N + n0 + tx] * gv;
    }
  }
  __syncthreads();
  {
    int n = tid >> 3, kq = tid & 7;
    float v[8];
#pragma unroll
    for (int j = 0; j < 8; ++j) v[j] = tl[(8 * kq + j) * 65 + n];
    int nn = n0 + n;
    long drow = (long)(nn >> sh) * rs + (nn & ((1 << sh) - 1)) + off;
    uint4 o;
    o.x = pack2(v[0], v[1]); o.y = pack2(v[2], v[3]); o.z = pack2(v[4], v[5]); o.w = pack2(v[6], v[7]);
    *(uint4*)(dst + drow * K + k0 + 8 * kq) = o;
  }
}

__device__ __forceinline__ void conv_ffn(const Params& p, int layer, int which, char* smem) {
  const float* wg = p.in[which ? 34 : 3] + (long)layer * 1024 * 2816;
  const float* wu = p.in[which ? 35 : 4] + (long)layer * 1024 * 2816;
  const float* wd = p.in[which ? 36 : 5] + (long)layer * 1024 * 2816;
  u16* dgu = (u16*)(p.ws + OFF_F);
  u16* dd = (u16*)(p.ws + OFF_FD);
  for (int j = blockIdx.x; j < 2112; j += gridDim.x) {
    if (j < 704) conv_tile(wg, 2816, 1024, dgu, 256, 0, j, smem, nullptr, 7);
    else if (j < 1408) conv_tile(wu, 2816, 1024, dgu, 256, 128, j - 704, smem, nullptr, 7);
    else conv_tile(wd, 1024, 2816, dd, 32, 0, j - 1408, smem);
  }
}
__device__ __forceinline__ void conv_mix(const Params& p, int layer, char* smem) {
  const float* win = p.in[7] + (long)layer * 1024 * 6272;
  const float* wglu = p.in[16] + (long)layer * 512 * 512;
  const float* wb = p.in[31] + (long)layer * 3 * 512 * 1024;
  const float* wout = p.in[32] + (long)layer * 1024 * 1024;
  for (int j = blockIdx.x; j < 2272; j += gridDim.x) {
    if (j < 1568) conv_tile(win, 6272, 1024, (u16*)(p.ws + OFF_WIN), 32, 0, j, smem);
    else if (j < 1632) conv_tile(wglu, 512, 512, (u16*)(p.ws + OFF_WGLU), 32, 0, j - 1568, smem);
    else if (j < 2016) {
      int jj = j - 1632, i = jj >> 7;
      conv_tile(wb + (long)i * 512 * 1024, 1024, 512, (u16*)(p.ws + OFF_WB) + (long)i * 1024 * 512, 32, 0, jj & 127, smem);
    } else conv_tile(wout, 1024, 1024, (u16*)(p.ws + OFF_WOUT), 32, 0, j - 2016, smem);
  }
}

__device__ __forceinline__ void phase_norm(const Params& p, bool from_in, const float* gain, u16* dst, long row_lo,
                                           long row_hi) {
  const int lane = tid_() & 63, w = tid_() >> 6;
  for (long row = row_lo + (long)blockIdx.x * 8 + w; row < row_hi; row += (long)gridDim.x * 8) {
    const float* src = from_in ? xin_row(p, row) : p.out + row * 1024;
    float4 v[4];
    float ss = 0.f;
#pragma unroll
    for (int i = 0; i < 4; ++i) {
      v[i] = *(const float4*)(src + 4 * (i * 64 + lane));
      ss += v[i].x * v[i].x + v[i].y * v[i].y + v[i].z * v[i].z + v[i].w * v[i].w;
    }
#pragma unroll
    for (int m = 32; m >= 1; m >>= 1) ss += __shfl_xor(ss, m);
    float rstd = rsqrtf(ss * (1.f / 1024.f) + 1e-6f);
#pragma unroll
    for (int i = 0; i < 4; ++i) {
      float4 g = *(const float4*)(gain + 4 * (i * 64 + lane));
      uint2 o;
      o.x = pack2(v[i].x * rstd * g.x, v[i].y * rstd * g.y);
      o.y = pack2(v[i].z * rstd * g.z, v[i].w * rstd * g.w);
      *(uint2*)(dst + (row - row_lo) * 1024 + 4 * (i * 64 + lane)) = o;
    }
  }
}

__device__ __forceinline__ void phase_ffn_a(const Params& p, char* smem) {
  EpiSwiglu E{(u16*)(p.ws + OFF_H)};
  run_gemm8(smem, (const u16*)(p.ws + OFF_HN), (const u16*)(p.ws + OFF_F), 5632, 1024, 1024, 1024, E);
}

__device__ __forceinline__ void phase_ffn_b(const Params& p, bool from_in, char* smem) {
  EpiRes E{p.out, from_in ? p.in[0] : p.out, from_in ? p.in[1] : nullptr, 0.5f};
  run_gemm8(smem, (const u16*)(p.ws + OFF_H), (const u16*)(p.ws + OFF_FD), 1024, 2816, 2816, 2816, E);
}

__device__ __forceinline__ void phase_proj(const Params& p, int half, char* smem) {
  EpiProj E{(u16*)(p.ws + OFF_A), (u16*)(p.ws + OFF_Z), half * 32768};
  run_gemm8(smem, (const u16*)(p.ws + OFF_Y), (const u16*)(p.ws + OFF_WIN), 3328, 1024, 1024, 1024, E, 32768);
}

__device__ __forceinline__ void phase_glu(const Params& p, char* smem) {
  EpiGlu E{(const u16*)(p.ws + OFF_A), (u16*)(p.ws + OFF_YA)};
  run_gemm8(smem, (const u16*)(p.ws + OFF_A), (const u16*)(p.ws + OFF_WGLU), 512, 512, 1280, 512, E);
  const int lane = tid_() & 63, w = tid_() >> 6;
  const u16* RA = (const u16*)(p.ws + OFF_A);
  u16* YB = (u16*)(p.ws + OFF_YB);
  for (long row = (long)blockIdx.x * 8 + w; row < NTOK; row += (long)gridDim.x * 8)
    *(uint4*)(YB + row * 512 + 8 * lane) = *(const uint4*)(RA + row * 1280 + 512 + 8 * lane);
}

__device__ __forceinline__ void phase_m(const Params& p, char* smem) {
  const int b = blockIdx.x;
  uint4* scr = (uint4*)(b < 128 ? p.ws + OFF_SCR0 + (long)b * 131072 : p.ws + OFF_CAR + (long)(b - 128) * 131072);
  const u16* hn2 = (const u16*)(p.ws + OFF_HN2);
  const u16* win = (const u16*)(p.ws + OFF_WIN);
  const u16* wb = (const u16*)(p.ws + OFF_WB);
  u16* Mo = (u16*)(p.ws + OFF_M);
#pragma unroll 1
  for (int u = b; u < 1024; u += gridDim.x) {
    OneUnit S{u & 255, u >> 8};
#pragma unroll 1
    for (int i = 0; i < 3; ++i) {
      {
        pg8::Gemm g{hn2, win + (long)(3200 + 1024 * i) * 1024, NTOK, 1024, 1024, 1024, 1024};
        EpiGate E{scr};
        pg8::gemm_phase<EpiGate, OneUnit, false>((PG8_LAS unsigned char*)smem, g, S, E, nullptr);
      }
      {
        const u16* ya = (const u16*)(p.ws + (i == 0 ? OFF_YA : i == 1 ? OFF_YB : OFF_Y));
        pg8::Gemm g{ya, wb + (long)i * 1024 * 512, NTOK, 1024, 512, 512, 512};
        EpiUp E{(const uint4*)scr, Mo, i == 0};
        pg8::gemm_phase<EpiUp, OneUnit, false>((PG8_LAS unsigned char*)smem, g, S, E, nullptr);
      }
    }
  }
}

__device__ __forceinline__ void phase_out(const Params& p, char* smem) {
  EpiRes E{p.out, p.out, nullptr, 1.0f};
  run_gemm8(smem, (const u16*)(p.ws + OFF_M), (const u16*)(p.ws + OFF_WOUT), 1024, 1024, 1024, 1024, E);
}

#define KS_PITCH 144
#define VT_PITCH 784
__device__ __forceinline__ void attn_item(const Params& p, int layer, int item, char* smem) {
  const int tid = tid_(), lane = tid & 63, w = tid >> 6;
  const int lr = lane & 31, lh = lane >> 5;
  const int qb = item >> 1, kvh = item & 1;
  const long t0 = (long)qb * 128;
  int L, pos0;
  if (t0 < 32768) { L = 2048; pos0 = (int)(t0 & 2047); } else { L = 4096; pos0 = (int)((t0 - 32768) & 4095); }
  u16* RA = (u16*)(p.ws + OFF_A);
  char* Ks = smem;
  char* Vt = smem + 384 * KS_PITCH;
  float* gq = (float*)(smem + MISC_OFF);
  float* gk = gq + 64;
  __syncthreads();
  if (tid < 64) gq[tid] = p.in[17][layer * 64 + tid];
  else if (tid < 128) gk[tid - 64] = p.in[18][layer * 64 + tid - 64];
  __syncthreads();
  {
    const int q4 = tid & 3;
    for (int pass = 0; pass < 3; ++pass) {
      int r = pass * 128 + (tid >> 2);
      int kpos = pos0 - 128 + r;
      bool valid = (kpos >= 0) && (kpos < L);
      float kv[16], vv[16];
      if (valid) {
        const u16* kp = RA + (t0 - 128 + r) * 1280 + 1024 + kvh * 64 + 16 * q4;
        uint4 a = *(const uint4*)kp, b = *(const uint4*)(kp + 8);
        uint4 c = *(const uint4*)(kp + 128), d = *(const uint4*)(kp + 136);
        u32 ka[8] = {a.x, a.y, a.z, a.w, b.x, b.y, b.z, b.w};
        u32 va[8] = {c.x, c.y, c.z, c.w, d.x, d.y, d.z, d.w};
#pragma unroll
        for (int i = 0; i < 8; ++i) {
          kv[2 * i] = bflo(ka[i]); kv[2 * i + 1] = bfhi(ka[i]);
          vv[2 * i] = bflo(va[i]); vv[2 * i + 1] = bfhi(va[i]);
        }
      } else {
#pragma unroll
        for (int i = 0; i < 16; ++i) { kv[i] = 0.f; vv[i] = 0.f; }
      }
      float ss = 0.f;
#pragma unroll
      for (int i = 0; i < 16; ++i) ss += kv[i] * kv[i];
      ss += __shfl_xor(ss, 1);
      ss += __shfl_xor(ss, 2);
      float rstd = rsqrtf(ss * (1.f / 64.f) + 1e-6f);
#pragma unroll
      for (int i = 0; i < 16; ++i) kv[i] = kv[i] * rstd * gk[16 * q4 + i];
      if (q4 == 0) {
#pragma unroll
        for (int i = 0; i < 8; ++i) {
          float invf = __expf(-1.6402954f * (float)i);
          float rev = (float)kpos * invf * 0.15915494f;
          rev -= floorf(rev);
          float cs = __builtin_amdgcn_cosf(rev), sn = __builtin_amdgcn_sinf(rev);
          float t1 = kv[i], t2 = kv[8 + i];
          kv[i] = t1 * cs - t2 * sn;
          kv[8 + i] = t2 * cs + t1 * sn;
        }
      }
      uint4 o0, o1;
      o0.x = pack2(kv[0], kv[1]); o0.y = pack2(kv[2], kv[3]); o0.z = pack2(kv[4], kv[5]); o0.w = pack2(kv[6], kv[7]);
      o1.x = pack2(kv[8], kv[9]); o1.y = pack2(kv[10], kv[11]); o1.z = pack2(kv[12], kv[13]); o1.w = pack2(kv[14], kv[15]);
      *(uint4*)(Ks + r * KS_PITCH + q4 * 32) = o0;
      *(uint4*)(Ks + r * KS_PITCH + q4 * 32 + 16) = o1;
#pragma unroll
      for (int i = 0; i < 16; ++i) *(u16*)(Vt + (16 * q4 + i) * VT_PITCH + r * 2) = f2bf(vv[i]);
    }
  }
  __syncthreads();
  float gqm = 0.f, gkm = 0.f;
  for (int i = 0; i < 64; ++i) { gqm = fmaxf(gqm, fabsf(gq[i])); gkm = fmaxf(gkm, fabsf(gk[i])); }
  const float mb = 8.f * gqm * gkm;
  for (int uu = 0; uu < 2; ++uu) {
    const int u = 2 * w + uu;
    const int hl = u >> 2, qt = u & 3;
    const int head = kvh * 4 + hl;
    const long tq = t0 + 32 * qt + lr;
    const int qpos = pos0 + 32 * qt + lr;
    u16* qrow = RA + tq * 1280 + 512 + head * 64;
    bf16x8 qf[4];
    {
      uint4 qraw[8];
      float ss = 0.f;
#pragma unroll
      for (int i = 0; i < 8; ++i) {
        uint4 a = *(const uint4*)(qrow + 8 * i);
        qraw[i] = a;
        float f0 = bflo(a.x), f1 = bfhi(a.x), f2 = bflo(a.y), f3 = bfhi(a.y);
        float f4 = bflo(a.z), f5 = bfhi(a.z), f6 = bflo(a.w), f7 = bfhi(a.w);
        ss += f0 * f0 + f1 * f1 + f2 * f2 + f3 * f3 + f4 * f4 + f5 * f5 + f6 * f6 + f7 * f7;
      }
      const float rstd = rsqrtf(ss * (1.f / 64.f) + 1e-6f) * 0.125f;
      {
        uint4 lo = qraw[0], hi = qraw[1];
        float t1[8] = {bflo(lo.x), bfhi(lo.x), bflo(lo.y), bfhi(lo.y), bflo(lo.z), bfhi(lo.z), bflo(lo.w), bfhi(lo.w)};
        float t2[8] = {bflo(hi.x), bfhi(hi.x), bflo(hi.y), bfhi(hi.y), bflo(hi.z), bfhi(hi.z), bflo(hi.w), bfhi(hi.w)};
        float f[8];
#pragma unroll
        for (int i = 0; i < 8; ++i) {
          float invf = __expf(-1.6402954f * (float)i);
          float rev = (float)qpos * invf * 0.15915494f;
          rev -= floorf(rev);
          float cs = __builtin_amdgcn_cosf(rev), sn = __builtin_amdgcn_sinf(rev);
          float x1 = t1[i] * rstd * gq[i], x2 = t2[i] * rstd * gq[8 + i];
          float a = lh ? x2 : x1;
          float b = lh ? x1 : -x2;
          f[i] = a * cs + b * sn;
        }
        u32 pk[4] = {pack2(f[0], f[1]), pack2(f[2], f[3]), pack2(f[4], f[5]), pack2(f[6], f[7])};
        qf[0] = *(bf16x8*)pk;
      }
#pragma unroll
      for (int s = 1; s < 4; ++s) {
        uint4 lo = qraw[2 * s], hi = qraw[2 * s + 1];
        uint4 sel;
        sel.x = lh ? hi.x : lo.x; sel.y = lh ? hi.y : lo.y; sel.z = lh ? hi.z : lo.z; sel.w = lh ? hi.w : lo.w;
        const float* gp = gq + 16 * s + 8 * lh;
        float f[8] = {bflo(sel.x), bfhi(sel.x), bflo(sel.y), bfhi(sel.y), bflo(sel.z), bfhi(sel.z), bflo(sel.w), bfhi(sel.w)};
#pragma unroll
        for (int i = 0; i < 8; ++i) f[i] = f[i] * rstd * gp[i];
        u32 pk2[4] = {pack2(f[0], f[1]), pack2(f[2], f[3]), pack2(f[4], f[5]), pack2(f[6], f[7])};
        qf[s] = *(bf16x8*)pk2;
      }
    }
    f32x16 o0, o1;
#pragma unroll
    for (int r = 0; r < 16; ++r) { o0[r] = 0.f; o1[r] = 0.f; }
    float lsum = 0.f;
    for (int kt = qt; kt < qt + 9; ++kt) {
      f32x16 s;
#pragma unroll
      for (int r = 0; r < 16; ++r) s[r] = 0.f;
      const char* kb = Ks + (kt * 32 + lr) * KS_PITCH + lh * 16;
#pragma unroll
      for (int ks = 0; ks < 4; ++ks) {
        bf16x8 kf = *(const bf16x8*)(kb + ks * 32);
        s = __builtin_amdgcn_mfma_f32_32x32x16_bf16(kf, qf[ks], s, 0, 0, 0);
      }
      float pv[16];
#pragma unroll
      for (int r = 0; r < 16; ++r) {
        int kw = kt * 32 + (r & 3) + 8 * (r >> 2) + 4 * lh;
        int kpos = pos0 - 128 + kw;
        int dlt = kpos - qpos;
        bool ok = (dlt <= 128) && (dlt >= -128) && (kpos >= 0) && (kpos < L);
        float e = ok ? __expf(s[r] - mb) : 0.f;
        pv[r] = e;
        lsum += e;
      }
#pragma unroll
      for (int sk = 0; sk < 2; ++sk) {
        u32 pk[4] = {pack2(pv[8 * sk + 0], pv[8 * sk + 1]), pack2(pv[8 * sk + 2], pv[8 * sk + 3]),
                     pack2(pv[8 * sk + 4], pv[8 * sk + 5]), pack2(pv[8 * sk + 6], pv[8 * sk + 7])};
        bf16x8 pf = *(bf16x8*)pk;
        const char* vb = Vt + lr * VT_PITCH + (kt * 32 + 16 * sk + 4 * lh) * 2;
        uint2 va = *(const uint2*)(vb), vb2 = *(const uint2*)(vb + 16);
        u32 vk[4] = {va.x, va.y, vb2.x, vb2.y};
        bf16x8 vf0 = *(bf16x8*)vk;
        uint2 vc = *(const uint2*)(vb + 32 * VT_PITCH), vd = *(const uint2*)(vb + 32 * VT_PITCH + 16);
        u32 vk1[4] = {vc.x, vc.y, vd.x, vd.y};
        bf16x8 vf1 = *(bf16x8*)vk1;
        o0 = __builtin_amdgcn_mfma_f32_32x32x16_bf16(vf0, pf, o0, 0, 0, 0);
        o1 = __builtin_amdgcn_mfma_f32_32x32x16_bf16(vf1, pf, o1, 0, 0, 0);
      }
    }
    lsum += __shfl_xor(lsum, 32);
    lsum += __expf(p.in[19][layer * 8 + head] - mb);
    float inv = 1.f / lsum;
#pragma unroll
    for (int g = 0; g < 4; ++g) {
      uint2 a, b;
      a.x = pack2(o0[4 * g] * inv, o0[4 * g + 1] * inv); a.y = pack2(o0[4 * g + 2] * inv, o0[4 * g + 3] * inv);
      b.x = pack2(o1[4 * g] * inv, o1[4 * g + 1] * inv); b.y = pack2(o1[4 * g + 2] * inv, o1[4 * g + 3] * inv);
      *(uint2*)(qrow + 8 * g + 4 * lh) = a;
      *(uint2*)(qrow + 32 + 8 * g + 4 * lh) = b;
    }
  }
}

#define S5_WAVE_LDS 12800
#define WAVE_SYNC() do { asm volatile("" ::: "memory"); __builtin_amdgcn_wave_barrier(); asm volatile("" ::: "memory"); } while (0)
template <bool PASS2>
__device__ __forceinline__ void s5_unit(const Params& p, int layer, int unit, char* wsm) {
  const int lane = tid_() & 63;
  const int c = unit >> 5, g = unit & 31;
  const long t0 = (long)c * 128;
  float* BU = (float*)wsm;
  char* ST = wsm + 8448;
  u16* RA = (u16*)(p.ws + OFF_A);
  float* CAR = (float*)(p.ws + OFF_CAR);
  const int c16 = lane & 15, q = lane >> 4;
  bf16x8 uf[8];
#pragma unroll
  for (int sb = 0; sb < 8; ++sb) {
    uint4 v = make_uint4(0u, 0u, 0u, 0u);
    if (q < 2) v = *(const uint4*)(RA + (t0 + 16 * sb + c16) * 1280 + 16 * g + 8 * q);
    uf[sb] = *(bf16x8*)&v;
  }
  f32x4 acc[8];
#pragma unroll
  for (int i = 0; i < 8; ++i) acc[i] = (f32x4){0.f, 0.f, 0.f, 0.f};
  int clo, chi;
  if (c < 256) { clo = c & ~15; chi = clo + 16; } else { clo = c & ~31; chi = clo + 32; }

#pragma unroll
  for (int d = 0; d < 2; ++d) {
    const long pg = ((long)(layer * 2 + d) * 32 + g);
    float lre = fminf(p.in[8][pg * 64 + lane], -1e-4f);
    float lim = p.in[9][pg * 64 + lane];
    float dt = expf(p.in[10][pg]);
    float er = expf(lre * dt);
    float ang = lim * dt;
    float nrev = rintf(ang * 0.15915494f);
    float rr = fmaf(-nrev, 6.28125f, ang);
    rr = fmaf(-nrev, 1.9353071795864769e-3f, rr);
    float ar = er * cosf(rr), ai = er * sinf(rr);
    float den = 1.f / (lre * lre + lim * lim);
    float nr = ar - 1.f;
    float c0r = (nr * lre + ai * lim) * den, c0i = (ai * lre - nr * lim) * den;
    WAVE_SYNC();
    {
      const float4* br = (const float4*)(p.in[11] + (pg * 64 + lane) * 16);
      const float4* bi = (const float4*)(p.in[12] + (pg * 64 + lane) * 16);
      u32 pr_[8], pi_[8];
#pragma unroll
      for (int i = 0; i < 4; ++i) {
        float4 x = br[i], y = bi[i];
        pr_[2 * i] = pack2(c0r * x.x - c0i * y.x, c0r * x.y - c0i * y.y);
        pr_[2 * i + 1] = pack2(c0r * x.z - c0i * y.z, c0r * x.w - c0i * y.w);
        pi_[2 * i] = pack2(c0r * y.x + c0i * x.x, c0r * y.y + c0i * x.y);
        pi_[2 * i + 1] = pack2(c0r * y.z + c0i * x.z, c0r * y.w + c0i * x.w);
      }
      uint4* dstr = (uint4*)((char*)BU + (2 * lane) * 32);
      dstr[0] = make_uint4(pr_[0], pr_[1], pr_[2], pr_[3]);
      dstr[1] = make_uint4(pr_[4], pr_[5], pr_[6], pr_[7]);
      dstr[2] = make_uint4(pi_[0], pi_[1], pi_[2], pi_[3]);
      dstr[3] = make_uint4(pi_[4], pi_[5], pi_[6], pi_[7]);
    }
    WAVE_SYNC();
    bf16x8 bfr[8];
#pragma unroll
    for (int nt = 0; nt < 8; ++nt) {
      uint4 v = make_uint4(0u, 0u, 0u, 0u);
      if (q < 2) v = *(const uint4*)((const char*)BU + (16 * nt + c16) * 32 + 16 * q);
      bfr[nt] = *(bf16x8*)&v;
    }
    WAVE_SYNC();
    float sr = 0.f, si = 0.f;
    bf16x8 cf[4];
    if (PASS2) {
      float pr = ar, pi = ai;
#pragma unroll
      for (int i = 0; i < 7; ++i) { float t = pr * pr - pi * pi; pi = 2.f * pr * pi; pr = t; }
      if (d == 0) {
        for (int cc = clo; cc < c; ++cc) {
          float2 e = *(const float2*)(CAR + (((long)cc * 32 + g) * 2 + 0) * 128 + 2 * lane);
          float t = pr * sr - pi * si + e.x; si = pr * si + pi * sr + e.y; sr = t;
        }
      } else {
        for (int cc = chi - 1; cc > c; --cc) {
          float2 e = *(const float2*)(CAR + (((long)cc * 32 + g) * 2 + 1) * 128 + 2 * lane);
          float t = pr * sr - pi * si + e.x; si = pr * si + pi * sr + e.y; sr = t;
        }
      }
      const float* cre = p.in[13] + (pg * 16 + c16) * 64;
      const float* cim = p.in[14] + (pg * 16 + c16) * 64;
#pragma unroll
      for (int ks = 0; ks < 4; ++ks) {
        float4 x = *(const float4*)(cre + 16 * ks + 4 * q);
        float4 y = *(const float4*)(cim + 16 * ks + 4 * q);
        u32 pk[4] = {pack2(x.x, -y.x), pack2(x.y, -y.y), pack2(x.z, -y.z), pack2(x.w, -y.w)};
        cf[ks] = *(bf16x8*)pk;
      }
    }
#pragma unroll
    for (int sbi = 0; sbi < 8; ++sbi) {
      const int sb = d ? 7 - sbi : sbi;
      f32x4 z[8];
#pragma unroll
      for (int nt = 0; nt < 8; ++nt) {
        z[nt] = (f32x4){0.f, 0.f, 0.f, 0.f};
        z[nt] = __builtin_amdgcn_mfma_f32_16x16x32_bf16(uf[sb], bfr[nt], z[nt], 0, 0, 0);
      }
      __builtin_amdgcn_sched_barrier(0);
#pragma unroll
      for (int nt = 0; nt < 8; ++nt)
#pragma unroll
        for (int r = 0; r < 4; ++r) BU[(4 * q + r) * 132 + 16 * nt + c16] = z[nt][r];
      asm volatile("s_waitcnt lgkmcnt(0)" ::: "memory");
      __builtin_amdgcn_sched_barrier(0);
      WAVE_SYNC();
#pragma unroll 4
      for (int s = 0; s < 16; ++s) {
        const int tl = d ? 15 - s : s;
        const float2 bu = *(const float2*)(BU + tl * 132 + 2 * lane);
        float t = ar * sr - ai * si + bu.x;
        si = ar * si + ai * sr + bu.y;
        sr = t;
        if (PASS2) *(u32*)(ST + tl * 272 + 4 * lane) = pack2(sr, si);
      }
      WAVE_SYNC();
      if (PASS2) {
        const char* ab = ST + c16 * 272 + q * 16;
#pragma unroll
        for (int ks = 0; ks < 4; ++ks) {
          bf16x8 af = *(const bf16x8*)(ab + ks * 64);
          acc[sb] = __builtin_amdgcn_mfma_f32_16x16x32_bf16(af, cf[ks], acc[sb], 0, 0, 0);
        }
        WAVE_SYNC();
      }
    }
    if (!PASS2) {
      float2 e = {sr, si};
      *(float2*)(CAR + (((long)c * 32 + g) * 2 + d) * 128 + 2 * lane) = e;
    }
  }
  if (PASS2) {
    const float dsk = p.in[15][(layer * 32 + g) * 16 + c16];
#pragma unroll
    for (int sb = 0; sb < 8; ++sb)
#pragma unroll
      for (int r = 0; r < 4; ++r) {
        int tau = sb * 16 + 4 * q + r;
        u16* up = RA + (t0 + tau) * 1280 + 16 * g + c16;
        float y = acc[sb][r] + dsk * bflo((u32)*up);
        float t = tanhf(0.7978845608f * (y + 0.044715f * y * y * y));
        y = 0.5f * y * (1.f + t);
        *up = f2bf(y);
      }
  }
}

template <bool PASS2>
__device__ __forceinline__ void s5_unit_old(const Params& p, int layer, int unit, char* wsm) {
  const int lane = tid_() & 63;
  const int c = unit >> 5, g = unit & 31;
  const long t0 = (long)c * 128;
  float* U = (float*)wsm;
  char* ST = wsm + 8192;
  u16* RA = (u16*)(p.ws + OFF_A);
  float* CAR = (float*)(p.ws + OFF_CAR);
  __builtin_amdgcn_wave_barrier();
#pragma unroll
  for (int i = 0; i < 2; ++i) {
    int tau = lane + 64 * i;
    const u16* src = RA + (t0 + tau) * 1280 + 16 * g;
    uint4 a = *(const uint4*)src, b = *(const uint4*)(src + 8);
    float4 f0 = {bflo(a.x), bfhi(a.x), bflo(a.y), bfhi(a.y)};
    float4 f1 = {bflo(a.z), bfhi(a.z), bflo(a.w), bfhi(a.w)};
    float4 f2 = {bflo(b.x), bfhi(b.x), bflo(b.y), bfhi(b.y)};
    float4 f3 = {bflo(b.z), bfhi(b.z), bflo(b.w), bfhi(b.w)};
    float4* d = (float4*)(U + tau * 16);
    d[0] = f0; d[1] = f1; d[2] = f2; d[3] = f3;
  }
  __builtin_amdgcn_wave_barrier();
  f32x4 acc[8];
#pragma unroll
  for (int i = 0; i < 8; ++i) acc[i] = (f32x4){0.f, 0.f, 0.f, 0.f};
  int clo, chi;
  if (c < 256) { clo = c & ~15; chi = clo + 16; } else { clo = c & ~31; chi = clo + 32; }

#pragma unroll
  for (int d = 0; d < 2; ++d) {
    const long pg = ((long)(layer * 2 + d) * 32 + g);
    float lre = fminf(p.in[8][pg * 64 + lane], -1e-4f);
    float lim = p.in[9][pg * 64 + lane];
    float dt = expf(p.in[10][pg]);
    float er = expf(lre * dt);
    float ang = lim * dt;
    float nrev = rintf(ang * 0.15915494f);
    float rr = fmaf(-nrev, 6.28125f, ang);
    rr = fmaf(-nrev, 1.9353071795864769e-3f, rr);
    float ar = er * cosf(rr), ai = er * sinf(rr);
    float den = 1.f / (lre * lre + lim * lim);
    float nr = ar - 1.f;
    float c0r = (nr * lre + ai * lim) * den, c0i = (ai * lre - nr * lim) * den;
    float Br[16], Bi[16];
    {
      const float4* br = (const float4*)(p.in[11] + (pg * 64 + lane) * 16);
      const float4* bi = (const float4*)(p.in[12] + (pg * 64 + lane) * 16);
#pragma unroll
      for (int i = 0; i < 4; ++i) {
        float4 x = br[i], y = bi[i];
        Br[4 * i + 0] = c0r * x.x - c0i * y.x; Bi[4 * i + 0] = c0r * y.x + c0i * x.x;
        Br[4 * i + 1] = c0r * x.y - c0i * y.y; Bi[4 * i + 1] = c0r * y.y + c0i * x.y;
        Br[4 * i + 2] = c0r * x.z - c0i * y.z; Bi[4 * i + 2] = c0r * y.z + c0i * x.z;
        Br[4 * i + 3] = c0r * x.w - c0i * y.w; Bi[4 * i + 3] = c0r * y.w + c0i * x.w;
      }
    }
    float sr = 0.f, si = 0.f;
    bf16x8 cf[4];
    if (PASS2) {
      float pr = ar, pi = ai;
#pragma unroll
      for (int i = 0; i < 7; ++i) { float t = pr * pr - pi * pi; pi = 2.f * pr * pi; pr = t; }
      if (d == 0) {
        for (int cc = clo; cc < c; ++cc) {
          float2 e = *(const float2*)(CAR + (((long)cc * 32 + g) * 2 + 0) * 128 + 2 * lane);
          float t = pr * sr - pi * si + e.x; si = pr * si + pi * sr + e.y; sr = t;
        }
      } else {
        for (int cc = chi - 1; cc > c; --cc) {
          float2 e = *(const float2*)(CAR + (((long)cc * 32 + g) * 2 + 1) * 128 + 2 * lane);
          float t = pr * sr - pi * si + e.x; si = pr * si + pi * sr + e.y; sr = t;
        }
      }
      const int h = lane & 15, q = lane >> 4;
      const float* cre = p.in[13] + (pg * 16 + h) * 64;
      const float* cim = p.in[14] + (pg * 16 + h) * 64;
#pragma unroll
      for (int ks = 0; ks < 4; ++ks) {
        float4 x = *(const float4*)(cre + 16 * ks + 4 * q);
        float4 y = *(const float4*)(cim + 16 * ks + 4 * q);
        u32 pk[4] = {pack2(x.x, -y.x), pack2(x.y, -y.y), pack2(x.z, -y.z), pack2(x.w, -y.w)};
        cf[ks] = *(bf16x8*)pk;
      }
    }
#pragma unroll
    for (int sbi = 0; sbi < 8; ++sbi) {
      const int sb = d ? 7 - sbi : sbi;
#pragma unroll 4
      for (int s = 0; s < 16; ++s) {
        const int tl = d ? 15 - s : s;
        const int tau = sb * 16 + tl;
        const float4* up = (const float4*)(U + tau * 16);
        float4 u0 = up[0], u1 = up[1], u2 = up[2], u3 = up[3];
        float uu[16] = {u0.x, u0.y, u0.z, u0.w, u1.x, u1.y, u1.z, u1.w, u2.x, u2.y, u2.z, u2.w, u3.x, u3.y, u3.z, u3.w};
        float bur = 0.f, bui = 0.f;
#pragma unroll
        for (int hh = 0; hh < 16; ++hh) { bur += Br[hh] * uu[hh]; bui += Bi[hh] * uu[hh]; }
        float t = ar * sr - ai * si + bur;
        si = ar * si + ai * sr + bui;
        sr = t;
        if (PASS2) *(u32*)(ST + tl * 272 + 4 * lane) = pack2(sr, si);
      }
      if (PASS2) {
        __builtin_amdgcn_wave_barrier();
        const char* ab = ST + (lane & 15) * 272 + (lane >> 4) * 16;
#pragma unroll
        for (int ks = 0; ks < 4; ++ks) {
          bf16x8 af = *(const bf16x8*)(ab + ks * 64);
          acc[sb] = __builtin_amdgcn_mfma_f32_16x16x32_bf16(af, cf[ks], acc[sb], 0, 0, 0);
        }
        __builtin_amdgcn_wave_barrier();
      }
    }
    if (!PASS2) {
      float2 e = {sr, si};
      *(float2*)(CAR + (((long)c * 32 + g) * 2 + d) * 128 + 2 * lane) = e;
    }
  }
  if (PASS2) {
    const int h = lane & 15, q = lane >> 4;
    const float dsk = p.in[15][(layer * 32 + g) * 16 + h];
#pragma unroll
    for (int sb = 0; sb < 8; ++sb)
#pragma unroll
      for (int r = 0; r < 4; ++r) {
        int tau = sb * 16 + 4 * q + r;
        float y = acc[sb][r] + dsk * U[tau * 16 + h];
        float t = tanhf(0.7978845608f * (y + 0.044715f * y * y * y));
        y = 0.5f * y * (1.f + t);
        RA[(t0 + tau) * 1280 + 16 * g + h] = f2bf(y);
      }
  }
}

#define OFF_FLAG (OFF_CTR + 1024)
__device__ __forceinline__ void rwkv_job(const Params& p, int layer, int job, char* smem) {
  const int tid = tid_(), lane = tid & 63, w = tid >> 6;
  const int pr = job >> 1, d = job & 1;
  int head, L;
  long tok0;
  if (pr < 64) { head = pr & 7; L = 4096; tok0 = 32768 + (long)(pr >> 3) * 4096; }
  else { int q = pr - 64; head = q & 7; L = 2048; tok0 = (long)(q >> 3) * 2048; }
  float* R = (float*)smem;
  float* KP = R + 2048; float* V = KP + 2048; float* W = V + 2048; float* NKK = W + 2048; float* KKA = NKK + 2048;
  float* AA = KKA + 2048; float* G = AA + 2048; float* YO = G + 2048;
  char* TW = smem + 73728; char* AL = TW + 4608; char* SG = AL + 4608;
  float* BON = (float*)(SG + 8704);
  float* MU = BON + 32;
  int* SPROG = (int*)(MU + 896);
  const u16* RZ = (const u16*)(p.ws + OFF_Z);
  u16* RY = (u16*)(p.ws + OFF_Y);
  u32* myflag = (u32*)(p.ws + OFF_FLAG) + layer * 384 + job;
  u32* paflag = (u32*)(p.ws + OFF_FLAG) + layer * 384 + (job ^ 1);
  const float* mu = p.in[20] + (long)layer * 2 * 1920;
  const float* w0 = p.in[21] + (long)(layer * 2 + d) * 512;
  const float* w2 = p.in[22] + (long)(layer * 2 + d) * 64 * 512;
  const float* a0 = p.in[23] + (long)(layer * 2 + d) * 512;
  const float* a2 = p.in[24] + (long)(layer * 2 + d) * 64 * 512;
  const float* g2 = p.in[25] + (long)layer * 128 * 512;
#define RW_ZB(v) ((v) == 0 ? 64 * head : (v) == 1 ? 512 + 64 * head : (v) == 2 ? 1024 + 64 * head \
                 : (v) == 3 ? 1536 + 64 * d : (v) == 4 ? 1664 + 64 * d : (v) == 5 ? 1792 : 1856)
  __syncthreads();
  for (int idx = tid; idx < 896; idx += NTHREADS) {
    int m = idx / 448, rem = idx - m * 448, v = rem >> 6, cc = rem & 63;
    MU[idx] = mu[m * 1920 + RW_ZB(v) + cc];
  }
  const int tau_a = tid >> 4, c4 = tid & 15;
  float kkc[4], kac[4], rkc[4], lnw[4], lnb[4];
#pragma unroll
  for (int e = 0; e < 4; ++e) {
    int cc = 64 * head + 4 * c4 + e;
    kkc[e] = p.in[26][layer * 512 + cc];
    kac[e] = p.in[27][layer * 512 + cc];
    rkc[e] = p.in[28][layer * 512 + cc];
    lnw[e] = p.in[29][layer * 512 + cc];
    lnb[e] = p.in[30][layer * 512 + cc];
  }
  const int c16 = lane & 15, q4 = lane >> 4;
  const int nt = w & 3, th = w >> 2;
  const int colb = 64 * head + 16 * nt + c16;
  bf16x8 w2f[2], a2f[2], g2f[4];
#pragma unroll
  for (int s = 0; s < 4; ++s) {
    float fw[8], fa[8], fg[8];
#pragma unroll
    for (int j = 0; j < 8; ++j) {
      int m = 32 * s + 8 * q4 + j;
      fg[j] = g2[(long)m * 512 + colb];
      if (s < 2) { fw[j] = w2[(long)m * 512 + colb]; fa[j] = a2[(long)m * 512 + colb]; }
    }
    u32 pg[4] = {pack2(fg[0], fg[1]), pack2(fg[2], fg[3]), pack2(fg[4], fg[5]), pack2(fg[6], fg[7])};
    g2f[s] = *(bf16x8*)pg;
    if (s < 2) {
      u32 pw[4] = {pack2(fw[0], fw[1]), pack2(fw[2], fw[3]), pack2(fw[4], fw[5]), pack2(fw[6], fw[7])};
      u32 pa[4] = {pack2(fa[0], fa[1]), pack2(fa[2], fa[3]), pack2(fa[4], fa[5]), pack2(fa[6], fa[7])};
      w2f[s] = *(bf16x8*)pw;
      a2f[s] = *(bf16x8*)pa;
    }
  }
  const float w0c = w0[colb], a0c = a0[colb];
  f2_t S2[2][2];
#pragma unroll
  for (int r = 0; r < 2; ++r) { S2[r][0] = (f2_t){0.f, 0.f}; S2[r][1] = (f2_t){0.f, 0.f}; }
  const int jq16 = lane & 15, rq = lane >> 4;
  const int row0 = 8 * w + 2 * rq;
  const int NC = L >> 5;
  uint2 zr[7][3];
  int prog = 0;

#define RW_LOAD(ci_)                                                                          \
  {                                                                                           \
    const int chunk_ = d ? NC - 1 - (ci_) : (ci_);                                            \
    const long t_ = tok0 + (long)chunk_ * 32 + tau_a;                                         \
    const int pos_ = chunk_ * 32 + tau_a;                                                     \
    const bool hp_ = pos_ > 0, hn_ = pos_ < L - 1;                                            \
    _Pragma("unroll") for (int v = 0; v < 7; ++v) {                                           \
      const u16* zp = RZ + t_ * 1920 + RW_ZB(v) + 4 * c4;                                     \
      zr[v][0] = *(const uint2*)zp;                                                           \
      zr[v][1] = hp_ ? *(const uint2*)(zp - 1920) : make_uint2(0u, 0u);                       \
      zr[v][2] = hn_ ? *(const uint2*)(zp + 1920) : make_uint2(0u, 0u);                       \
    }                                                                                         \
  }
#define RW_PREP_A()                                                                           \
  {                                                                                           \
    _Pragma("unroll") for (int v = 0; v < 7; ++v) {                                           \
      uint2 zc = zr[v][0], zpv = zr[v][1], znv = zr[v][2];                                    \
      float4 m0 = *(const float4*)(MU + v * 64 + 4 * c4);                                     \
      float4 m1 = *(const float4*)(MU + 448 + v * 64 + 4 * c4);                               \
      float zc4[4] = {bflo(zc.x), bfhi(zc.x), bflo(zc.y), bfhi(zc.y)};                        \
      float zp4[4] = {bflo(zpv.x), bfhi(zpv.x), bflo(zpv.y), bfhi(zpv.y)};                    \
      float zn4[4] = {bflo(znv.x), bfhi(znv.x), bflo(znv.y), bfhi(znv.y)};                    \
      float mm0[4] = {m0.x, m0.y, m0.z, m0.w}, mm1[4] = {m1.x, m1.y, m1.z, m1.w};             \
      float o[4];                                                                             \
      _Pragma("unroll") for (int e = 0; e < 4; ++e)                                           \
          o[e] = zc4[e] + mm0[e] * (zp4[e] - zc4[e]) + mm1[e] * (zn4[e] - zc4[e]);            \
      if (v == 0) *(float4*)(R + tau_a * 64 + 4 * c4) = make_float4(o[0], o[1], o[2], o[3]);  \
      else if (v == 1) *(float4*)(KP + tau_a * 64 + 4 * c4) = make_float4(o[0], o[1], o[2], o[3]); \
      else if (v == 2) *(float4*)(V + tau_a * 64 + 4 * c4) = make_float4(o[0], o[1], o[2], o[3]);  \
      else if (v == 3) {                                                                      \
        float th_[4];                                                                         \
        _Pragma("unroll") for (int e = 0; e < 4; ++e) th_[e] = 1.f - 2.f * frcp(1.f + __expf(2.f * o[e])); \
        *(uint2*)(TW + tau_a * 144 + 8 * c4) = make_uint2(pack2(th_[0], th_[1]), pack2(th_[2], th_[3])); \
      } else if (v == 4) {                                                                    \
        *(uint2*)(AL + tau_a * 144 + 8 * c4) = make_uint2(pack2(o[0], o[1]), pack2(o[2], o[3])); \
      } else {                                                                                \
        *(uint2*)(SG + tau_a * 272 + (v - 5) * 128 + 8 * c4) =                                \
            make_uint2(pack2(fsig(o[0]), fsig(o[1])), pack2(fsig(o[2]), fsig(o[3])));         \
      }                                                                                       \
    }                                                                                         \
  }
#define RW_PREP_B()                                                                           \
  {                                                                                           \
    f32x4 cw = {0.f, 0.f, 0.f, 0.f}, ca = cw, cgt = cw;                                       \
    const int tr_ = 16 * th + c16;                                                            \
    _Pragma("unroll") for (int s = 0; s < 2; ++s) {                                           \
      bf16x8 tf = *(const bf16x8*)(TW + tr_ * 144 + (32 * s + 8 * q4) * 2);                   \
      bf16x8 af = *(const bf16x8*)(AL + tr_ * 144 + (32 * s + 8 * q4) * 2);                   \
      cw = __builtin_amdgcn_mfma_f32_16x16x32_bf16(tf, w2f[s], cw, 0, 0, 0);                  \
      ca = __builtin_amdgcn_mfma_f32_16x16x32_bf16(af, a2f[s], ca, 0, 0, 0);                  \
    }                                                                                         \
    _Pragma("unroll") for (int s = 0; s < 4; ++s) {                                           \
      bf16x8 sf = *(const bf16x8*)(SG + tr_ * 272 + (32 * s + 8 * q4) * 2);                   \
      cgt = __builtin_amdgcn_mfma_f32_16x16x32_bf16(sf, g2f[s], cgt, 0, 0, 0);                \
    }                                                                                         \
    _Pragma("unroll") for (int r = 0; r < 4; ++r) {                                           \
      int tau = 16 * th + 4 * q4 + r, cc = 16 * nt + c16;                                     \
      W[tau * 64 + cc] = __expf(-0.60653066f * fsig(cw[r] + w0c));                            \
      AA[tau * 64 + cc] = fsig(ca[r] + a0c);                                                  \
      G[tau * 64 + cc] = cgt[r];                                                              \
    }                                                                                         \
  }
#define RW_PREP_C()                                                                           \
  {                                                                                           \
    float4 k4 = *(const float4*)(KP + tau_a * 64 + 4 * c4);                                   \
    float4 a4 = *(const float4*)(AA + tau_a * 64 + 4 * c4);                                   \
    float4 r4 = *(const float4*)(R + tau_a * 64 + 4 * c4);                                    \
    float kk[4] = {k4.x * kkc[0], k4.y * kkc[1], k4.z * kkc[2], k4.w * kkc[3]};               \
    float kx[4] = {k4.x, k4.y, k4.z, k4.w}, ax[4] = {a4.x, a4.y, a4.z, a4.w}, rx[4] = {r4.x, r4.y, r4.z, r4.w}; \
    float ss = kk[0] * kk[0] + kk[1] * kk[1] + kk[2] * kk[2] + kk[3] * kk[3];                 \
    float bn = rx[0] * kx[0] * rkc[0] + rx[1] * kx[1] * rkc[1] + rx[2] * kx[2] * rkc[2] + rx[3] * kx[3] * rkc[3]; \
    ss = row16_sum(ss); bn = row16_sum(bn);                                                   \
    float inv = 1.f / fmaxf(sqrtf(ss), 1e-12f);                                               \
    float nk[4], ka[4], kd[4];                                                                \
    _Pragma("unroll") for (int e = 0; e < 4; ++e) {                                           \
      float k1 = kk[e] * inv;                                                                 \
      nk[e] = -k1;                                                                            \
      ka[e] = k1 * ax[e];                                                                     \
      kd[e] = kx[e] * (1.f + (ax[e] - 1.f) * kac[e]);                                         \
    }                                                                                         \
    *(float4*)(NKK + tau_a * 64 + 4 * c4) = make_float4(nk[0], nk[1], nk[2], nk[3]);          \
    *(float4*)(KKA + tau_a * 64 + 4 * c4) = make_float4(ka[0], ka[1], ka[2], ka[3]);          \
    *(float4*)(KP + tau_a * 64 + 4 * c4) = make_float4(kd[0], kd[1], kd[2], kd[3]);           \
    if (c4 == 0) BON[tau_a] = bn;                                                             \
  }

  __syncthreads();
  RW_LOAD(0);
  RW_PREP_A();
  __syncthreads();
  RW_PREP_B();
  __syncthreads();
  RW_PREP_C();
  __syncthreads();

  for (int ci = 0; ci < NC; ++ci) {
    const int chunk = d ? NC - 1 - ci : ci;
    const long tb = tok0 + (long)chunk * 32;
    const bool more = (ci + 1 < NC);
    const bool second = ci >= (NC >> 1);
    if (more) RW_LOAD(ci + 1);
    u64* yp = (u64*)(RY + (tb + tau_a) * 512 + 64 * head + 4 * c4);
    u64 st = 0;
    if (second) {
      const int need = NC - ci;
      if (prog < need) {
        if (tid == 0) {
          int v = 0;
          for (unsigned spins = 0; spins < (1u << 24); ++spins) {
            v = (int)__hip_atomic_load(paflag, __ATOMIC_RELAXED, __HIP_MEMORY_SCOPE_AGENT);
            if (v >= need) break;
            __builtin_amdgcn_s_sleep(2);
          }
          *SPROG = v;
        }
        __syncthreads();
        prog = *SPROG;
        if (prog < need) prog = need;
      }
      st = __hip_atomic_load(yp, __ATOMIC_RELAXED, __HIP_MEMORY_SCOPE_AGENT);
    }
    {
      float yp0 = 0.f, yp1 = 0.f;
      int tprev = d ? 31 : 0;
#pragma unroll 2
      for (int s = 0; s < 32; ++s) {
        const int tau = d ? 31 - s : s;
        const int o = tau * 64 + 4 * jq16;
        const float4 w4 = *(const float4*)(W + o);
        const float4 n4 = *(const float4*)(NKK + o);
        const float4 a4 = *(const float4*)(KKA + o);
        const float4 d4 = *(const float4*)(KP + o);
        const float4 r4 = *(const float4*)(R + o);
        const float2 v2 = *(const float2*)(V + tau * 64 + row0);
        const f2_t w01 = {w4.x, w4.y}, w23 = {w4.z, w4.w}, n01 = {n4.x, n4.y}, n23 = {n4.z, n4.w};
        const f2_t a01 = {a4.x, a4.y}, a23 = {a4.z, a4.w}, d01 = {d4.x, d4.y}, d23 = {d4.z, d4.w};
        const f2_t r01 = {r4.x, r4.y}, r23 = {r4.z, r4.w};
        f2_t t0 = S2[0][0] * n01 + S2[0][1] * n23;
        f2_t t1 = S2[1][0] * n01 + S2[1][1] * n23;
        float q0 = t0.x + t0.y, q1 = t1.x + t1.y, q2 = yp0, q3 = yp1;
        asm("s_nop 1\n\t"
            "v_add_f32_dpp %0, %0, %0 row_ror:1 row_mask:0xf bank_mask:0xf bound_ctrl:1\n\t"
            "v_add_f32_dpp %1, %1, %1 row_ror:1 row_mask:0xf bank_mask:0xf bound_ctrl:1\n\t"
            "v_add_f32_dpp %2, %2, %2 row_ror:1 row_mask:0xf bank_mask:0xf bound_ctrl:1\n\t"
            "v_add_f32_dpp %3, %3, %3 row_ror:1 row_mask:0xf bank_mask:0xf bound_ctrl:1\n\t"
            "v_add_f32_dpp %0, %0, %0 row_ror:2 row_mask:0xf bank_mask:0xf bound_ctrl:1\n\t"
            "v_add_f32_dpp %1, %1, %1 row_ror:2 row_mask:0xf bank_mask:0xf bound_ctrl:1\n\t"
            "v_add_f32_dpp %2, %2, %2 row_ror:2 row_mask:0xf bank_mask:0xf bound_ctrl:1\n\t"
            "v_add_f32_dpp %3, %3, %3 row_ror:2 row_mask:0xf bank_mask:0xf bound_ctrl:1\n\t"
            "v_add_f32_dpp %0, %0, %0 row_ror:4 row_mask:0xf bank_mask:0xf bound_ctrl:1\n\t"
            "v_add_f32_dpp %1, %1, %1 row_ror:4 row_mask:0xf bank_mask:0xf bound_ctrl:1\n\t"
            "v_add_f32_dpp %2, %2, %2 row_ror:4 row_mask:0xf bank_mask:0xf bound_ctrl:1\n\t"
            "v_add_f32_dpp %3, %3, %3 row_ror:4 row_mask:0xf bank_mask:0xf bound_ctrl:1\n\t"
            "v_add_f32_dpp %0, %0, %0 row_ror:8 row_mask:0xf bank_mask:0xf bound_ctrl:1\n\t"
            "v_add_f32_dpp %1, %1, %1 row_ror:8 row_mask:0xf bank_mask:0xf bound_ctrl:1\n\t"
            "v_add_f32_dpp %2, %2, %2 row_ror:8 row_mask:0xf bank_mask:0xf bound_ctrl:1\n\t"
            "v_add_f32_dpp %3, %3, %3 row_ror:8 row_mask:0xf bank_mask:0xf bound_ctrl:1"
            : "+v"(q0), "+v"(q1), "+v"(q2), "+v"(q3));
        if (jq16 == 0) *(float2*)(YO + tprev * 64 + row0) = make_float2(q2, q3);
        tprev = tau;
        {
          const f2_t sv = {q0, q0}, vr = {v2.x, v2.x};
          S2[0][0] = S2[0][0] * w01 + (sv * a01 + vr * d01);
          S2[0][1] = S2[0][1] * w23 + (sv * a23 + vr * d23);
          f2_t t = S2[0][0] * r01 + S2[0][1] * r23;
          yp0 = t.x + t.y;
        }
        {
          const f2_t sv = {q1, q1}, vr = {v2.y, v2.y};
          S2[1][0] = S2[1][0] * w01 + (sv * a01 + vr * d01);
          S2[1][1] = S2[1][1] * w23 + (sv * a23 + vr * d23);
          f2_t t = S2[1][0] * r01 + S2[1][1] * r23;
          yp1 = t.x + t.y;
        }
      }
      yp0 = row16_sum(yp0);
      yp1 = row16_sum(yp1);
      if (jq16 == 0) *(float2*)(YO + tprev * 64 + row0) = make_float2(yp0, yp1);
    }
    __syncthreads();
    {
      float4 y4 = *(const float4*)(YO + tau_a * 64 + 4 * c4);
      float yv[4] = {y4.x, y4.y, y4.z, y4.w};
      if (!second) {
        u64 pk = (u64)pack2(yv[0], yv[1]) | ((u64)pack2(yv[2], yv[3]) << 32);
        __hip_atomic_store(yp, pk, __ATOMIC_RELAXED, __HIP_MEMORY_SCOPE_AGENT);
        asm volatile("s_waitcnt vmcnt(0)" ::: "memory");
      } else {
        u32 s0 = (u32)st, s1 = (u32)(st >> 32);
        yv[0] += bflo(s0); yv[1] += bfhi(s0); yv[2] += bflo(s1); yv[3] += bfhi(s1);
        float sm1 = row16_sum(yv[0] + yv[1] + yv[2] + yv[3]);
        float mean = sm1 * (1.f / 64.f);
        float vs = 0.f;
#pragma unroll
        for (int e = 0; e < 4; ++e) { float dd = yv[e] - mean; vs += dd * dd; }
        vs = row16_sum(vs);
        float rstd = rsqrtf(vs * (1.f / 64.f) + 64e-5f);
        float4 v4 = *(const float4*)(V + tau_a * 64 + 4 * c4);
        float4 g4 = *(const float4*)(G + tau_a * 64 + 4 * c4);
        float vv[4] = {v4.x, v4.y, v4.z, v4.w}, gg[4] = {g4.x, g4.y, g4.z, g4.w};
        float bn = BON[tau_a];
        float o[4];
#pragma unroll
        for (int e = 0; e < 4; ++e) o[e] = ((yv[e] - mean) * rstd * lnw[e] + lnb[e] + bn * vv[e]) * gg[e];
        *(uint2*)yp = make_uint2(pack2(o[0], o[1]), pack2(o[2], o[3]));
      }
    }
    if (more) RW_PREP_A();
    __syncthreads();
    if (!second && tid == 0) __hip_atomic_store(myflag, (u32)(ci + 1), __ATOMIC_RELAXED, __HIP_MEMORY_SCOPE_AGENT);
    if (more) {
      RW_PREP_B();
      __syncthreads();
      RW_PREP_C();
      __syncthreads();
    }
  }
#undef RW_ZB
#undef RW_LOAD
#undef RW_PREP_A
#undef RW_PREP_B
#undef RW_PREP_C
}

#define N_ATT_ITEMS 1024
#define N_S5_ITEMS 2048
__device__ __forceinline__ void phase_mixer1(const Params& p, int layer, char* smem) {
#ifndef NO_RW
  for (int slot = blockIdx.x; slot < 512; slot += gridDim.x) {
    const int job = slot < 256 ? slot : (slot < 384 ? -1 : slot - 128);
    if (job >= 0) rwkv_job(p, layer, job, smem);
  }
#endif
  int* ctr = (int*)(p.ws + OFF_CTR) + layer;
  int* sitem = (int*)(smem + MISC_OFF + 2048);
  const int w = tid_() >> 6;
  while (true) {
    __syncthreads();
    if (tid_() == 0) *sitem = atomicAdd(ctr, 1);
    __syncthreads();
    int it = *sitem;
    if (it >= N_ATT_ITEMS + N_S5_ITEMS) break;
    if (it < N_ATT_ITEMS) {
#ifndef NO_ATT
      attn_item(p, layer, it, smem);
#endif
    } else {
#ifndef NO_S5
      s5_unit_old<false>(p, layer, (it - N_ATT_ITEMS) * 8 + w, smem + w * S5_WAVE_LDS);
#endif
    }
  }
}

__device__ __forceinline__ void phase_s5p2(const Params& p, int layer, char* smem) {
  const int w = tid_() >> 6;
  for (int it = blockIdx.x; it < N_S5_ITEMS; it += gridDim.x) s5_unit_old<true>(p, layer, it * 8 + w, smem + w * S5_WAVE_LDS);
}

#define XB_TMO      128
#define XB_XCNT(j)  (256  + 64 * (j))
#define XB_XSUB(j)  (1280 + 64 * (j))
#define XB_XGEN(j)  (2304 + 64 * (j))
#define XB_TOP      3328
#define XB_TOPGEN   3392
#define XCD_BAR_WORDS 3456
#define XB_SPIN_CAP (1u << 18)
#define XLAS __attribute__((address_space(3)))

__device__ __forceinline__ unsigned xb_ld(unsigned* p)              { return __hip_atomic_load(p, __ATOMIC_RELAXED, __HIP_MEMORY_SCOPE_AGENT); }
__device__ __forceinline__ unsigned xb_add(unsigned* p, unsigned v) { return __hip_atomic_fetch_add(p, v, __ATOMIC_RELAXED, __HIP_MEMORY_SCOPE_AGENT); }
__device__ __forceinline__ unsigned xb_xcc_id() { return (unsigned)__builtin_amdgcn_s_getreg((3 << 11) | 20) & 0xFu; }
#define XB_SPIN(cond, bar) do { unsigned _sp = 0; while (cond) { __builtin_amdgcn_s_sleep(1); \
    if ((++_sp & 255u) == 0u) { if (xb_ld(&(bar)[XB_TMO])) break; if (_sp > XB_SPIN_CAP) { atomicAdd(&(bar)[XB_TMO], 1u); break; } } } } while (0)

struct XcdBarrier {
    unsigned* bar; unsigned x;
    volatile XLAS unsigned* st;
};

__device__ __forceinline__ XcdBarrier xcd_barrier_post(unsigned* bar, volatile XLAS unsigned* st) {
    XcdBarrier b; b.bar = bar; b.x = xb_xcc_id(); b.st = st;
    if (threadIdx.x == 0) (void)xb_add(&bar[XB_XCNT(b.x)], 1u);
    return b;
}
__device__ __forceinline__ void xcd_barrier_complete(unsigned* bar, unsigned x, unsigned& nloc, unsigned& nx) {
    const unsigned G = gridDim.x * gridDim.y * gridDim.z;
    unsigned sum, cnt, mine, sp = 0u;
    for (;;) {
        sum = 0u; cnt = 0u; mine = 0u;
#pragma unroll
        for (unsigned j = 0; j < 16; ++j) { const unsigned c = xb_ld(&bar[XB_XCNT(j)]); sum += c; cnt += (c > 0u) ? 1u : 0u; mine = (j == x) ? c : mine; }
        if (sum == G) break;
        __builtin_amdgcn_s_sleep(1);
        if ((++sp & 255u) == 0u) { if (xb_ld(&bar[XB_TMO])) break; if (sp > XB_SPIN_CAP) { atomicAdd(&bar[XB_TMO], 1u); break; } }
    }
    nloc = mine > 0u ? mine : 1u; nx = cnt > 0u ? cnt : 1u;
}

__device__ __forceinline__ void xcd_barrier(const XcdBarrier& b) {
    asm volatile("s_waitcnt vmcnt(0)" ::: "memory");
    __syncthreads();
    if (threadIdx.x == 0) {
        unsigned* bar = b.bar;
        __builtin_amdgcn_s_waitcnt(0);
        unsigned nloc = b.st[0], nx = b.st[1];
        if (nloc == 0u) { xcd_barrier_complete(bar, b.x, nloc, nx); b.st[0] = nloc; b.st[1] = nx; }
        const unsigned old = xb_add(&bar[XB_XSUB(b.x)], 1u);
        const unsigned gen = old / nloc;
        if (old + 1u == (gen + 1u) * nloc) {
            __builtin_amdgcn_fence(__ATOMIC_RELEASE, "agent");
            asm volatile("s_waitcnt vmcnt(0)" ::: "memory");
            const unsigned og = xb_add(&bar[XB_TOP], 1u);
            const unsigned tg = og / nx;
            if (og + 1u == (tg + 1u) * nx) xb_add(&bar[XB_TOPGEN], 1u);
            else XB_SPIN(xb_ld(&bar[XB_TOPGEN]) == tg, bar);
            __builtin_amdgcn_fence(__ATOMIC_ACQUIRE, "agent");
            xb_add(&bar[XB_XGEN(b.x)], 1u);
            asm volatile("s_waitcnt vmcnt(0)" ::: "memory");
        } else {
            XB_SPIN(xb_ld(&bar[XB_XGEN(b.x)]) == gen, bar);
            __builtin_amdgcn_fence(__ATOMIC_ACQUIRE, "agent");
            asm volatile("s_waitcnt vmcnt(0)" ::: "memory");
        }
    }
    __syncthreads();
}

__global__ void __launch_bounds__(NTHREADS) mega(Params p, int ph_lo, int ph_hi) {
  extern __shared__ __attribute__((aligned(16))) char smem[];
  cg::grid_group grid = cg::this_grid();
  volatile XLAS unsigned* xst = (volatile XLAS unsigned*)(smem + 132096);
  if (tid_() == 0) { xst[0] = 0u; xst[1] = 0u; }
  __syncthreads();
  XcdBarrier xb = xcd_barrier_post((unsigned*)(p.ws + OFF_BAR), xst);
  for (int ph = ph_lo; ph < ph_hi; ++ph) {
    const int layer = ph >> 4, sp = ph & 15;
    switch (sp) {
      case 0:
      case 13:
        if (sp == 0 && blockIdx.x == 0) {
          const int t0_ = tid_();
          if (t0_ == 0) ((int*)(p.ws + OFF_CTR))[layer] = 0;
          if (t0_ < 384) ((u32*)(p.ws + OFF_FLAG))[layer * 384 + t0_] = 0u;
        }
        phase_norm(p, ph == 0, (sp == 0 ? p.in[2] : p.in[33]) + layer * 1024, (u16*)(p.ws + OFF_HN), 0, NTOK);
        if (sp == 0) conv_ffn(p, layer, 0, smem);
        break;
      case 1:
      case 14:
        phase_ffn_a(p, smem);
        break;
      case 2:
      case 15:
        phase_ffn_b(p, ph == 2, smem);
        if (sp == 2) conv_mix(p, layer, smem);
        break;
      case 3:
      case 5:
      case 10: {
        const bool full = (sp == 10);
        const long lo = full ? 0 : (sp == 3 ? 0 : 32768), hi = full ? NTOK : lo + 32768;
        phase_norm(p, false, p.in[6] + layer * 1024, (u16*)(p.ws + (full ? OFF_HN2 : OFF_Y)), lo, hi);
        break;
      }
      case 4:
      case 6:
        phase_proj(p, sp == 6, smem);
        break;
      case 7: phase_mixer1(p, layer, smem); break;
      case 8: phase_s5p2(p, layer, smem); break;
      case 9: phase_glu(p, smem); break;
      case 11: phase_m(p, smem); break;
      case 12:
        phase_out(p, smem);
        conv_ffn(p, layer, 1, smem);
        break;
    }
    if (ph + 1 < ph_hi) {
      if (ph == ph_lo) {
        asm volatile("s_waitcnt vmcnt(0)" ::: "memory");
        __syncthreads();
        if (tid_() < 64) {
          __builtin_amdgcn_fence(__ATOMIC_RELEASE, "agent");
          asm volatile("s_waitcnt vmcnt(0)" ::: "memory");
        }
        grid.sync();
        if (tid_() < 64) {
          __builtin_amdgcn_fence(__ATOMIC_ACQUIRE, "agent");
          asm volatile("s_waitcnt vmcnt(0)" ::: "memory");
        }
        __syncthreads();
      } else {
        xcd_barrier(xb);
      }
    }
  }
}

extern "C" void kernel_launch(void* const* d_in, const int* in_sizes, int n_in, void* d_out, int out_size, void* d_ws,
                              size_t ws_size, hipStream_t stream) {
  static int grid_blocks = 0;
  if (!grid_blocks) {
    int dev = 0, cus = 0, per_cu = 0;
    hipGetDevice(&dev);
    hipDeviceGetAttribute(&cus, hipDeviceAttributeMultiprocessorCount, dev);
    hipFuncSetAttribute((const void*)mega, hipFuncAttributeMaxDynamicSharedMemorySize, SMEM_BYTES);
    hipOccupancyMaxActiveBlocksPerMultiprocessor(&per_cu, mega, NTHREADS, SMEM_BYTES);
    if (per_cu < 1) per_cu = 1;
    grid_blocks = cus * per_cu;
  }
  if (ws_size < (size_t)WS_NEED) {
    fprintf(stderr, "workspace too small: %zu\n", ws_size);
    return;
  }
  Params p{};
  for (int i = 0; i < 37; ++i) p.in[i] = (const float*)d_in[i];
  p.out = (float*)d_out;
  p.ws = (char*)d_ws;
  hipMemsetAsync((char*)d_ws + OFF_BAR, 0, XCD_BAR_WORDS * sizeof(unsigned), stream);
#ifndef ONE_LAUNCH
  for (int ph = 0; ph < 32; ++ph) {
    hipLaunchKernelGGL(mega, dim3(grid_blocks), dim3(NTHREADS), SMEM_BYTES, stream, p, ph, ph + 1);
  }
#else
  int lo = 0, hi = 32;
  void* args[] = {&p, &lo, &hi};
  hipError_t e = hipLaunchCooperativeKernel((const void*)mega, dim3(grid_blocks), dim3(NTHREADS), args, SMEM_BYTES, stream);
  if (e != hipSuccess) fprintf(stderr, "cooperative launch failed: %s (grid %d)\n", hipGetErrorString(e), grid_blocks);
#endif
}
```

```cpp
#include <hip/hip_runtime.h>
#include <hip/hip_cooperative_groups.h>
#include <cstdio>
namespace cg = cooperative_groups;

typedef unsigned short u16;
typedef unsigned int u32;
typedef unsigned long long u64;
typedef __attribute__((ext_vector_type(8))) short bf16x8;
typedef __attribute__((ext_vector_type(16))) float f32x16;
typedef __attribute__((ext_vector_type(4))) float f32x4;
typedef __bf16 bf2_t __attribute__((ext_vector_type(2)));
typedef float f2_t __attribute__((ext_vector_type(2)));

#define ONE_LAUNCH 1
#define NTOK 65536
#define NTHREADS 512
#define SMEM_BYTES 135168
#define AS_BYTES 36864
#define BS_BYTES 18432
#define MISC_OFF 110592

#define OFF_A 0L
#define OFF_Z 167772160L
#define OFF_Y 419430400L
#define OFF_H 0L
#define OFF_HN2 0L
#define OFF_M 134217728L
#define OFF_YA 268435456L
#define OFF_YB 335544320L
#define OFF_SCR0 402653184L
#define OFF_F 369098752L
#define OFF_FD (OFF_F + 11534336L)
#define OFF_HN 386400256L
#define OFF_WM 486539264L
#define OFF_WIN OFF_WM
#define OFF_WGLU (OFF_WM + 12845056L)
#define OFF_WB (OFF_WGLU + 524288L)
#define OFF_WOUT (OFF_WB + 3145728L)
#define OFF_CAR 505151488L
#define OFF_CTR 521928704L
#define OFF_BAR 521936896L
#define WS_NEED 521952256L

struct Params {
  const float* in[37];
  float* out;
  char* ws;
};

__device__ __forceinline__ int tid_() {
  int t = threadIdx.x;
  asm volatile("" : "+v"(t));
  return t;
}
__device__ __forceinline__ u32 pack2(float a, float b) {
  f2_t v = {a, b};
  bf2_t r = __builtin_convertvector(v, bf2_t);
  return *(u32*)&r;
}
__device__ __forceinline__ u16 f2bf(float a) { return (u16)(pack2(a, 0.f) & 0xffffu); }
__device__ __forceinline__ float bflo(u32 v) { return __uint_as_float(v << 16); }
__device__ __forceinline__ float bfhi(u32 v) { return __uint_as_float(v & 0xffff0000u); }
__device__ __forceinline__ float sigm(float x) { return 1.f / (1.f + __expf(-x)); }
__device__ __forceinline__ float dpp_xor1(float v) {
  return __int_as_float(__builtin_amdgcn_mov_dpp(__float_as_int(v), 0xB1, 0xF, 0xF, true));
}
__device__ __forceinline__ float frcp(float x) { return __builtin_amdgcn_rcpf(x); }
__device__ __forceinline__ float fsig(float x) { return __builtin_amdgcn_rcpf(1.f + __expf(-x)); }
__device__ __forceinline__ float dpp_ror1(float v) {
  return __int_as_float(__builtin_amdgcn_mov_dpp(__float_as_int(v), 0x121, 0xF, 0xF, true));
}
__device__ __forceinline__ float dpp_ror2(float v) {
  return __int_as_float(__builtin_amdgcn_mov_dpp(__float_as_int(v), 0x122, 0xF, 0xF, true));
}
__device__ __forceinline__ float dpp_ror4(float v) {
  return __int_as_float(__builtin_amdgcn_mov_dpp(__float_as_int(v), 0x124, 0xF, 0xF, true));
}
__device__ __forceinline__ float dpp_ror8(float v) {
  return __int_as_float(__builtin_amdgcn_mov_dpp(__float_as_int(v), 0x128, 0xF, 0xF, true));
}
__device__ __forceinline__ float dpp_xor2(float v) {
  return __int_as_float(__builtin_amdgcn_mov_dpp(__float_as_int(v), 0x4E, 0xF, 0xF, true));
}

namespace pg8 {
#define PG8_LAS __attribute__((address_space(3)))
typedef unsigned short bf16_t;
typedef short bf16x8 __attribute__((ext_vector_type(8)));
typedef float f32x4 __attribute__((ext_vector_type(4)));
typedef unsigned u32x4 __attribute__((ext_vector_type(4)));
constexpr int BM = 256, BK = 64, HALF = 128, HTB = HALF * BK * 2  , STAGE_BYTES = 8 * HTB, NXCD = 8, WGM = 8;

__host__ __device__ __forceinline__ int lds_byte(int r, int c) { const int st = (r >> 4) * 2 + (c >> 5), rr = r & 15, cc = c & 31, ob = rr * 64 + cc * 2; return st * 1024 + (ob ^ (((ob >> 9) & 1) << 5)); }
__host__ __device__ __forceinline__ void stage_rc(int b, int& R, int& C) { const int st = b / 1024, sb = b % 1024, swz = sb ^ (((sb >> 9) & 1) << 5); R = (st >> 1) * 16 + swz / 64; C = (st & 1) * 32 + (swz % 64) / 2; }
__host__ __device__ __forceinline__ int perm32(int rho) { const int n = rho >> 4, i = rho & 15; return 8 * (i >> 2) + 4 * n + (i & 3); }
struct Unit { int pm, pn; };
struct Gemm { const bf16_t* A; const bf16_t* Bt; int M, N, K, lda, ldb; };
struct StaticOrder {
    int nM, nN, nwg, G, c;
    __host__ __device__ void init(int M, int N, int G_, int c_) { nM = M / BM; nN = N / BM; nwg = nM * nN; G = G_; c = c_; }
    __host__ __device__ bool next(int i, Unit& u) const {
        const long L = (long)i * G + c; if (L >= nwg) return false;
        int wgid = (int)L; { const int q = nwg / NXCD, r = nwg % NXCD, xcd = wgid % NXCD, off = wgid / NXCD; wgid = (xcd < r ? xcd * (q + 1) : r * (q + 1) + (xcd - r) * q) + off; }
        const int nig = WGM * nN, gid = wgid / nig, fm = gid * WGM, gsz = (nM - fm) < WGM ? (nM - fm) : WGM;
        u.pm = fm + ((wgid % nig) % gsz); u.pn = (wgid % nig) / gsz; return true;
    }
    __device__ __forceinline__ void a_ready(const Unit&) const {}
    __device__ __forceinline__ void done(const Unit&) const {}
};
template <class Epi, class Sched, bool STAMP = false>
__device__ __forceinline__ void gemm_phase(PG8_LAS unsigned char* lds, const Gemm g, const Sched& S, const Epi& E, unsigned long long* stamps) {
    const int tid = tid_(), wid = __builtin_amdgcn_readfirstlane(tid >> 6), lane = tid & 63, wr = wid >> 2, wc = wid & 3, fr = lane & 15, fq = lane >> 4;
    const int K = g.K, nt = K / BK;
    int ts_lo = 0, ts_hi = 0, nts = 0; const unsigned long long rt_entry = STAMP ? 0ull : 0ull;
#define PG8_STAMP() do { if (STAMP && wid == 0 && nts < 64) { const unsigned long long _c = (unsigned long long)clock64(); \
        ts_lo = (lane == nts) ? (int)(unsigned)_c : ts_lo; ts_hi = (lane == nts) ? (int)(unsigned)(_c >> 32) : ts_hi; ++nts; } } while (0)
    PG8_STAMP();
    unsigned voffA[2], voffB[2];
#pragma unroll
    for (int i = 0; i < 2; ++i) { int R, C; stage_rc(tid * 16 + i * 8192, R, C); const int Rb = Epi::PERM ? ((R & ~31) + perm32(R & 31)) : R;
        voffA[i] = (unsigned)(R * g.lda + C) * 2u; voffB[i] = (unsigned)(Rb * g.ldb + C) * 2u; }
    const size_t kstep = (size_t)(BK * 2);
    const size_t hstepA = (size_t)HALF * g.lda * 2, hstepB = (size_t)HALF * g.ldb * 2;
    const size_t tstepA = 2 * hstepA, tstepB = 2 * hstepB;
    const unsigned ldsw = (unsigned)wid * 1024u;
    const int aoff = lds_byte(wr * 64 + fr, fq * 8), boff = lds_byte(wc * 32 + fr, fq * 8);
#define PG8_SA(b, h) (((b) * 2 + (h)) * HTB)
#define PG8_SB(b, h) ((4 + (b) * 2 + (h)) * HTB)
#define PG8_STAGE(bufoff, gbase, voff) do { _Pragma("unroll") for (int _i = 0; _i < 2; ++_i) \
        __builtin_amdgcn_global_load_lds((const unsigned*)((const char*)(gbase) + (voff)[_i]), (PG8_LAS unsigned*)(lds + (bufoff) + ldsw + _i * 8192), 16, 0, 0); } while (0)
#define PG8_LDA(dst, b, h) do { _Pragma("unroll") for (int m = 0; m < 4; ++m) _Pragma("unroll") for (int k = 0; k < 2; ++k) dst[m][k] = *(const PG8_LAS bf16x8*)(lds + PG8_SA(b, h) + aoff + m * 2048 + k * 1024); } while (0)
#define PG8_LDB(dst, b, h) do { _Pragma("unroll") for (int n = 0; n < 2; ++n) _Pragma("unroll") for (int k = 0; k < 2; ++k) dst[n][k] = *(const PG8_LAS bf16x8*)(lds + PG8_SB(b, h) + boff + n * 2048 + k * 1024); } while (0)
#define PG8_MMA(ai, bj, At, Bt) do { __builtin_amdgcn_s_setprio(1); _Pragma("unroll") for (int m = 0; m < 4; ++m) _Pragma("unroll") for (int n = 0; n < 2; ++n) _Pragma("unroll") for (int k = 0; k < 2; ++k) \
        acc[ai][bj][m][n] = __builtin_amdgcn_mfma_f32_16x16x32_bf16(Bt[n][k], At[m][k], acc[ai][bj][m][n], 0, 0, 0); __builtin_amdgcn_s_setprio(0); } while (0)
#define PG8_WAIT_V(n) asm volatile("s_waitcnt vmcnt(" #n ")" ::: "memory")
#define PG8_WAIT_L(n) asm volatile("s_waitcnt lgkmcnt(" #n ")" ::: "memory")
#define PG8_BAR __builtin_amdgcn_s_barrier()
#define PG8_SCHED __builtin_amdgcn_sched_barrier(0)
    Unit cur, nxt; int ui = 0;
    if (!S.next(0, cur)) return;
    f32x4 acc[2][2][4][2];
#pragma unroll
    for (int a = 0; a < 2; ++a)
#pragma unroll
        for (int b = 0; b < 2; ++b)
#pragma unroll
            for (int m = 0; m < 4; ++m)
#pragma unroll
                for (int n = 0; n < 2; ++n) acc[a][b][m][n] = (f32x4){0.f, 0.f, 0.f, 0.f};
    bf16x8 At[4][2], B0[2][2], B1[2][2];
    const char* cA = (const char*)g.A + (size_t)cur.pm * tstepA; const char* cB = (const char*)g.Bt + (size_t)cur.pn * tstepB;
    S.a_ready(cur);
    PG8_STAGE(PG8_SB(0, 0), cB, voffB); PG8_STAGE(PG8_SA(0, 0), cA, voffA); PG8_STAGE(PG8_SB(0, 1), cB + hstepB, voffB); PG8_STAGE(PG8_SA(0, 1), cA + hstepA, voffA);
    if (wr == 1) PG8_BAR;
    PG8_WAIT_V(4); PG8_BAR;
    PG8_STAGE(PG8_SB(1, 0), cB + kstep, voffB); PG8_STAGE(PG8_SA(1, 0), cA + kstep, voffA); PG8_STAGE(PG8_SB(1, 1), cB + hstepB + kstep, voffB);
    PG8_WAIT_V(6); PG8_BAR;
    PG8_STAMP();
    for (;;) {
        const bool has_next = S.next(ui + 1, nxt);
        const char* nA = has_next ? (const char*)g.A + (size_t)nxt.pm * tstepA : cA; const char* nB = has_next ? (const char*)g.Bt + (size_t)nxt.pn * tstepB : cB;
        for (int t = 0; t < nt; t += 2) {
            const bool last = (t == nt - 2);
            const char* a1 = cA + (size_t)(t + 1) * kstep;
            const char* a2 = last ? nA : cA + (size_t)(t + 2) * kstep; const char* b2 = last ? nB : cB + (size_t)(t + 2) * kstep;
            const char* a3 = a2 + kstep; const char* b3 = b2 + kstep;
            if (last && has_next) S.a_ready(nxt);
            PG8_LDB(B0, 0, 0); PG8_SCHED; PG8_LDA(At, 0, 0); PG8_STAGE(PG8_SA(1, 1), a1 + hstepA, voffA);
            PG8_WAIT_L(8); PG8_BAR; PG8_WAIT_L(0); PG8_MMA(0, 0, At, B0); PG8_BAR; PG8_SCHED;
            PG8_LDB(B1, 0, 1); PG8_STAGE(PG8_SB(0, 0), b2, voffB);
            PG8_BAR; PG8_WAIT_L(0); PG8_MMA(0, 1, At, B1); PG8_BAR;
            PG8_LDA(At, 0, 1); PG8_STAGE(PG8_SA(0, 0), a2, voffA);
            PG8_BAR; PG8_WAIT_L(0); PG8_MMA(1, 0, At, B0); PG8_BAR; PG8_SCHED;
            PG8_STAGE(PG8_SB(0, 1), b2 + hstepB, voffB);
            PG8_WAIT_V(6); PG8_BAR; PG8_MMA(1, 1, At, B1); PG8_BAR;
            PG8_LDB(B0, 1, 0); PG8_SCHED; PG8_LDA(At, 1, 0); PG8_STAGE(PG8_SA(0, 1), a2 + hstepA, voffA);
            PG8_WAIT_L(8); PG8_BAR; PG8_WAIT_L(0); PG8_MMA(0, 0, At, B0); PG8_BAR; PG8_SCHED;
            PG8_LDB(B1, 1, 1); PG8_STAGE(PG8_SB(1, 0), b3, voffB);
            PG8_BAR; PG8_WAIT_L(0); PG8_MMA(0, 1, At, B1); PG8_BAR;
            PG8_LDA(At, 1, 1); PG8_STAGE(PG8_SA(1, 0), a3, voffA);
            PG8_BAR; PG8_WAIT_L(0); PG8_MMA(1, 0, At, B0); PG8_BAR; PG8_SCHED;
            PG8_STAGE(PG8_SB(1, 1), b3 + hstepB, voffB);
            PG8_WAIT_V(6); PG8_BAR; PG8_MMA(1, 1, At, B1); PG8_BAR;
        }
        PG8_STAMP();
        if constexpr (!Epi::AFTER_DRAIN) { E(acc, cur, wr, wc, fr, fq); S.done(cur); }
        PG8_STAMP();
        if (!has_next) break;
#pragma unroll
        for (int a = 0; a < 2; ++a)
#pragma unroll
            for (int b = 0; b < 2; ++b)
#pragma unroll
                for (int m = 0; m < 4; ++m)
#pragma unroll
                    for (int n = 0; n < 2; ++n) acc[a][b][m][n] = (f32x4){0.f, 0.f, 0.f, 0.f};
        cur = nxt; cA = nA; cB = nB; ++ui;
    }
    PG8_WAIT_V(0);
    if (wr == 0) PG8_BAR;
    PG8_BAR;
    if constexpr (Epi::AFTER_DRAIN) { E.fused(acc, cur, wr, wc, fr, fq, lds, wid, lane); S.done(cur); }
    PG8_STAMP();
    if (STAMP && wid == 0) { stamps[lane] = lane < nts ? (((unsigned long long)(unsigned)ts_hi << 32) | (unsigned)ts_lo) : 0ull;
        if (lane == 62) stamps[62] = rt_entry; if (lane == 63) stamps[63] = 0ull; }
#undef PG8_STAMP
#undef PG8_SA
#undef PG8_SB
#undef PG8_STAGE
#undef PG8_LDA
#undef PG8_LDB
#undef PG8_MMA
#undef PG8_WAIT_V
#undef PG8_WAIT_L
#undef PG8_BAR
#undef PG8_SCHED
}
}

struct EpiSwiglu {
  static constexpr bool PERM = true, AFTER_DRAIN = false;
  u16* H;
  __device__ __forceinline__ void operator()(const pg8::f32x4 (&acc)[2][2][4][2], const pg8::Unit& u, int wr, int wc, int fr,
                                             int fq) const {
    const int row0 = u.pm * 256 + wr * 64 + fr, col0 = u.pn * 128 + wc * 32 + 8 * fq;
#pragma unroll
    for (int ai = 0; ai < 2; ++ai)
#pragma unroll
      for (int m = 0; m < 4; ++m) {
        u16* rowp = H + (size_t)(row0 + ai * 128 + m * 16) * 2816 + col0;
        float v[8];
#pragma unroll
        for (int n = 0; n < 2; ++n)
#pragma unroll
          for (int j = 0; j < 4; ++j) {
            float g = acc[ai][0][m][n][j], uu = acc[ai][1][m][n][j];
            v[4 * n + j] = g * fsig(g) * uu;
          }
        uint4 o;
        o.x = pack2(v[0], v[1]); o.y = pack2(v[2], v[3]); o.z = pack2(v[4], v[5]); o.w = pack2(v[6], v[7]);
        *(uint4*)rowp = o;
      }
  }
};
struct EpiRes {
  static constexpr bool PERM = false, AFTER_DRAIN = false;
  float* out; const float* r0; const float* r1; float scale;
  __device__ __forceinline__ void operator()(const pg8::f32x4 (&acc)[2][2][4][2], const pg8::Unit& u, int wr, int wc, int fr,
                                             int fq) const {
    const int row0 = u.pm * 256 + wr * 64 + fr, col0 = u.pn * 256 + wc * 32 + 4 * fq;
#pragma unroll
    for (int ai = 0; ai < 2; ++ai)
#pragma unroll
      for (int m = 0; m < 4; ++m) {
        const long row = row0 + ai * 128 + m * 16;
        const float* rp = (r1 != nullptr && row >= 32768) ? r1 + (row - 32768) * 1024 : r0 + row * 1024;
        float* op = out + row * 1024;
#pragma unroll
        for (int bj = 0; bj < 2; ++bj)
#pragma unroll
          for (int n = 0; n < 2; ++n) {
            const int c = col0 + bj * 128 + n * 16;
            float4 x = *(const float4*)(rp + c);
            pg8::f32x4 a = acc[ai][bj][m][n];
            float4 o = make_float4(x.x + scale * a[0], x.y + scale * a[1], x.z + scale * a[2], x.w + scale * a[3]);
            *(float4*)(op + c) = o;
          }
      }
  }
};
struct EpiGlu {
  static constexpr bool PERM = true, AFTER_DRAIN = false;
  const u16* RA; u16* YA;
  __device__ __forceinline__ void operator()(const pg8::f32x4 (&acc)[2][2][4][2], const pg8::Unit& u, int wr, int wc, int fr,
                                             int fq) const {
    const int row0 = u.pm * 256 + wr * 64 + fr, col0 = u.pn * 256 + wc * 32 + 8 * fq;
#pragma unroll
    for (int ai = 0; ai < 2; ++ai)
#pragma unroll
      for (int m = 0; m < 4; ++m) {
        const long row = row0 + ai * 128 + m * 16;
#pragma unroll
        for (int bj = 0; bj < 2; ++bj) {
          const int c = col0 + bj * 128;
          uint4 y = *(const uint4*)(RA + row * 1280 + c);
          pg8::f32x4 a0 = acc[ai][bj][m][0], a1 = acc[ai][bj][m][1];
          uint4 o;
          o.x = pack2(bflo(y.x) * fsig(a0[0]), bfhi(y.x) * fsig(a0[1]));
          o.y = pack2(bflo(y.y) * fsig(a0[2]), bfhi(y.y) * fsig(a0[3]));
          o.z = pack2(bflo(y.z) * fsig(a1[0]), bfhi(y.z) * fsig(a1[1]));
          o.w = pack2(bflo(y.w) * fsig(a1[2]), bfhi(y.w) * fsig(a1[3]));
          *(uint4*)(YA + row * 512 + c) = o;
        }
      }
  }
};
struct EpiProj {
  static constexpr bool PERM = true, AFTER_DRAIN = false;
  u16* RA; u16* RZ; int row_off;
  __device__ __forceinline__ void operator()(const pg8::f32x4 (&acc)[2][2][4][2], const pg8::Unit& u, int wr, int wc, int fr,
                                             int fq) const {
    const int row0 = row_off + u.pm * 256 + wr * 64 + fr, col0 = u.pn * 256 + wc * 32 + 8 * fq;
#pragma unroll
    for (int ai = 0; ai < 2; ++ai)
#pragma unroll
      for (int m = 0; m < 4; ++m) {
        const long row = row0 + ai * 128 + m * 16;
#pragma unroll
        for (int bj = 0; bj < 2; ++bj) {
          const int c = col0 + bj * 128;
          if (c >= 3200) continue;
          u16* dst = (c < 1280) ? RA + row * 1280 + c : RZ + row * 1920 + (c - 1280);
          pg8::f32x4 a0 = acc[ai][bj][m][0], a1 = acc[ai][bj][m][1];
          uint4 o;
          o.x = pack2(a0[0], a0[1]); o.y = pack2(a0[2], a0[3]); o.z = pack2(a1[0], a1[1]); o.w = pack2(a1[2], a1[3]);
          *(uint4*)dst = o;
        }
      }
  }
};
struct EpiGate {
  static constexpr bool PERM = true, AFTER_DRAIN = false;
  uint4* scr;
  __device__ __forceinline__ void operator()(const pg8::f32x4 (&acc)[2][2][4][2], const pg8::Unit& u, int wr, int wc, int fr,
                                             int fq) const {
    const int t = (wr * 4 + wc) * 64 + fq * 16 + fr;
#pragma unroll
    for (int ai = 0; ai < 2; ++ai)
#pragma unroll
      for (int m = 0; m < 4; ++m)
#pragma unroll
        for (int bj = 0; bj < 2; ++bj) {
          pg8::f32x4 a0 = acc[ai][bj][m][0], a1 = acc[ai][bj][m][1];
          uint4 o;
          o.x = pack2(fsig(a0[0]), fsig(a0[1])); o.y = pack2(fsig(a0[2]), fsig(a0[3]));
          o.z = pack2(fsig(a1[0]), fsig(a1[1])); o.w = pack2(fsig(a1[2]), fsig(a1[3]));
          scr[((ai * 4 + m) * 2 + bj) * 512 + t] = o;
        }
  }
};
struct EpiUp {
  static constexpr bool PERM = true, AFTER_DRAIN = false;
  const uint4* scr; u16* Mo; bool first;
  __device__ __forceinline__ void operator()(const pg8::f32x4 (&acc)[2][2][4][2], const pg8::Unit& u, int wr, int wc, int fr,
                                             int fq) const {
    const int t = (wr * 4 + wc) * 64 + fq * 16 + fr;
    const int row0 = u.pm * 256 + wr * 64 + fr, col0 = u.pn * 256 + wc * 32 + 8 * fq;
#pragma unroll
    for (int ai = 0; ai < 2; ++ai)
#pragma unroll
      for (int m = 0; m < 4; ++m) {
        const long row = row0 + ai * 128 + m * 16;
#pragma unroll
        for (int bj = 0; bj < 2; ++bj) {
          uint4 g = scr[((ai * 4 + m) * 2 + bj) * 512 + t];
          pg8::f32x4 a0 = acc[ai][bj][m][0], a1 = acc[ai][bj][m][1];
          float v[8] = {bflo(g.x) * a0[0], bfhi(g.x) * a0[1], bflo(g.y) * a0[2], bfhi(g.y) * a0[3],
                        bflo(g.z) * a1[0], bfhi(g.z) * a1[1], bflo(g.w) * a1[2], bfhi(g.w) * a1[3]};
          u16* mp = Mo + row * 1024 + col0 + bj * 128;
          if (!first) {
            uint4 o = *(const uint4*)mp;
            v[0] += bflo(o.x); v[1] += bfhi(o.x); v[2] += bflo(o.y); v[3] += bfhi(o.y);
            v[4] += bflo(o.z); v[5] += bfhi(o.z); v[6] += bflo(o.w); v[7] += bfhi(o.w);
          }
          uint4 w;
          w.x = pack2(v[0], v[1]); w.y = pack2(v[2], v[3]); w.z = pack2(v[4], v[5]); w.w = pack2(v[6], v[7]);
          *(uint4*)mp = w;
        }
      }
  }
};
struct OneUnit {
  int pm, pn;
  __device__ __forceinline__ bool next(int i, pg8::Unit& u) const { if (i) return false; u.pm = pm; u.pn = pn; return true; }
  __device__ __forceinline__ void a_ready(const pg8::Unit&) const {}
  __device__ __forceinline__ void done(const pg8::Unit&) const {}
};
template <class Epi>
__device__ __forceinline__ void run_gemm8(char* smem, const u16* A, const u16* Bt, int N, int K, int lda, int ldb, const Epi& E,
                                          int M = NTOK) {
  pg8::Gemm g{A, Bt, M, N, K, lda, ldb};
  pg8::StaticOrder S;
  S.init(M, N, (int)gridDim.x, (int)blockIdx.x);
  pg8::gemm_phase<Epi, pg8::StaticOrder, false>((PG8_LAS unsigned char*)smem, g, S, E, nullptr);
}

__device__ __forceinline__ float row16_sum(float v) {
  v += dpp_ror1(v);
  v += dpp_ror2(v);
  v += dpp_ror4(v);
  v += dpp_ror8(v);
  return v;
}
template <bool AF32, int NI>
__device__ __forceinline__ void gemm_loop(const void* Aptr, long lda, const u16* Bt, long ldb, int K,
                                          f32x16 (&acc)[2][NI], float& ss, char* smem) {
  const int tid = tid_(), lane = tid & 63, w = tid >> 6;
  const int wm = w >> 1, wn = w & 1, lr = lane & 31, lh = lane >> 5;
  const int arow = tid >> 1, ahalf = tid & 1;
  const int brow = (NI == 2) ? (tid >> 2) : (tid >> 3), bq = (NI == 2) ? (tid & 3) : (tid & 7);
  const int nk = K >> 6;
  float4 raf[8];
  uint4 rab[4];
  uint4 rb[2];
  const float* Af = (const float*)Aptr + (long)arow * lda + 32 * ahalf;
  const u16* Ab = (const u16*)Aptr + (long)arow * lda + 32 * ahalf;
  const u16* Bp = Bt + (long)brow * ldb + 8 * NI * bq;
  char* a_dst = smem + arow * 144 + ahalf * 64;
  char* b_dst = smem + AS_BYTES + brow * 144 + bq * 16 * NI;
  const char* a_src = smem + (wm * 64 + lr) * 144 + lh * 16;
  const char* b_src = smem + AS_BYTES + (wn * 32 * NI + lr) * 144 + lh * 16;

#define G_LOAD(kt)                                                                       \
  {                                                                                      \
    if (AF32) {                                                                          \
      _Pragma("unroll") for (int i = 0; i < 8; ++i) raf[i] = *(const float4*)(Af + (kt) * 64 + 4 * i); \
    } else {                                                                             \
      _Pragma("unroll") for (int i = 0; i < 4; ++i) rab[i] = *(const uint4*)(Ab + (kt) * 64 + 8 * i); \
    }                                                                                    \
    rb[0] = *(const uint4*)(Bp + (kt) * 64);                                             \
    if (NI == 2) rb[1] = *(const uint4*)(Bp + (kt) * 64 + 8);                            \
  }
#define G_STORE(buf)                                                                     \
  {                                                                                      \
    char* ad = a_dst + (buf) * (AS_BYTES + BS_BYTES);                                    \
    char* bd = b_dst + (buf) * (AS_BYTES + BS_BYTES);                                    \
    if (AF32) {                                                                          \
      _Pragma("unroll") for (int i = 0; i < 4; ++i) {                                    \
        float4 x0 = raf[2 * i], x1 = raf[2 * i + 1];                                     \
        ss += x0.x * x0.x + x0.y * x0.y + x0.z * x0.z + x0.w * x0.w;                     \
        ss += x1.x * x1.x + x1.y * x1.y + x1.z * x1.z + x1.w * x1.w;                     \
        uint4 o;                                                                         \
        o.x = pack2(x0.x, x0.y); o.y = pack2(x0.z, x0.w);                                \
        o.z = pack2(x1.x, x1.y); o.w = pack2(x1.z, x1.w);                                \
        *(uint4*)(ad + 16 * i) = o;                                                      \
      }                                                                                  \
    } else {                                                                             \
      _Pragma("unroll") for (int i = 0; i < 4; ++i) *(uint4*)(ad + 16 * i) = rab[i];     \
    }                                                                                    \
    *(uint4*)(bd) = rb[0];                                                               \
    if (NI == 2) *(uint4*)(bd + 16) = rb[1];                                             \
  }

  G_LOAD(0);
  G_STORE(0);
  __syncthreads();
  for (int kt = 0; kt < nk; ++kt) {
    const int buf = kt & 1;
    if (kt + 1 < nk) G_LOAD(kt + 1);
    const char* as = a_src + buf * (AS_BYTES + BS_BYTES);
    const char* bs = b_src + buf * (AS_BYTES + BS_BYTES);
#pragma unroll
    for (int kk = 0; kk < 4; ++kk) {
      bf16x8 a0 = *(const bf16x8*)(as + kk * 32);
      bf16x8 a1 = *(const bf16x8*)(as + 32 * 144 + kk * 32);
      bf16x8 b0 = *(const bf16x8*)(bs + kk * 32);
      acc[0][0] = __builtin_amdgcn_mfma_f32_32x32x16_bf16(a0, b0, acc[0][0], 0, 0, 0);
      acc[1][0] = __builtin_amdgcn_mfma_f32_32x32x16_bf16(a1, b0, acc[1][0], 0, 0, 0);
      if (NI == 2) {
        bf16x8 b1 = *(const bf16x8*)(bs + 32 * 144 + kk * 32);
        acc[0][NI - 1] = __builtin_amdgcn_mfma_f32_32x32x16_bf16(a0, b1, acc[0][NI - 1], 0, 0, 0);
        acc[1][NI - 1] = __builtin_amdgcn_mfma_f32_32x32x16_bf16(a1, b1, acc[1][NI - 1], 0, 0, 0);
      }
    }
    if (kt + 1 < nk) G_STORE(buf ^ 1);
    __syncthreads();
  }
#undef G_LOAD
#undef G_STORE
}

template <int NI>
__device__ __forceinline__ void zero_acc(f32x16 (&acc)[2][NI]) {
#pragma unroll
  for (int i = 0; i < 2; ++i)
#pragma unroll
    for (int j = 0; j < NI; ++j)
#pragma unroll
      for (int r = 0; r < 16; ++r) acc[i][j][r] = 0.f;
}

__device__ __forceinline__ void publish_rstd(float ss, char* smem) {
  float tot = ss + __shfl_xor(ss, 1);
  float* rs = (float*)(smem + MISC_OFF);
  if ((tid_() & 1) == 0) rs[tid_() >> 1] = rsqrtf(tot * (1.f / 1024.f) + 1e-6f);
  __syncthreads();
}

__device__ __forceinline__ void decode_tile(int id, int NT, int& mt, int& nt) {
  int grp = id / (8 * NT);
  int loc = id - grp * 8 * NT;
  mt = grp * 8 + (loc & 7);
  nt = loc >> 3;
}

__device__ __forceinline__ const float* xin_row(const Params& p, long t) {
  return t < 32768 ? p.in[0] + t * 1024 : p.in[1] + (t - 32768) * 1024;
}

__device__ void conv_tile(const float* src, int N, int K, u16* dst, int rs, int off, int tile, char* smem,
                          const float* gain = nullptr, int sh = 5) {
  const int tid = tid_();
  float* tl = (float*)smem;
  int ntn = N >> 6;
  int kt = tile / ntn, nt = tile - kt * ntn;
  int k0 = kt * 64, n0 = nt * 64;
  __syncthreads();
  {
    int ty = tid >> 6, tx = tid & 63;
#pragma unroll
    for (int i = 0; i < 8; ++i) {
      int k = ty + 8 * i;
      float gv = gain ? gain[k0 + k] : 1.f;
      tl[k * 65 + tx] = src[(long)(k0 + k) * N + n0 + tx] * gv;
    }
  }
  __syncthreads();
  {
    int n = tid >> 3, kq = tid & 7;
    float v[8];
#pragma unroll
    for (int j = 0; j < 8; ++j) v[j] = tl[(8 * kq + j) * 65 + n];
    int nn = n0 + n;
    long drow = (long)(nn >> sh) * rs + (nn & ((1 << sh) - 1)) + off;
    uint4 o;
    o.x = pack2(v[0], v[1]); o.y = pack2(v[2], v[3]); o.z = pack2(v[4], v[5]); o.w = pack2(v[6], v[7]);
    *(uint4*)(dst + drow * K + k0 + 8 * kq) = o;
  }
}

__device__ __forceinline__ void conv_ffn(const Params& p, int layer, int which, char* smem) {
  const float* wg = p.in[which ? 34 : 3] + (long)layer * 1024 * 2816;
  const float* wu = p.in[which ? 35 : 4] + (long)layer * 1024 * 2816;
  const float* wd = p.in[which ? 36 : 5] + (long)layer * 1024 * 2816;
  u16* dgu = (u16*)(p.ws + OFF_F);
  u16* dd = (u16*)(p.ws + OFF_FD);
  for (int j = blockIdx.x; j < 2112; j += gridDim.x) {
    if (j < 704) conv_tile(wg, 2816, 1024, dgu, 256, 0, j, smem, nullptr, 7);
    else if (j < 1408) conv_tile(wu, 2816, 1024, dgu, 256, 128, j - 704, smem, nullptr, 7);
    else conv_tile(wd, 1024, 2816, dd, 32, 0, j - 1408, smem);
  }
}
__device__ __forceinline__ void conv_mix(const Params& p, int layer, char* smem) {
  const float* win = p.in[7] + (long)layer * 1024 * 6272;
  const float* wglu = p.in[16] + (long)layer * 512 * 512;
  const float* wb = p.in[31] + (long)layer * 3 * 512 * 1024;
  const float* wout = p.in[32] + (long)layer * 1024 * 1024;
  for (int j = blockIdx.x; j < 2272; j += gridDim.x) {
    if (j < 1568) conv_tile(win, 6272, 1024, (u16*)(p.ws + OFF_WIN), 32, 0, j, smem);
    else if (j < 1632) conv_tile(wglu, 512, 512, (u16*)(p.ws + OFF_WGLU), 32, 0, j - 1568, smem);
    else if (j < 2016) {
      int jj = j - 1632, i = jj >> 7;
      conv_tile(wb + (long)i * 512 * 1024, 1024, 512, (u16*)(p.ws + OFF_WB) + (long)i * 1024 * 512, 32, 0, jj & 127, smem);
    } else conv_tile(wout, 1024, 1024, (u16*)(p.ws + OFF_WOUT), 32, 0, j - 2016, smem);
  }
}

__device__ __forceinline__ void phase_norm(const Params& p, bool from_in, const float* gain, u16* dst, long row_lo,
                                           long row_hi) {
  const int lane = tid_() & 63, w = tid_() >> 6;
  for (long row = row_lo + (long)blockIdx.x * 8 + w; row < row_hi; row += (long)gridDim.x * 8) {
    const float* src = from_in ? xin_row(p, row) : p.out + row * 1024;
    float4 v[4];
    float ss = 0.f;
#pragma unroll
    for (int i = 0; i < 4; ++i) {
      v[i] = *(const float4*)(src + 4 * (i * 64 + lane));
      ss += v[i].x * v[i].x + v[i].y * v[i].y + v[i].z * v[i].z + v[i].w * v[i].w;
    }
#pragma unroll
    for (int m = 32; m >= 1; m >>= 1) ss += __shfl_xor(ss, m);
    float rstd = rsqrtf(ss * (1.f / 1024.f) + 1e-6f);
#pragma unroll
    for (int i = 0; i < 4; ++i) {
      float4 g = *(const float4*)(gain + 4 * (i * 64 + lane));
      uint2 o;
      o.x = pack2(v[i].x * rstd * g.x, v[i].y * rstd * g.y);
      o.y = pack2(v[i].z * rstd * g.z, v[i].w * rstd * g.w);
      *(uint2*)(dst + (row - row_lo) * 1024 + 4 * (i * 64 + lane)) = o;
    }
  }
}

__device__ __forceinline__ void phase_ffn_a(const Params& p, char* smem) {
  EpiSwiglu E{(u16*)(p.ws + OFF_H)};
  run_gemm8(smem, (const u16*)(p.ws + OFF_HN), (const u16*)(p.ws + OFF_F), 5632, 1024, 1024, 1024, E);
}

__device__ __forceinline__ void phase_ffn_b(const Params& p, bool from_in, char* smem) {
  EpiRes E{p.out, from_in ? p.in[0] : p.out, from_in ? p.in[1] : nullptr, 0.5f};
  run_gemm8(smem, (const u16*)(p.ws + OFF_H), (const u16*)(p.ws + OFF_FD), 1024, 2816, 2816, 2816, E);
}

__device__ __forceinline__ void phase_proj(const Params& p, int half, char* smem) {
  EpiProj E{(u16*)(p.ws + OFF_A), (u16*)(p.ws + OFF_Z), half * 32768};
  run_gemm8(smem, (const u16*)(p.ws + OFF_Y), (const u16*)(p.ws + OFF_WIN), 3328, 1024, 1024, 1024, E, 32768);
}

__device__ __forceinline__ void phase_glu(const Params& p, char* smem) {
  EpiGlu E{(const u16*)(p.ws + OFF_A), (u16*)(p.ws + OFF_YA)};
  run_gemm8(smem, (const u16*)(p.ws + OFF_A), (const u16*)(p.ws + OFF_WGLU), 512, 512, 1280, 512, E);
  const int lane = tid_() & 63, w = tid_() >> 6;
  const u16* RA = (const u16*)(p.ws + OFF_A);
  u16* YB = (u16*)(p.ws + OFF_YB);
  for (long row = (long)blockIdx.x * 8 + w; row < NTOK; row += (long)gridDim.x * 8)
    *(uint4*)(YB + row * 512 + 8 * lane) = *(const uint4*)(RA + row * 1280 + 512 + 8 * lane);
}

__device__ __forceinline__ void phase_m(const Params& p, char* smem) {
  const int b = blockIdx.x;
  uint4* scr = (uint4*)(b < 128 ? p.ws + OFF_SCR0 + (long)b * 131072 : p.ws + OFF_CAR + (long)(b - 128) * 131072);
  const u16* hn2 = (const u16*)(p.ws + OFF_HN2);
  const u16* win = (const u16*)(p.ws + OFF_WIN);
  const u16* wb = (const u16*)(p.ws + OFF_WB);
  u16* Mo = (u16*)(p.ws + OFF_M);
#pragma unroll 1
  for (int u = b; u < 1024; u += gridDim.x) {
    OneUnit S{u & 255, u >> 8};
#pragma unroll 1
    for (int i = 0; i < 3; ++i) {
      {
        pg8::Gemm g{hn2, win + (long)(3200 + 1024 * i) * 1024, NTOK, 1024, 1024, 1024, 1024};
        EpiGate E{scr};
        pg8::gemm_phase<EpiGate, OneUnit, false>((PG8_LAS unsigned char*)smem, g, S, E, nullptr);
      }
      {
        const u16* ya = (const u16*)(p.ws + (i == 0 ? OFF_YA : i == 1 ? OFF_YB : OFF_Y));
        pg8::Gemm g{ya, wb + (long)i * 1024 * 512, NTOK, 1024, 512, 512, 512};
        EpiUp E{(const uint4*)scr, Mo, i == 0};
        pg8::gemm_phase<EpiUp, OneUnit, false>((PG8_LAS unsigned char*)smem, g, S, E, nullptr);
      }
    }
  }
}

__device__ __forceinline__ void phase_out(const Params& p, char* smem) {
  EpiRes E{p.out, p.out, nullptr, 1.0f};
  run_gemm8(smem, (const u16*)(p.ws + OFF_M), (const u16*)(p.ws + OFF_WOUT), 1024, 1024, 1024, 1024, E);
}

#define KS_PITCH 144
#define VT_PITCH 784
__device__ __forceinline__ void attn_item(const Params& p, int layer, int item, char* smem) {
  const int tid = tid_(), lane = tid & 63, w = tid >> 6;
  const int lr = lane & 31, lh = lane >> 5;
  const int qb = item >> 1, kvh = item & 1;
  const long t0 = (long)qb * 128;
  int L, pos0;
  if (t0 < 32768) { L = 2048; pos0 = (int)(t0 & 2047); } else { L = 4096; pos0 = (int)((t0 - 32768) & 4095); }
  u16* RA = (u16*)(p.ws + OFF_A);
  char* Ks = smem;
  char* Vt = smem + 384 * KS_PITCH;
  float* gq = (float*)(smem + MISC_OFF);
  float* gk = gq + 64;
  __syncthreads();
  if (tid < 64) gq[tid] = p.in[17][layer * 64 + tid];
  else if (tid < 128) gk[tid - 64] = p.in[18][layer * 64 + tid - 64];
  __syncthreads();
  {
    const int q4 = tid & 3;
    for (int pass = 0; pass < 3; ++pass) {
      int r = pass * 128 + (tid >> 2);
      int kpos = pos0 - 128 + r;
      bool valid = (kpos >= 0) && (kpos < L);
      float kv[16], vv[16];
      if (valid) {
        const u16* kp = RA + (t0 - 128 + r) * 1280 + 1024 + kvh * 64 + 16 * q4;
        uint4 a = *(const uint4*)kp, b = *(const uint4*)(kp + 8);
        uint4 c = *(const uint4*)(kp + 128), d = *(const uint4*)(kp + 136);
        u32 ka[8] = {a.x, a.y, a.z, a.w, b.x, b.y, b.z, b.w};
        u32 va[8] = {c.x, c.y, c.z, c.w, d.x, d.y, d.z, d.w};
#pragma unroll
        for (int i = 0; i < 8; ++i) {
          kv[2 * i] = bflo(ka[i]); kv[2 * i + 1] = bfhi(ka[i]);
          vv[2 * i] = bflo(va[i]); vv[2 * i + 1] = bfhi(va[i]);
        }
      } else {
#pragma unroll
        for (int i = 0; i < 16; ++i) { kv[i] = 0.f; vv[i] = 0.f; }
      }
      float ss = 0.f;
#pragma unroll
      for (int i = 0; i < 16; ++i) ss += kv[i] * kv[i];
      ss += __shfl_xor(ss, 1);
      ss += __shfl_xor(ss, 2);
      float rstd = rsqrtf(ss * (1.f / 64.f) + 1e-6f);
#pragma unroll
      for (int i = 0; i < 16; ++i) kv[i] = kv[i] * rstd * gk[16 * q4 + i];
      if (q4 == 0) {
#pragma unroll
        for (int i = 0; i < 8; ++i) {
          float invf = __expf(-1.6402954f * (float)i);
          float rev = (float)kpos * invf * 0.15915494f;
          rev -= floorf(rev);
          float cs = __builtin_amdgcn_cosf(rev), sn = __builtin_amdgcn_sinf(rev);
          float t1 = kv[i], t2 = kv[8 + i];
          kv[i] = t1 * cs - t2 * sn;
          kv[8 + i] = t2 * cs + t1 * sn;
        }
      }
      uint4 o0, o1;
      o0.x = pack2(kv[0], kv[1]); o0.y = pack2(kv[2], kv[3]); o0.z = pack2(kv[4], kv[5]); o0.w = pack2(kv[6], kv[7]);
      o1.x = pack2(kv[8], kv[9]); o1.y = pack2(kv[10], kv[11]); o1.z = pack2(kv[12], kv[13]); o1.w = pack2(kv[14], kv[15]);
      *(uint4*)(Ks + r * KS_PITCH + q4 * 32) = o0;
      *(uint4*)(Ks + r * KS_PITCH + q4 * 32 + 16) = o1;
#pragma unroll
      for (int i = 0; i < 16; ++i) *(u16*)(Vt + (16 * q4 + i) * VT_PITCH + r * 2) = f2bf(vv[i]);
    }
  }
  __syncthreads();
  float gqm = 0.f, gkm = 0.f;
  for (int i = 0; i < 64; ++i) { gqm = fmaxf(gqm, fabsf(gq[i])); gkm = fmaxf(gkm, fabsf(gk[i])); }
  const float mb = 8.f * gqm * gkm;
  for (int uu = 0; uu < 2; ++uu) {
    const int u = 2 * w + uu;
    const int hl = u >> 2, qt = u & 3;
    const int head = kvh * 4 + hl;
    const long tq = t0 + 32 * qt + lr;
    const int qpos = pos0 + 32 * qt + lr;
    u16* qrow = RA + tq * 1280 + 512 + head * 64;
    bf16x8 qf[4];
    {
      uint4 qraw[8];
      float ss = 0.f;
#pragma unroll
      for (int i = 0; i < 8; ++i) {
        uint4 a = *(const uint4*)(qrow + 8 * i);
        qraw[i] = a;
        float f0 = bflo(a.x), f1 = bfhi(a.x), f2 = bflo(a.y), f3 = bfhi(a.y);
        float f4 = bflo(a.z), f5 = bfhi(a.z), f6 = bflo(a.w), f7 = bfhi(a.w);
        ss += f0 * f0 + f1 * f1 + f2 * f2 + f3 * f3 + f4 * f4 + f5 * f5 + f6 * f6 + f7 * f7;
      }
      const float rstd = rsqrtf(ss * (1.f / 64.f) + 1e-6f) * 0.125f;
      {
        uint4 lo = qraw[0], hi = qraw[1];
        float t1[8] = {bflo(lo.x), bfhi(lo.x), bflo(lo.y), bfhi(lo.y), bflo(lo.z), bfhi(lo.z), bflo(lo.w), bfhi(lo.w)};
        float t2[8] = {bflo(hi.x), bfhi(hi.x), bflo(hi.y), bfhi(hi.y), bflo(hi.z), bfhi(hi.z), bflo(hi.w), bfhi(hi.w)};
        float f[8];
#pragma unroll
        for (int i = 0; i < 8; ++i) {
          float invf = __expf(-1.6402954f * (float)i);
          float rev = (float)qpos * invf * 0.15915494f;
          rev -= floorf(rev);
          float cs = __builtin_amdgcn_cosf(rev), sn = __builtin_amdgcn_sinf(rev);
          float x1 = t1[i] * rstd * gq[i], x2 = t2[i] * rstd * gq[8 + i];
          float a = lh ? x2 : x1;
          float b = lh ? x1 : -x2;
          f[i] = a * cs + b * sn;
        }
        u32 pk[4] = {pack2(f[0], f[1]), pack2(f[2], f[3]), pack2(f[4], f[5]), pack2(f[6], f[7])};
        qf[0] = *(bf16x8*)pk;
      }
#pragma unroll
      for (int s = 1; s < 4; ++s) {
        uint4 lo = qraw[2 * s], hi = qraw[2 * s + 1];
        uint4 sel;
        sel.x = lh ? hi.x : lo.x; sel.y = lh ? hi.y : lo.y; sel.z = lh ? hi.z : lo.z; sel.w = lh ? hi.w : lo.w;
        const float* gp = gq + 16 * s + 8 * lh;
        float f[8] = {bflo(sel.x), bfhi(sel.x), bflo(sel.y), bfhi(sel.y), bflo(sel.z), bfhi(sel.z), bflo(sel.w), bfhi(sel.w)};
#pragma unroll
        for (int i = 0; i < 8; ++i) f[i] = f[i] * rstd * gp[i];
        u32 pk2[4] = {pack2(f[0], f[1]), pack2(f[2], f[3]), pack2(f[4], f[5]), pack2(f[6], f[7])};
        qf[s] = *(bf16x8*)pk2;
      }
    }
    f32x16 o0, o1;
#pragma unroll
    for (int r = 0; r < 16; ++r) { o0[r] = 0.f; o1[r] = 0.f; }
    float lsum = 0.f;
    for (int kt = qt; kt < qt + 9; ++kt) {
      f32x16 s;
#pragma unroll
      for (int r = 0; r < 16; ++r) s[r] = 0.f;
      const char* kb = Ks + (kt * 32 + lr) * KS_PITCH + lh * 16;
#pragma unroll
      for (int ks = 0; ks < 4; ++ks) {
        bf16x8 kf = *(const bf16x8*)(kb + ks * 32);
        s = __builtin_amdgcn_mfma_f32_32x32x16_bf16(kf, qf[ks], s, 0, 0, 0);
      }
      float pv[16];
#pragma unroll
      for (int r = 0; r < 16; ++r) {
        int kw = kt * 32 + (r & 3) + 8 * (r >> 2) + 4 * lh;
        int kpos = pos0 - 128 + kw;
        int dlt = kpos - qpos;
        bool ok = (dlt <= 128) && (dlt >= -128) && (kpos >= 0) && (kpos < L);
        float e = ok ? __expf(s[r] - mb) : 0.f;
        pv[r] = e;
        lsum += e;
      }
#pragma unroll
      for (int sk = 0; sk < 2; ++sk) {
        u32 pk[4] = {pack2(pv[8 * sk + 0], pv[8 * sk + 1]), pack2(pv[8 * sk + 2], pv[8 * sk + 3]),
                     pack2(pv[8 * sk + 4], pv[8 * sk + 5]), pack2(pv[8 * sk + 6], pv[8 * sk + 7])};
        bf16x8 pf = *(bf16x8*)pk;
        const char* vb = Vt + lr * VT_PITCH + (kt * 32 + 16 * sk + 4 * lh) * 2;
        uint2 va = *(const uint2*)(vb), vb2 = *(const uint2*)(vb + 16);
        u32 vk[4] = {va.x, va.y, vb2.x, vb2.y};
        bf16x8 vf0 = *(bf16x8*)vk;
        uint2 vc = *(const uint2*)(vb + 32 * VT_PITCH), vd = *(const uint2*)(vb + 32 * VT_PITCH + 16);
        u32 vk1[4] = {vc.x, vc.y, vd.x, vd.y};
        bf16x8 vf1 = *(bf16x8*)vk1;
        o0 = __builtin_amdgcn_mfma_f32_32x32x16_bf16(vf0, pf, o0, 0, 0, 0);
        o1 = __builtin_amdgcn_mfma_f32_32x32x16_bf16(vf1, pf, o1, 0, 0, 0);
      }
    }
    lsum += __shfl_xor(lsum, 32);
    lsum += __expf(p.in[19][layer * 8 + head] - mb);
    float inv = 1.f / lsum;
#pragma unroll
    for (int g = 0; g < 4; ++g) {
      uint2 a, b;
      a.x = pack2(o0[4 * g] * inv, o0[4 * g + 1] * inv); a.y = pack2(o0[4 * g + 2] * inv, o0[4 * g + 3] * inv);
      b.x = pack2(o1[4 * g] * inv, o1[4 * g + 1] * inv); b.y = pack2(o1[4 * g + 2] * inv, o1[4 * g + 3] * inv);
      *(uint2*)(qrow + 8 * g + 4 * lh) = a;
      *(uint2*)(qrow + 32 + 8 * g + 4 * lh) = b;
    }
  }
}

#define S5_WAVE_LDS 12800
#define WAVE_SYNC() do { asm volatile("" ::: "memory"); __builtin_amdgcn_wave_barrier(); asm volatile("" ::: "memory"); } while (0)
template <bool PASS2>
__device__ __forceinline__ void s5_unit(const Params& p, int layer, int unit, char* wsm) {
  const int lane = tid_() & 63;
  const int c = unit >> 5, g = unit & 31;
  const long t0 = (long)c * 128;
  float* BU = (float*)wsm;
  char* ST = wsm + 8448;
  u16* RA = (u16*)(p.ws + OFF_A);
  float* CAR = (float*)(p.ws + OFF_CAR);
  const int c16 = lane & 15, q = lane >> 4;
  const float rt_zero = (float)(blockIdx.x >> 24);
  const bf16x8 zfrag = {0, 0, 0, 0, 0, 0, 0, 0};
  bf16x8 uf[8];
#pragma unroll
  for (int sb = 0; sb < 8; ++sb) {
    bf16x8 v = *(const bf16x8*)(RA + (t0 + 16 * sb + c16) * 1280 + 16 * g + 8 * (q & 1));
    uf[sb] = (q < 2) ? v : zfrag;
  }
  f32x4 acc[8];
#pragma unroll
  for (int i = 0; i < 8; ++i) acc[i] = (f32x4){0.f, 0.f, 0.f, 0.f};
  int clo, chi;
  if (c < 256) { clo = c & ~15; chi = clo + 16; } else { clo = c & ~31; chi = clo + 32; }

#pragma unroll
  for (int d = 0; d < 2; ++d) {
    const long pg = ((long)(layer * 2 + d) * 32 + g);
    float lre = fminf(p.in[8][pg * 64 + lane], -1e-4f);
    float lim = p.in[9][pg * 64 + lane];
    float dt = expf(p.in[10][pg]);
    float er = expf(lre * dt);
    float ang = lim * dt;
    float nrev = rintf(ang * 0.15915494f);
    float rr = fmaf(-nrev, 6.28125f, ang);
    rr = fmaf(-nrev, 1.9353071795864769e-3f, rr);
    float ar = er * cosf(rr), ai = er * sinf(rr);
    float den = 1.f / (lre * lre + lim * lim);
    float nr = ar - 1.f;
    float c0r = (nr * lre + ai * lim) * den, c0i = (ai * lre - nr * lim) * den;
    WAVE_SYNC();
    {
      const float4* br = (const float4*)(p.in[11] + (pg * 64 + lane) * 16);
      const float4* bi = (const float4*)(p.in[12] + (pg * 64 + lane) * 16);
      u32 pr_[8], pi_[8];
#pragma unroll
      for (int i = 0; i < 4; ++i) {
        float4 x = br[i], y = bi[i];
        pr_[2 * i] = pack2(c0r * x.x - c0i * y.x, c0r * x.y - c0i * y.y);
        pr_[2 * i + 1] = pack2(c0r * x.z - c0i * y.z, c0r * x.w - c0i * y.w);
        pi_[2 * i] = pack2(c0r * y.x + c0i * x.x, c0r * y.y + c0i * x.y);
        pi_[2 * i + 1] = pack2(c0r * y.z + c0i * x.z, c0r * y.w + c0i * x.w);
      }
      uint4* dstr = (uint4*)((char*)BU + (2 * lane) * 32);
      dstr[0] = make_uint4(pr_[0], pr_[1], pr_[2], pr_[3]);
      dstr[1] = make_uint4(pr_[4], pr_[5], pr_[6], pr_[7]);
      dstr[2] = make_uint4(pi_[0], pi_[1], pi_[2], pi_[3]);
      dstr[3] = make_uint4(pi_[4], pi_[5], pi_[6], pi_[7]);
    }
    WAVE_SYNC();
    bf16x8 bfr[8];
#pragma unroll
    for (int nt = 0; nt < 8; ++nt) {
      bf16x8 v = *(const bf16x8*)((const char*)BU + (16 * nt + c16) * 32 + 16 * (q & 1));
      bfr[nt] = (q < 2) ? v : zfrag;
    }
    WAVE_SYNC();
    float sr = 0.f, si = 0.f;
    bf16x8 cf[4];
    if (PASS2) {
      float pr = ar, pi = ai;
#pragma unroll
      for (int i = 0; i < 7; ++i) { float t = pr * pr - pi * pi; pi = 2.f * pr * pi; pr = t; }
      if (d == 0) {
        for (int cc = clo; cc < c; ++cc) {
          float2 e = *(const float2*)(CAR + (((long)cc * 32 + g) * 2 + 0) * 128 + 2 * lane);
          float t = pr * sr - pi * si + e.x; si = pr * si + pi * sr + e.y; sr = t;
        }
      } else {
        for (int cc = chi - 1; cc > c; --cc) {
          float2 e = *(const float2*)(CAR + (((long)cc * 32 + g) * 2 + 1) * 128 + 2 * lane);
          float t = pr * sr - pi * si + e.x; si = pr * si + pi * sr + e.y; sr = t;
        }
      }
      const float* cre = p.in[13] + (pg * 16 + c16) * 64;
      const float* cim = p.in[14] + (pg * 16 + c16) * 64;
#pragma unroll
      for (int ks = 0; ks < 4; ++ks) {
        float4 x = *(const float4*)(cre + 16 * ks + 4 * q);
        float4 y = *(const float4*)(cim + 16 * ks + 4 * q);
        u32 pk[4] = {pack2(x.x, -y.x), pack2(x.y, -y.y), pack2(x.z, -y.z), pack2(x.w, -y.w)};
        cf[ks] = *(bf16x8*)pk;
      }
    }
#pragma unroll
    for (int sbi = 0; sbi < 8; ++sbi) {
      const int sb = d ? 7 - sbi : sbi;
      f32x4 z[8];
#pragma unroll
      for (int nt = 0; nt < 8; ++nt) {
        z[nt] = (f32x4){0.f, 0.f, 0.f, 0.f};
        z[nt] = __builtin_amdgcn_mfma_f32_16x16x32_bf16(uf[sb], bfr[nt], z[nt], 0, 0, 0);
      }
      __builtin_amdgcn_sched_barrier(0);
#pragma unroll
      for (int nt = 0; nt < 8; ++nt)
#pragma unroll
        for (int r = 0; r < 4; ++r) BU[(4 * q + r) * 132 + 16 * nt + c16] = z[nt][r] + rt_zero;
      asm volatile("s_waitcnt lgkmcnt(0)" ::: "memory");
      __builtin_amdgcn_sched_barrier(0);
      WAVE_SYNC();
#pragma unroll 4
      for (int s = 0; s < 16; ++s) {
        const int tl = d ? 15 - s : s;
        const float2 bu = *(const float2*)(BU + tl * 132 + 2 * lane);
        float t = ar * sr - ai * si + bu.x;
        si = ar * si + ai * sr + bu.y;
        sr = t;
        if (PASS2) *(u32*)(ST + tl * 272 + 4 * lane) = pack2(sr, si);
      }
      WAVE_SYNC();
      if (PASS2) {
        const char* ab = ST + c16 * 272 + q * 16;
#pragma unroll
        for (int ks = 0; ks < 4; ++ks) {
          bf16x8 af = *(const bf16x8*)(ab + ks * 64);
          acc[sb] = __builtin_amdgcn_mfma_f32_16x16x32_bf16(af, cf[ks], acc[sb], 0, 0, 0);
        }
        WAVE_SYNC();
      }
    }
    if (!PASS2) {
      float2 e = {sr, si};
      *(float2*)(CAR + (((long)c * 32 + g) * 2 + d) * 128 + 2 * lane) = e;
    }
  }
  if (PASS2) {
    const float dsk = p.in[15][(layer * 32 + g) * 16 + c16];
#pragma unroll
    for (int sb = 0; sb < 8; ++sb)
#pragma unroll
      for (int r = 0; r < 4; ++r) {
        int tau = sb * 16 + 4 * q + r;
        u16* up = RA + (t0 + tau) * 1280 + 16 * g + c16;
        float y = acc[sb][r] + dsk * bflo((u32)*up);
        float t = tanhf(0.7978845608f * (y + 0.044715f * y * y * y));
        y = 0.5f * y * (1.f + t);
        *up = f2bf(y);
      }
  }
}

template <bool PASS2>
__device__ __forceinline__ void s5_unit_old(const Params& p, int layer, int unit, char* wsm) {
  const int lane = tid_() & 63;
  const int c = unit >> 5, g = unit & 31;
  const long t0 = (long)c * 128;
  float* U = (float*)wsm;
  char* ST = wsm + 8192;
  u16* RA = (u16*)(p.ws + OFF_A);
  float* CAR = (float*)(p.ws + OFF_CAR);
  __builtin_amdgcn_wave_barrier();
#pragma unroll
  for (int i = 0; i < 2; ++i) {
    int tau = lane + 64 * i;
    const u16* src = RA + (t0 + tau) * 1280 + 16 * g;
    uint4 a = *(const uint4*)src, b = *(const uint4*)(src + 8);
    float4 f0 = {bflo(a.x), bfhi(a.x), bflo(a.y), bfhi(a.y)};
    float4 f1 = {bflo(a.z), bfhi(a.z), bflo(a.w), bfhi(a.w)};
    float4 f2 = {bflo(b.x), bfhi(b.x), bflo(b.y), bfhi(b.y)};
    float4 f3 = {bflo(b.z), bfhi(b.z), bflo(b.w), bfhi(b.w)};
    float4* d = (float4*)(U + tau * 16);
    d[0] = f0; d[1] = f1; d[2] = f2; d[3] = f3;
  }
  __builtin_amdgcn_wave_barrier();
  f32x4 acc[8];
#pragma unroll
  for (int i = 0; i < 8; ++i) acc[i] = (f32x4){0.f, 0.f, 0.f, 0.f};
  int clo, chi;
  if (c < 256) { clo = c & ~15; chi = clo + 16; } else { clo = c & ~31; chi = clo + 32; }

#pragma unroll
  for (int d = 0; d < 2; ++d) {
    const long pg = ((long)(layer * 2 + d) * 32 + g);
    float lre = fminf(p.in[8][pg * 64 + lane], -1e-4f);
    float lim = p.in[9][pg * 64 + lane];
    float dt = expf(p.in[10][pg]);
    float er = expf(lre * dt);
    float ang = lim * dt;
    float nrev = rintf(ang * 0.15915494f);
    float rr = fmaf(-nrev, 6.28125f, ang);
    rr = fmaf(-nrev, 1.9353071795864769e-3f, rr);
    float ar = er * cosf(rr), ai = er * sinf(rr);
    float den = 1.f / (lre * lre + lim * lim);
    float nr = ar - 1.f;
    float c0r = (nr * lre + ai * lim) * den, c0i = (ai * lre - nr * lim) * den;
    float Br[16], Bi[16];
    {
      const float4* br = (const float4*)(p.in[11] + (pg * 64 + lane) * 16);
      const float4* bi = (const float4*)(p.in[12] + (pg * 64 + lane) * 16);
#pragma unroll
      for (int i = 0; i < 4; ++i) {
        float4 x = br[i], y = bi[i];
        Br[4 * i + 0] = c0r * x.x - c0i * y.x; Bi[4 * i + 0] = c0r * y.x + c0i * x.x;
        Br[4 * i + 1] = c0r * x.y - c0i * y.y; Bi[4 * i + 1] = c0r * y.y + c0i * x.y;
        Br[4 * i + 2] = c0r * x.z - c0i * y.z; Bi[4 * i + 2] = c0r * y.z + c0i * x.z;
        Br[4 * i + 3] = c0r * x.w - c0i * y.w; Bi[4 * i + 3] = c0r * y.w + c0i * x.w;
      }
    }
    float sr = 0.f, si = 0.f;
    bf16x8 cf[4];
    if (PASS2) {
      float pr = ar, pi = ai;
#pragma unroll
      for (int i = 0; i < 7; ++i) { float t = pr * pr - pi * pi; pi = 2.f * pr * pi; pr = t; }
      if (d == 0) {
        for (int cc = clo; cc < c; ++cc) {
          float2 e = *(const float2*)(CAR + (((long)cc * 32 + g) * 2 + 0) * 128 + 2 * lane);
          float t = pr * sr - pi * si + e.x; si = pr * si + pi * sr + e.y; sr = t;
        }
      } else {
        for (int cc = chi - 1; cc > c; --cc) {
          float2 e = *(const float2*)(CAR + (((long)cc * 32 + g) * 2 + 1) * 128 + 2 * lane);
          float t = pr * sr - pi * si + e.x; si = pr * si + pi * sr + e.y; sr = t;
        }
      }
      const int h = lane & 15, q = lane >> 4;
      const float* cre = p.in[13] + (pg * 16 + h) * 64;
      const float* cim = p.in[14] + (pg * 16 + h) * 64;
#pragma unroll
      for (int ks = 0; ks < 4; ++ks) {
        float4 x = *(const float4*)(cre + 16 * ks + 4 * q);
        float4 y = *(const float4*)(cim + 16 * ks + 4 * q);
        u32 pk[4] = {pack2(x.x, -y.x), pack2(x.y, -y.y), pack2(x.z, -y.z), pack2(x.w, -y.w)};
        cf[ks] = *(bf16x8*)pk;
      }
    }
#pragma unroll
    for (int sbi = 0; sbi < 8; ++sbi) {
      const int sb = d ? 7 - sbi : sbi;
#pragma unroll 4
      for (int s = 0; s < 16; ++s) {
        const int tl = d ? 15 - s : s;
        const int tau = sb * 16 + tl;
        const float4* up = (const float4*)(U + tau * 16);
        float4 u0 = up[0], u1 = up[1], u2 = up[2], u3 = up[3];
        float uu[16] = {u0.x, u0.y, u0.z, u0.w, u1.x, u1.y, u1.z, u1.w, u2.x, u2.y, u2.z, u2.w, u3.x, u3.y, u3.z, u3.w};
        float bur = 0.f, bui = 0.f;
#pragma unroll
        for (int hh = 0; hh < 16; ++hh) { bur += Br[hh] * uu[hh]; bui += Bi[hh] * uu[hh]; }
        float t = ar * sr - ai * si + bur;
        si = ar * si + ai * sr + bui;
        sr = t;
        if (PASS2) *(u32*)(ST + tl * 272 + 4 * lane) = pack2(sr, si);
      }
      if (PASS2) {
        __builtin_amdgcn_wave_barrier();
        const char* ab = ST + (lane & 15) * 272 + (lane >> 4) * 16;
#pragma unroll
        for (int ks = 0; ks < 4; ++ks) {
          bf16x8 af = *(const bf16x8*)(ab + ks * 64);
          acc[sb] = __builtin_amdgcn_mfma_f32_16x16x32_bf16(af, cf[ks], acc[sb], 0, 0, 0);
        }
        __builtin_amdgcn_wave_barrier();
      }
    }
    if (!PASS2) {
      float2 e = {sr, si};
      *(float2*)(CAR + (((long)c * 32 + g) * 2 + d) * 128 + 2 * lane) = e;
    }
  }
  if (PASS2) {
    const int h = lane & 15, q = lane >> 4;
    const float dsk = p.in[15][(layer * 32 + g) * 16 + h];
#pragma unroll
    for (int sb = 0; sb < 8; ++sb)
#pragma unroll
      for (int r = 0; r < 4; ++r) {
        int tau = sb * 16 + 4 * q + r;
        float y = acc[sb][r] + dsk * U[tau * 16 + h];
        float t = tanhf(0.7978845608f * (y + 0.044715f * y * y * y));
        y = 0.5f * y * (1.f + t);
        RA[(t0 + tau) * 1280 + 16 * g + h] = f2bf(y);
      }
  }
}

#define OFF_FLAG (OFF_CTR + 1024)
__device__ __forceinline__ void rwkv_job(const Params& p, int layer, int job, char* smem) {
  const int tid = tid_(), lane = tid & 63, w = tid >> 6;
  const int pr = job >> 1, d = job & 1;
  int head, L;
  long tok0;
  if (pr < 64) { head = pr & 7; L = 4096; tok0 = 32768 + (long)(pr >> 3) * 4096; }
  else { int q = pr - 64; head = q & 7; L = 2048; tok0 = (long)(q >> 3) * 2048; }
  float* R = (float*)smem;
  float* KP = R + 2048; float* V = KP + 2048; float* W = V + 2048; float* NKK = W + 2048; float* KKA = NKK + 2048;
  float* AA = KKA + 2048; float* G = AA + 2048; float* YO = G + 2048;
  char* TW = smem + 73728; char* AL = TW + 4608; char* SG = AL + 4608;
  float* BON = (float*)(SG + 8704);
  float* MU = BON + 32;
  int* SPROG = (int*)(MU + 896);
  const u16* RZ = (const u16*)(p.ws + OFF_Z);
  u16* RY = (u16*)(p.ws + OFF_Y);
  u32* myflag = (u32*)(p.ws + OFF_FLAG) + layer * 384 + job;
  u32* paflag = (u32*)(p.ws + OFF_FLAG) + layer * 384 + (job ^ 1);
  const float* mu = p.in[20] + (long)layer * 2 * 1920;
  const float* w0 = p.in[21] + (long)(layer * 2 + d) * 512;
  const float* w2 = p.in[22] + (long)(layer * 2 + d) * 64 * 512;
  const float* a0 = p.in[23] + (long)(layer * 2 + d) * 512;
  const float* a2 = p.in[24] + (long)(layer * 2 + d) * 64 * 512;
  const float* g2 = p.in[25] + (long)layer * 128 * 512;
#define RW_ZB(v) ((v) == 0 ? 64 * head : (v) == 1 ? 512 + 64 * head : (v) == 2 ? 1024 + 64 * head \
                 : (v) == 3 ? 1536 + 64 * d : (v) == 4 ? 1664 + 64 * d : (v) == 5 ? 1792 : 1856)
  __syncthreads();
  for (int idx = tid; idx < 896; idx += NTHREADS) {
    int m = idx / 448, rem = idx - m * 448, v = rem >> 6, cc = rem & 63;
    MU[idx] = mu[m * 1920 + RW_ZB(v) + cc];
  }
  const int tau_a = tid >> 4, c4 = tid & 15;
  float kkc[4], kac[4], rkc[4], lnw[4], lnb[4];
#pragma unroll
  for (int e = 0; e < 4; ++e) {
    int cc = 64 * head + 4 * c4 + e;
    kkc[e] = p.in[26][layer * 512 + cc];
    kac[e] = p.in[27][layer * 512 + cc];
    rkc[e] = p.in[28][layer * 512 + cc];
    lnw[e] = p.in[29][layer * 512 + cc];
    lnb[e] = p.in[30][layer * 512 + cc];
  }
  const int c16 = lane & 15, q4 = lane >> 4;
  const int nt = w & 3, th = w >> 2;
  const int colb = 64 * head + 16 * nt + c16;
  bf16x8 w2f[2], a2f[2], g2f[4];
#pragma unroll
  for (int s = 0; s < 4; ++s) {
    float fw[8], fa[8], fg[8];
#pragma unroll
    for (int j = 0; j < 8; ++j) {
      int m = 32 * s + 8 * q4 + j;
      fg[j] = g2[(long)m * 512 + colb];
      if (s < 2) { fw[j] = w2[(long)m * 512 + colb]; fa[j] = a2[(long)m * 512 + colb]; }
    }
    u32 pg[4] = {pack2(fg[0], fg[1]), pack2(fg[2], fg[3]), pack2(fg[4], fg[5]), pack2(fg[6], fg[7])};
    g2f[s] = *(bf16x8*)pg;
    if (s < 2) {
      u32 pw[4] = {pack2(fw[0], fw[1]), pack2(fw[2], fw[3]), pack2(fw[4], fw[5]), pack2(fw[6], fw[7])};
      u32 pa[4] = {pack2(fa[0], fa[1]), pack2(fa[2], fa[3]), pack2(fa[4], fa[5]), pack2(fa[6], fa[7])};
      w2f[s] = *(bf16x8*)pw;
      a2f[s] = *(bf16x8*)pa;
    }
  }
  const float w0c = w0[colb], a0c = a0[colb];
  f2_t S2[2][2];
#pragma unroll
  for (int r = 0; r < 2; ++r) { S2[r][0] = (f2_t){0.f, 0.f}; S2[r][1] = (f2_t){0.f, 0.f}; }
  const int jq16 = lane & 15, rq = lane >> 4;
  const int row0 = 8 * w + 2 * rq;
  const int NC = L >> 5;
  uint2 zr[7][3];
  int prog = 0;

#define RW_LOAD(ci_)                                                                          \
  {                                                                                           \
    const int chunk_ = d ? NC - 1 - (ci_) : (ci_);                                            \
    const long t_ = tok0 + (long)chunk_ * 32 + tau_a;                                         \
    const int pos_ = chunk_ * 32 + tau_a;                                                     \
    const bool hp_ = pos_ > 0, hn_ = pos_ < L - 1;                                            \
    _Pragma("unroll") for (int v = 0; v < 7; ++v) {                                           \
      const u16* zp = RZ + t_ * 1920 + RW_ZB(v) + 4 * c4;                                     \
      zr[v][0] = *(const uint2*)zp;                                                           \
      zr[v][1] = hp_ ? *(const uint2*)(zp - 1920) : make_uint2(0u, 0u);                       \
      zr[v][2] = hn_ ? *(const uint2*)(zp + 1920) : make_uint2(0u, 0u);                       \
    }                                                                                         \
  }
#define RW_PREP_A()                                                                           \
  {                                                                                           \
    _Pragma("unroll") for (int v = 0; v < 7; ++v) {                                           \
      uint2 zc = zr[v][0], zpv = zr[v][1], znv = zr[v][2];                                    \
      float4 m0 = *(const float4*)(MU + v * 64 + 4 * c4);                                     \
      float4 m1 = *(const float4*)(MU + 448 + v * 64 + 4 * c4);                               \
      float zc4[4] = {bflo(zc.x), bfhi(zc.x), bflo(zc.y), bfhi(zc.y)};                        \
      float zp4[4] = {bflo(zpv.x), bfhi(zpv.x), bflo(zpv.y), bfhi(zpv.y)};                    \
      float zn4[4] = {bflo(znv.x), bfhi(znv.x), bflo(znv.y), bfhi(znv.y)};                    \
      float mm0[4] = {m0.x, m0.y, m0.z, m0.w}, mm1[4] = {m1.x, m1.y, m1.z, m1.w};             \
      float o[4];                                                                             \
      _Pragma("unroll") for (int e = 0; e < 4; ++e)                                           \
          o[e] = zc4[e] + mm0[e] * (zp4[e] - zc4[e]) + mm1[e] * (zn4[e] - zc4[e]);            \
      if (v == 0) *(float4*)(R + tau_a * 64 + 4 * c4) = make_float4(o[0], o[1], o[2], o[3]);  \
      else if (v == 1) *(float4*)(KP + tau_a * 64 + 4 * c4) = make_float4(o[0], o[1], o[2], o[3]); \
      else if (v == 2) *(float4*)(V + tau_a * 64 + 4 * c4) = make_float4(o[0], o[1], o[2], o[3]);  \
      else if (v == 3) {                                                                      \
        float th_[4];                                                                         \
        _Pragma("unroll") for (int e = 0; e < 4; ++e) th_[e] = 1.f - 2.f * frcp(1.f + __expf(2.f * o[e])); \
        *(uint2*)(TW + tau_a * 144 + 8 * c4) = make_uint2(pack2(th_[0], th_[1]), pack2(th_[2], th_[3])); \
      } else if (v == 4) {                                                                    \
        *(uint2*)(AL + tau_a * 144 + 8 * c4) = make_uint2(pack2(o[0], o[1]), pack2(o[2], o[3])); \
      } else {                                                                                \
        *(uint2*)(SG + tau_a * 272 + (v - 5) * 128 + 8 * c4) =                                \
            make_uint2(pack2(fsig(o[0]), fsig(o[1])), pack2(fsig(o[2]), fsig(o[3])));         \
      }                                                                                       \
    }                                                                                         \
  }
#define RW_PREP_B()                                                                           \
  {                                                                                           \
    f32x4 cw = {0.f, 0.f, 0.f, 0.f}, ca = cw, cgt = cw;                                       \
    const int tr_ = 16 * th + c16;                                                            \
    _Pragma("unroll") for (int s = 0; s < 2; ++s) {                                           \
      bf16x8 tf = *(const bf16x8*)(TW + tr_ * 144 + (32 * s + 8 * q4) * 2);                   \
      bf16x8 af = *(const bf16x8*)(AL + tr_ * 144 + (32 * s + 8 * q4) * 2);                   \
      cw = __builtin_amdgcn_mfma_f32_16x16x32_bf16(tf, w2f[s], cw, 0, 0, 0);                  \
      ca = __builtin_amdgcn_mfma_f32_16x16x32_bf16(af, a2f[s], ca, 0, 0, 0);                  \
    }                                                                                         \
    _Pragma("unroll") for (int s = 0; s < 4; ++s) {                                           \
      bf16x8 sf = *(const bf16x8*)(SG + tr_ * 272 + (32 * s + 8 * q4) * 2);                   \
      cgt = __builtin_amdgcn_mfma_f32_16x16x32_bf16(sf, g2f[s], cgt, 0, 0, 0);                \
    }                                                                                         \
    _Pragma("unroll") for (int r = 0; r < 4; ++r) {                                           \
      int tau = 16 * th + 4 * q4 + r, cc = 16 * nt + c16;                                     \
      W[tau * 64 + cc] = __expf(-0.60653066f * fsig(cw[r] + w0c));                            \
      AA[tau * 64 + cc] = fsig(ca[r] + a0c);                                                  \
      G[tau * 64 + cc] = cgt[r];                                                              \
    }                                                                                         \
  }
#define RW_PREP_C()                                                                           \
  {                                                                                           \
    float4 k4 = *(const float4*)(KP + tau_a * 64 + 4 * c4);                                   \
    float4 a4 = *(const float4*)(AA + tau_a * 64 + 4 * c4);                                   \
    float4 r4 = *(const float4*)(R + tau_a * 64 + 4 * c4);                                    \
    float kk[4] = {k4.x * kkc[0], k4.y * kkc[1], k4.z * kkc[2], k4.w * kkc[3]};               \
    float kx[4] = {k4.x, k4.y, k4.z, k4.w}, ax[4] = {a4.x, a4.y, a4.z, a4.w}, rx[4] = {r4.x, r4.y, r4.z, r4.w}; \
    float ss = kk[0] * kk[0] + kk[1] * kk[1] + kk[2] * kk[2] + kk[3] * kk[3];                 \
    float bn = rx[0] * kx[0] * rkc[0] + rx[1] * kx[1] * rkc[1] + rx[2] * kx[2] * rkc[2] + rx[3] * kx[3] * rkc[3]; \
    ss = row16_sum(ss); bn = row16_sum(bn);                                                   \
    float inv = 1.f / fmaxf(sqrtf(ss), 1e-12f);                                               \
    float nk[4], ka[4], kd[4];                                                                \
    _Pragma("unroll") for (int e = 0; e < 4; ++e) {                                           \
      float k1 = kk[e] * inv;                                                                 \
      nk[e] = -k1;                                                                            \
      ka[e] = k1 * ax[e];                                                                     \
      kd[e] = kx[e] * (1.f + (ax[e] - 1.f) * kac[e]);                                         \
    }                                                                                         \
    *(float4*)(NKK + tau_a * 64 + 4 * c4) = make_float4(nk[0], nk[1], nk[2], nk[3]);          \
    *(float4*)(KKA + tau_a * 64 + 4 * c4) = make_float4(ka[0], ka[1], ka[2], ka[3]);          \
    *(float4*)(KP + tau_a * 64 + 4 * c4) = make_float4(kd[0], kd[1], kd[2], kd[3]);           \
    if (c4 == 0) BON[tau_a] = bn;                                                             \
  }

  __syncthreads();
  RW_LOAD(0);
  RW_PREP_A();
  __syncthreads();
  RW_PREP_B();
  __syncthreads();
  RW_PREP_C();
  __syncthreads();

  for (int ci = 0; ci < NC; ++ci) {
    const int chunk = d ? NC - 1 - ci : ci;
    const long tb = tok0 + (long)chunk * 32;
    const bool more = (ci + 1 < NC);
    const bool second = ci >= (NC >> 1);
    if (more) RW_LOAD(ci + 1);
    u64* yp = (u64*)(RY + (tb + tau_a) * 512 + 64 * head + 4 * c4);
    u64 st = 0;
    if (second) {
      const int need = NC - ci;
      if (prog < need) {
        if (tid == 0) {
          int v = 0;
          for (unsigned spins = 0; spins < (1u << 24); ++spins) {
            v = (int)__hip_atomic_load(paflag, __ATOMIC_RELAXED, __HIP_MEMORY_SCOPE_AGENT);
            if (v >= need) break;
            __builtin_amdgcn_s_sleep(2);
          }
          *SPROG = v;
        }
        __syncthreads();
        prog = *SPROG;
        if (prog < need) prog = need;
      }
      st = __hip_atomic_load(yp, __ATOMIC_RELAXED, __HIP_MEMORY_SCOPE_AGENT);
    }
    {
      float yp0 = 0.f, yp1 = 0.f;
      int tprev = d ? 31 : 0;
#pragma unroll 2
      for (int s = 0; s < 32; ++s) {
        const int tau = d ? 31 - s : s;
        const int o = tau * 64 + 4 * jq16;
        const float4 w4 = *(const float4*)(W + o);
        const float4 n4 = *(const float4*)(NKK + o);
        const float4 a4 = *(const float4*)(KKA + o);
        const float4 d4 = *(const float4*)(KP + o);
        const float4 r4 = *(const float4*)(R + o);
        const float2 v2 = *(const float2*)(V + tau * 64 + row0);
        const f2_t w01 = {w4.x, w4.y}, w23 = {w4.z, w4.w}, n01 = {n4.x, n4.y}, n23 = {n4.z, n4.w};
        const f2_t a01 = {a4.x, a4.y}, a23 = {a4.z, a4.w}, d01 = {d4.x, d4.y}, d23 = {d4.z, d4.w};
        const f2_t r01 = {r4.x, r4.y}, r23 = {r4.z, r4.w};
        f2_t t0 = S2[0][0] * n01 + S2[0][1] * n23;
        f2_t t1 = S2[1][0] * n01 + S2[1][1] * n23;
        float q0 = t0.x + t0.y, q1 = t1.x + t1.y, q2 = yp0, q3 = yp1;
        asm("s_nop 1\n\t"
            "v_add_f32_dpp %0, %0, %0 row_ror:1 row_mask:0xf bank_mask:0xf bound_ctrl:1\n\t"
            "v_add_f32_dpp %1, %1, %1 row_ror:1 row_mask:0xf bank_mask:0xf bound_ctrl:1\n\t"
            "v_add_f32_dpp %2, %2, %2 row_ror:1 row_mask:0xf bank_mask:0xf bound_ctrl:1\n\t"
            "v_add_f32_dpp %3, %3, %3 row_ror:1 row_mask:0xf bank_mask:0xf bound_ctrl:1\n\t"
            "v_add_f32_dpp %0, %0, %0 row_ror:2 row_mask:0xf bank_mask:0xf bound_ctrl:1\n\t"
            "v_add_f32_dpp %1, %1, %1 row_ror:2 row_mask:0xf bank_mask:0xf bound_ctrl:1\n\t"
            "v_add_f32_dpp %2, %2, %2 row_ror:2 row_mask:0xf bank_mask:0xf bound_ctrl:1\n\t"
            "v_add_f32_dpp %3, %3, %3 row_ror:2 row_mask:0xf bank_mask:0xf bound_ctrl:1\n\t"
            "v_add_f32_dpp %0, %0, %0 row_ror:4 row_mask:0xf bank_mask:0xf bound_ctrl:1\n\t"
            "v_add_f32_dpp %1, %1, %1 row_ror:4 row_mask:0xf bank_mask:0xf bound_ctrl:1\n\t"
            "v_add_f32_dpp %2, %2, %2 row_ror:4 row_mask:0xf bank_mask:0xf bound_ctrl:1\n\t"
            "v_add_f32_dpp %3, %3, %3 row_ror:4 row_mask:0xf bank_mask:0xf bound_ctrl:1\n\t"
            "v_add_f32_dpp %0, %0, %0 row_ror:8 row_mask:0xf bank_mask:0xf bound_ctrl:1\n\t"
            "v_add_f32_dpp %1, %1, %1 row_ror:8 row_mask:0xf bank_mask:0xf bound_ctrl:1\n\t"
            "v_add_f32_dpp %2, %2, %2 row_ror:8 row_mask:0xf bank_mask:0xf bound_ctrl:1\n\t"
            "v_add_f32_dpp %3, %3, %3 row_ror:8 row_mask:0xf bank_mask:0xf bound_ctrl:1"
            : "+v"(q0), "+v"(q1), "+v"(q2), "+v"(q3));
        if (jq16 == 0) *(float2*)(YO + tprev * 64 + row0) = make_float2(q2, q3);
        tprev = tau;
        {
          const f2_t sv = {q0, q0}, vr = {v2.x, v2.x};
          S2[0][0] = S2[0][0] * w01 + (sv * a01 + vr * d01);
          S2[0][1] = S2[0][1] * w23 + (sv * a23 + vr * d23);
          f2_t t = S2[0][0] * r01 + S2[0][1] * r23;
          yp0 = t.x + t.y;
        }
        {
          const f2_t sv = {q1, q1}, vr = {v2.y, v2.y};
          S2[1][0] = S2[1][0] * w01 + (sv * a01 + vr * d01);
          S2[1][1] = S2[1][1] * w23 + (sv * a23 + vr * d23);
          f2_t t = S2[1][0] * r01 + S2[1][1] * r23;
          yp1 = t.x + t.y;
        }
      }
      yp0 = row16_sum(yp0);
      yp1 = row16_sum(yp1);
      if (jq16 == 0) *(float2*)(YO + tprev * 64 + row0) = make_float2(yp0, yp1);
    }
    __syncthreads();
    {
      float4 y4 = *(const float4*)(YO + tau_a * 64 + 4 * c4);
      float yv[4] = {y4.x, y4.y, y4.z, y4.w};
      if (!second) {
        u64 pk = (u64)pack2(yv[0], yv[1]) | ((u64)pack2(yv[2], yv[3]) << 32);
        __hip_atomic_store(yp, pk, __ATOMIC_RELAXED, __HIP_MEMORY_SCOPE_AGENT);
        asm volatile("s_waitcnt vmcnt(0)" ::: "memory");
      } else {
        u32 s0 = (u32)st, s1 = (u32)(st >> 32);
        yv[0] += bflo(s0); yv[1] += bfhi(s0); yv[2] += bflo(s1); yv[3] += bfhi(s1);
        float sm1 = row16_sum(yv[0] + yv[1] + yv[2] + yv[3]);
        float mean = sm1 * (1.f / 64.f);
        float vs = 0.f;
#pragma unroll
        for (int e = 0; e < 4; ++e) { float dd = yv[e] - mean; vs += dd * dd; }
        vs = row16_sum(vs);
        float rstd = rsqrtf(vs * (1.f / 64.f) + 64e-5f);
        float4 v4 = *(const float4*)(V + tau_a * 64 + 4 * c4);
        float4 g4 = *(const float4*)(G + tau_a * 64 + 4 * c4);
        float vv[4] = {v4.x, v4.y, v4.z, v4.w}, gg[4] = {g4.x, g4.y, g4.z, g4.w};
        float bn = BON[tau_a];
        float o[4];
#pragma unroll
        for (int e = 0; e < 4; ++e) o[e] = ((yv[e] - mean) * rstd * lnw[e] + lnb[e] + bn * vv[e]) * gg[e];
        *(uint2*)yp = make_uint2(pack2(o[0], o[1]), pack2(o[2], o[3]));
      }
    }
    if (more) RW_PREP_A();
    __syncthreads();
    if (!second && tid == 0) __hip_atomic_store(myflag, (u32)(ci + 1), __ATOMIC_RELAXED, __HIP_MEMORY_SCOPE_AGENT);
    if (more) {
      RW_PREP_B();
      __syncthreads();
      RW_PREP_C();
      __syncthreads();
    }
  }
#undef RW_ZB
#undef RW_LOAD
#undef RW_PREP_A
#undef RW_PREP_B
#undef RW_PREP_C
}

#define N_ATT_ITEMS 1024
#define N_S5_ITEMS 2048
__device__ __forceinline__ void phase_mixer1(const Params& p, int layer, char* smem) {
#ifndef NO_RW
  for (int slot = blockIdx.x; slot < 512; slot += gridDim.x) {
    const int job = slot < 256 ? slot : (slot < 384 ? -1 : slot - 128);
    if (job >= 0) rwkv_job(p, layer, job, smem);
  }
#endif
  int* ctr = (int*)(p.ws + OFF_CTR) + layer;
  int* sitem = (int*)(smem + MISC_OFF + 2048);
  const int w = tid_() >> 6;
  while (true) {
    __syncthreads();
    if (tid_() == 0) *sitem = atomicAdd(ctr, 1);
    __syncthreads();
    int it = *sitem;
    if (it >= N_ATT_ITEMS + N_S5_ITEMS) break;
    if (it < N_ATT_ITEMS) {
#ifndef NO_ATT
      attn_item(p, layer, it, smem);
#endif
    } else {
#ifndef NO_S5
      s5_unit<false>(p, layer, (it - N_ATT_ITEMS) * 8 + w, smem + w * S5_WAVE_LDS);
#endif
    }
  }
}

__device__ __forceinline__ void phase_s5p2(const Params& p, int layer, char* smem) {
  const int w = tid_() >> 6;
  for (int it = blockIdx.x; it < N_S5_ITEMS; it += gridDim.x) s5_unit<true>(p, layer, it * 8 + w, smem + w * S5_WAVE_LDS);
}

#define XB_TMO      128
#define XB_XCNT(j)  (256  + 64 * (j))
#define XB_XSUB(j)  (1280 + 64 * (j))
#define XB_XGEN(j)  (2304 + 64 * (j))
#define XB_TOP      3328
#define XB_TOPGEN   3392
#define XCD_BAR_WORDS 3456
#define XB_SPIN_CAP (1u << 18)
#define XLAS __attribute__((address_space(3)))

__device__ __forceinline__ unsigned xb_ld(unsigned* p)              { return __hip_atomic_load(p, __ATOMIC_RELAXED, __HIP_MEMORY_SCOPE_AGENT); }
__device__ __forceinline__ unsigned xb_add(unsigned* p, unsigned v) { return __hip_atomic_fetch_add(p, v, __ATOMIC_RELAXED, __HIP_MEMORY_SCOPE_AGENT); }
__device__ __forceinline__ unsigned xb_xcc_id() { return (unsigned)__builtin_amdgcn_s_getreg((3 << 11) | 20) & 0xFu; }
#define XB_SPIN(cond, bar) do { unsigned _sp = 0; while (cond) { __builtin_amdgcn_s_sleep(1); \
    if ((++_sp & 255u) == 0u) { if (xb_ld(&(bar)[XB_TMO])) break; if (_sp > XB_SPIN_CAP) { atomicAdd(&(bar)[XB_TMO], 1u); break; } } } } while (0)

struct XcdBarrier {
    unsigned* bar; unsigned x;
    volatile XLAS unsigned* st;
};

__device__ __forceinline__ XcdBarrier xcd_barrier_post(unsigned* bar, volatile XLAS unsigned* st) {
    XcdBarrier b; b.bar = bar; b.x = xb_xcc_id(); b.st = st;
    if (threadIdx.x == 0) (void)xb_add(&bar[XB_XCNT(b.x)], 1u);
    return b;
}
__device__ __forceinline__ void xcd_barrier_complete(unsigned* bar, unsigned x, unsigned& nloc, unsigned& nx) {
    const unsigned G = gridDim.x * gridDim.y * gridDim.z;
    unsigned sum, cnt, mine, sp = 0u;
    for (;;) {
        sum = 0u; cnt = 0u; mine = 0u;
#pragma unroll
        for (unsigned j = 0; j < 16; ++j) { const unsigned c = xb_ld(&bar[XB_XCNT(j)]); sum += c; cnt += (c > 0u) ? 1u : 0u; mine = (j == x) ? c : mine; }
        if (sum == G) break;
        __builtin_amdgcn_s_sleep(1);
        if ((++sp & 255u) == 0u) { if (xb_ld(&bar[XB_TMO])) break; if (sp > XB_SPIN_CAP) { atomicAdd(&bar[XB_TMO], 1u); break; } }
    }
    nloc = mine > 0u ? mine : 1u; nx = cnt > 0u ? cnt : 1u;
}

__device__ __forceinline__ void xcd_barrier(const XcdBarrier& b) {
    asm volatile("s_waitcnt vmcnt(0)" ::: "memory");
    __syncthreads();
    if (threadIdx.x == 0) {
        unsigned* bar = b.bar;
        __builtin_amdgcn_s_waitcnt(0);
        unsigned nloc = b.st[0], nx = b.st[1];
        if (nloc == 0u) { xcd_barrier_complete(bar, b.x, nloc, nx); b.st[0] = nloc; b.st[1] = nx; }
        const unsigned old = xb_add(&bar[XB_XSUB(b.x)], 1u);
        const unsigned gen = old / nloc;
        if (old + 1u == (gen + 1u) * nloc) {
            __builtin_amdgcn_fence(__ATOMIC_RELEASE, "agent");
            asm volatile("s_waitcnt vmcnt(0)" ::: "memory");
            const unsigned og = xb_add(&bar[XB_TOP], 1u);
            const unsigned tg = og / nx;
            if (og + 1u == (tg + 1u) * nx) xb_add(&bar[XB_TOPGEN], 1u);
            else XB_SPIN(xb_ld(&bar[XB_TOPGEN]) == tg, bar);
            __builtin_amdgcn_fence(__ATOMIC_ACQUIRE, "agent");
            xb_add(&bar[XB_XGEN(b.x)], 1u);
            asm volatile("s_waitcnt vmcnt(0)" ::: "memory");
        } else {
            XB_SPIN(xb_ld(&bar[XB_XGEN(b.x)]) == gen, bar);
            __builtin_amdgcn_fence(__ATOMIC_ACQUIRE, "agent");
            asm volatile("s_waitcnt vmcnt(0)" ::: "memory");
        }
    }
    __syncthreads();
}

__global__ void __launch_bounds__(NTHREADS) mega(Params p, int ph_lo, int ph_hi) {
  extern __shared__ __attribute__((aligned(16))) char smem[];
  cg::grid_group grid = cg::this_grid();
  volatile XLAS unsigned* xst = (volatile XLAS unsigned*)(smem + 132096);
  if (tid_() == 0) { xst[0] = 0u; xst[1] = 0u; }
  __syncthreads();
  XcdBarrier xb = xcd_barrier_post((unsigned*)(p.ws + OFF_BAR), xst);
  for (int ph = ph_lo; ph < ph_hi; ++ph) {
    const int layer = ph >> 4, sp = ph & 15;
    switch (sp) {
      case 0:
      case 13:
        if (sp == 0 && blockIdx.x == 0) {
          const int t0_ = tid_();
          if (t0_ == 0) ((int*)(p.ws + OFF_CTR))[layer] = 0;
          if (t0_ < 384) ((u32*)(p.ws + OFF_FLAG))[layer * 384 + t0_] = 0u;
        }
        phase_norm(p, ph == 0, (sp == 0 ? p.in[2] : p.in[33]) + layer * 1024, (u16*)(p.ws + OFF_HN), 0, NTOK);
        if (sp == 0) conv_ffn(p, layer, 0, smem);
        break;
      case 1:
      case 14:
        phase_ffn_a(p, smem);
        break;
      case 2:
      case 15:
        phase_ffn_b(p, ph == 2, smem);
        if (sp == 2) conv_mix(p, layer, smem);
        break;
      case 3:
      case 5:
      case 10: {
        const bool full = (sp == 10);
        const long lo = full ? 0 : (sp == 3 ? 0 : 32768), hi = full ? NTOK : lo + 32768;
        phase_norm(p, false, p.in[6] + layer * 1024, (u16*)(p.ws + (full ? OFF_HN2 : OFF_Y)), lo, hi);
        break;
      }
      case 4:
      case 6:
        phase_proj(p, sp == 6, smem);
        break;
      case 7: phase_mixer1(p, layer, smem); break;
      case 8: phase_s5p2(p, layer, smem); break;
      case 9: phase_glu(p, smem); break;
      case 11: phase_m(p, smem); break;
      case 12:
        phase_out(p, smem);
        conv_ffn(p, layer, 1, smem);
        break;
    }
    if (ph + 1 < ph_hi) {
      if (ph == ph_lo) {
        asm volatile("s_waitcnt vmcnt(0)" ::: "memory");
        __syncthreads();
        if (tid_() < 64) {
          __builtin_amdgcn_fence(__ATOMIC_RELEASE, "agent");
          asm volatile("s_waitcnt vmcnt(0)" ::: "memory");
        }
        grid.sync();
        if (tid_() < 64) {
          __builtin_amdgcn_fence(__ATOMIC_ACQUIRE, "agent");
          asm volatile("s_waitcnt vmcnt(0)" ::: "memory");
        }
        __syncthreads();
      } else {
        xcd_barrier(xb);
      }
    }
  }
}

extern "C" void kernel_launch(void* const* d_in, const int* in_sizes, int n_in, void* d_out, int out_size, void* d_ws,
                              size_t ws_size, hipStream_t stream) {
  static int grid_blocks = 0;
  if (!grid_blocks) {
    int dev = 0, cus = 0, per_cu = 0;
    hipGetDevice(&dev);
    hipDeviceGetAttribute(&cus, hipDeviceAttributeMultiprocessorCount, dev);
    hipFuncSetAttribute((const void*)mega, hipFuncAttributeMaxDynamicSharedMemorySize, SMEM_BYTES);
    hipOccupancyMaxActiveBlocksPerMultiprocessor(&per_cu, mega, NTHREADS, SMEM_BYTES);
    if (per_cu < 1) per_cu = 1;
    grid_blocks = cus * per_cu;
  }
  if (ws_size < (size_t)WS_NEED) {
    fprintf(stderr, "workspace too small: %zu\n", ws_size);
    return;
  }
  Params p{};
  for (int i = 0; i < 37; ++i) p.in[i] = (const float*)d_in[i];
  p.out = (float*)d_out;
  p.ws = (char*)d_ws;
  hipMemsetAsync((char*)d_ws + OFF_BAR, 0, XCD_BAR_WORDS * sizeof(unsigned), stream);
#ifndef ONE_LAUNCH
  for (int ph = 0; ph < 32; ++ph) {
    hipLaunchKernelGGL(mega, dim3(grid_blocks), dim3(NTHREADS), SMEM_BYTES, stream, p, ph, ph + 1);
  }
#else
  int lo = 0, hi = 32;
  void* args[] = {&p, &lo, &hi};
  hipError_t e = hipLaunchCooperativeKernel((const void*)mega, dim3(grid_blocks), dim3(NTHREADS), args, SMEM_BYTES, stream);
  if (e != hipSuccess) fprintf(stderr, "cooperative launch failed: %s (grid %d)\n", hipGetErrorString(e), grid_blocks);
#endif
}
```

```cpp
#include <hip/hip_runtime.h>
#include <hip/hip_cooperative_groups.h>
#include <cstdio>
namespace cg = cooperative_groups;

typedef unsigned short u16;
typedef unsigned int u32;
typedef unsigned long long u64;
typedef __attribute__((ext_vector_type(8))) short bf16x8;
typedef __attribute__((ext_vector_type(16))) float f32x16;
typedef __attribute__((ext_vector_type(4))) float f32x4;
typedef __bf16 bf2_t __attribute__((ext_vector_type(2)));
typedef float f2_t __attribute__((ext_vector_type(2)));

#define ONE_LAUNCH 1
#define NTOK 65536
#define NTHREADS 512
#define SMEM_BYTES 135168
#define AS_BYTES 36864
#define BS_BYTES 18432
#define MISC_OFF 110592

#define OFF_A 0L
#define OFF_Z 167772160L
#define OFF_Y 419430400L
#define OFF_H 0L
#define OFF_HN2 0L
#define OFF_M 134217728L
#define OFF_YA 268435456L
#define OFF_YB 335544320L
#define OFF_SCR0 402653184L
#define OFF_F 369098752L
#define OFF_FD (OFF_F + 11534336L)
#define OFF_HN 386400256L
#define OFF_WM 486539264L
#define OFF_WIN OFF_WM
#define OFF_WGLU (OFF_WM + 12845056L)
#define OFF_WB (OFF_WGLU + 524288L)
#define OFF_WOUT (OFF_WB + 3145728L)
#define OFF_CAR 505151488L
#define OFF_CTR 521928704L
#define OFF_BAR 521936896L
#define WS_NEED 521952256L

struct Params {
  const float* in[37];
  float* out;
  char* ws;
};

__device__ __forceinline__ int tid_() {
  int t = threadIdx.x;
  asm volatile("" : "+v"(t));
  return t;
}
__device__ __forceinline__ u32 pack2(float a, float b) {
  f2_t v = {a, b};
  bf2_t r = __builtin_convertvector(v, bf2_t);
  return *(u32*)&r;
}
__device__ __forceinline__ u16 f2bf(float a) { return (u16)(pack2(a, 0.f) & 0xffffu); }
__device__ __forceinline__ float bflo(u32 v) { return __uint_as_float(v << 16); }
__device__ __forceinline__ float bfhi(u32 v) { return __uint_as_float(v & 0xffff0000u); }
__device__ __forceinline__ float sigm(float x) { return 1.f / (1.f + __expf(-x)); }
__device__ __forceinline__ float dpp_xor1(float v) {
  return __int_as_float(__builtin_amdgcn_mov_dpp(__float_as_int(v), 0xB1, 0xF, 0xF, true));
}
__device__ __forceinline__ float frcp(float x) { return __builtin_amdgcn_rcpf(x); }
__device__ __forceinline__ float fsig(float x) { return __builtin_amdgcn_rcpf(1.f + __expf(-x)); }
__device__ __forceinline__ float dpp_ror1(float v) {
  return __int_as_float(__builtin_amdgcn_mov_dpp(__float_as_int(v), 0x121, 0xF, 0xF, true));
}
__device__ __forceinline__ float dpp_ror2(float v) {
  return __int_as_float(__builtin_amdgcn_mov_dpp(__float_as_int(v), 0x122, 0xF, 0xF, true));
}
__device__ __forceinline__ float dpp_ror4(float v) {
  return __int_as_float(__builtin_amdgcn_mov_dpp(__float_as_int(v), 0x124, 0xF, 0xF, true));
}
__device__ __forceinline__ float dpp_ror8(float v) {
  return __int_as_float(__builtin_amdgcn_mov_dpp(__float_as_int(v), 0x128, 0xF, 0xF, true));
}
__device__ __forceinline__ float dpp_xor2(float v) {
  return __int_as_float(__builtin_amdgcn_mov_dpp(__float_as_int(v), 0x4E, 0xF, 0xF, true));
}

namespace pg8 {
#define PG8_LAS __attribute__((address_space(3)))
typedef unsigned short bf16_t;
typedef short bf16x8 __attribute__((ext_vector_type(8)));
typedef float f32x4 __attribute__((ext_vector_type(4)));
typedef unsigned u32x4 __attribute__((ext_vector_type(4)));
constexpr int BM = 256, BK = 64, HALF = 128, HTB = HALF * BK * 2  , STAGE_BYTES = 8 * HTB, NXCD = 8, WGM = 8;

__host__ __device__ __forceinline__ int lds_byte(int r, int c) { const int st = (r >> 4) * 2 + (c >> 5), rr = r & 15, cc = c & 31, ob = rr * 64 + cc * 2; return st * 1024 + (ob ^ (((ob >> 9) & 1) << 5)); }
__host__ __device__ __forceinline__ void stage_rc(int b, int& R, int& C) { const int st = b / 1024, sb = b % 1024, swz = sb ^ (((sb >> 9) & 1) << 5); R = (st >> 1) * 16 + swz / 64; C = (st & 1) * 32 + (swz % 64) / 2; }
__host__ __device__ __forceinline__ int perm32(int rho) { const int n = rho >> 4, i = rho & 15; return 8 * (i >> 2) + 4 * n + (i & 3); }
struct Unit { int pm, pn; };
struct Gemm { const bf16_t* A; const bf16_t* Bt; int M, N, K, lda, ldb; };
struct StaticOrder {
    int nM, nN, nwg, G, c;
    __host__ __device__ void init(int M, int N, int G_, int c_) { nM = M / BM; nN = N / BM; nwg = nM * nN; G = G_; c = c_; }
    __host__ __device__ bool next(int i, Unit& u) const {
        const long L = (long)i * G + c; if (L >= nwg) return false;
        int wgid = (int)L; { const int q = nwg / NXCD, r = nwg % NXCD, xcd = wgid % NXCD, off = wgid / NXCD; wgid = (xcd < r ? xcd * (q + 1) : r * (q + 1) + (xcd - r) * q) + off; }
        const int nig = WGM * nN, gid = wgid / nig, fm = gid * WGM, gsz = (nM - fm) < WGM ? (nM - fm) : WGM;
        u.pm = fm + ((wgid % nig) % gsz); u.pn = (wgid % nig) / gsz; return true;
    }
    __device__ __forceinline__ void a_ready(const Unit&) const {}
    __device__ __forceinline__ void done(const Unit&) const {}
};
template <class Epi, class Sched, bool STAMP = false>
__device__ __forceinline__ void gemm_phase(PG8_LAS unsigned char* lds, const Gemm g, const Sched& S, const Epi& E, unsigned long long* stamps) {
    const int tid = tid_(), wid = __builtin_amdgcn_readfirstlane(tid >> 6), lane = tid & 63, wr = wid >> 2, wc = wid & 3, fr = lane & 15, fq = lane >> 4;
    const int K = g.K, nt = K / BK;
    int ts_lo = 0, ts_hi = 0, nts = 0; const unsigned long long rt_entry = STAMP ? 0ull : 0ull;
#define PG8_STAMP() do { if (STAMP && wid == 0 && nts < 64) { const unsigned long long _c = (unsigned long long)clock64(); \
        ts_lo = (lane == nts) ? (int)(unsigned)_c : ts_lo; ts_hi = (lane == nts) ? (int)(unsigned)(_c >> 32) : ts_hi; ++nts; } } while (0)
    PG8_STAMP();
    unsigned voffA[2], voffB[2];
#pragma unroll
    for (int i = 0; i < 2; ++i) { int R, C; stage_rc(tid * 16 + i * 8192, R, C); const int Rb = Epi::PERM ? ((R & ~31) + perm32(R & 31)) : R;
        voffA[i] = (unsigned)(R * g.lda + C) * 2u; voffB[i] = (unsigned)(Rb * g.ldb + C) * 2u; }
    const size_t kstep = (size_t)(BK * 2);
    const size_t hstepA = (size_t)HALF * g.lda * 2, hstepB = (size_t)HALF * g.ldb * 2;
    const size_t tstepA = 2 * hstepA, tstepB = 2 * hstepB;
    const unsigned ldsw = (unsigned)wid * 1024u;
    const int aoff = lds_byte(wr * 64 + fr, fq * 8), boff = lds_byte(wc * 32 + fr, fq * 8);
#define PG8_SA(b, h) (((b) * 2 + (h)) * HTB)
#define PG8_SB(b, h) ((4 + (b) * 2 + (h)) * HTB)
#define PG8_STAGE(bufoff, gbase, voff) do { _Pragma("unroll") for (int _i = 0; _i < 2; ++_i) \
        __builtin_amdgcn_global_load_lds((const unsigned*)((const char*)(gbase) + (voff)[_i]), (PG8_LAS unsigned*)(lds + (bufoff) + ldsw + _i * 8192), 16, 0, 0); } while (0)
#define PG8_LDA(dst, b, h) do { _Pragma("unroll") for (int m = 0; m < 4; ++m) _Pragma("unroll") for (int k = 0; k < 2; ++k) dst[m][k] = *(const PG8_LAS bf16x8*)(lds + PG8_SA(b, h) + aoff + m * 2048 + k * 1024); } while (0)
#define PG8_LDB(dst, b, h) do { _Pragma("unroll") for (int n = 0; n < 2; ++n) _Pragma("unroll") for (int k = 0; k < 2; ++k) dst[n][k] = *(const PG8_LAS bf16x8*)(lds + PG8_SB(b, h) + boff + n * 2048 + k * 1024); } while (0)
#define PG8_MMA(ai, bj, At, Bt) do { __builtin_amdgcn_s_setprio(1); _Pragma("unroll") for (int m = 0; m < 4; ++m) _Pragma("unroll") for (int n = 0; n < 2; ++n) _Pragma("unroll") for (int k = 0; k < 2; ++k) \
        acc[ai][bj][m][n] = __builtin_amdgcn_mfma_f32_16x16x32_bf16(Bt[n][k], At[m][k], acc[ai][bj][m][n], 0, 0, 0); __builtin_amdgcn_s_setprio(0); } while (0)
#define PG8_WAIT_V(n) asm volatile("s_waitcnt vmcnt(" #n ")" ::: "memory")
#define PG8_WAIT_L(n) asm volatile("s_waitcnt lgkmcnt(" #n ")" ::: "memory")
#define PG8_BAR __builtin_amdgcn_s_barrier()
#define PG8_SCHED __builtin_amdgcn_sched_barrier(0)
    Unit cur, nxt; int ui = 0;
    if (!S.next(0, cur)) return;
    f32x4 acc[2][2][4][2];
#pragma unroll
    for (int a = 0; a < 2; ++a)
#pragma unroll
        for (int b = 0; b < 2; ++b)
#pragma unroll
            for (int m = 0; m < 4; ++m)
#pragma unroll
                for (int n = 0; n < 2; ++n) acc[a][b][m][n] = (f32x4){0.f, 0.f, 0.f, 0.f};
    bf16x8 At[4][2], B0[2][2], B1[2][2];
    const char* cA = (const char*)g.A + (size_t)cur.pm * tstepA; const char* cB = (const char*)g.Bt + (size_t)cur.pn * tstepB;
    S.a_ready(cur);
    PG8_STAGE(PG8_SB(0, 0), cB, voffB); PG8_STAGE(PG8_SA(0, 0), cA, voffA); PG8_STAGE(PG8_SB(0, 1), cB + hstepB, voffB); PG8_STAGE(PG8_SA(0, 1), cA + hstepA, voffA);
    if (wr == 1) PG8_BAR;
    PG8_WAIT_V(4); PG8_BAR;
    PG8_STAGE(PG8_SB(1, 0), cB + kstep, voffB); PG8_STAGE(PG8_SA(1, 0), cA + kstep, voffA); PG8_STAGE(PG8_SB(1, 1), cB + hstepB + kstep, voffB);
    PG8_WAIT_V(6); PG8_BAR;
    PG8_STAMP();
    for (;;) {
        const bool has_next = S.next(ui + 1, nxt);
        const char* nA = has_next ? (const char*)g.A + (size_t)nxt.pm * tstepA : cA; const char* nB = has_next ? (const char*)g.Bt + (size_t)nxt.pn * tstepB : cB;
        for (int t = 0; t < nt; t += 2) {
            const bool last = (t == nt - 2);
            const char* a1 = cA + (size_t)(t + 1) * kstep;
            const char* a2 = last ? nA : cA + (size_t)(t + 2) * kstep; const char* b2 = last ? nB : cB + (size_t)(t + 2) * kstep;
            const char* a3 = a2 + kstep; const char* b3 = b2 + kstep;
            if (last && has_next) S.a_ready(nxt);
            PG8_LDB(B0, 0, 0); PG8_SCHED; PG8_LDA(At, 0, 0); PG8_STAGE(PG8_SA(1, 1), a1 + hstepA, voffA);
            PG8_WAIT_L(8); PG8_BAR; PG8_WAIT_L(0); PG8_MMA(0, 0, At, B0); PG8_BAR; PG8_SCHED;
            PG8_LDB(B1, 0, 1); PG8_STAGE(PG8_SB(0, 0), b2, voffB);
            PG8_BAR; PG8_WAIT_L(0); PG8_MMA(0, 1, At, B1); PG8_BAR;
            PG8_LDA(At, 0, 1); PG8_STAGE(PG8_SA(0, 0), a2, voffA);
            PG8_BAR; PG8_WAIT_L(0); PG8_MMA(1, 0, At, B0); PG8_BAR; PG8_SCHED;
            PG8_STAGE(PG8_SB(0, 1), b2 + hstepB, voffB);
            PG8_WAIT_V(6); PG8_BAR; PG8_MMA(1, 1, At, B1); PG8_BAR;
            PG8_LDB(B0, 1, 0); PG8_SCHED; PG8_LDA(At, 1, 0); PG8_STAGE(PG8_SA(0, 1), a2 + hstepA, voffA);
            PG8_WAIT_L(8); PG8_BAR; PG8_WAIT_L(0); PG8_MMA(0, 0, At, B0); PG8_BAR; PG8_SCHED;
            PG8_LDB(B1, 1, 1); PG8_STAGE(PG8_SB(1, 0), b3, voffB);
            PG8_BAR; PG8_WAIT_L(0); PG8_MMA(0, 1, At, B1); PG8_BAR;
            PG8_LDA(At, 1, 1); PG8_STAGE(PG8_SA(1, 0), a3, voffA);
            PG8_BAR; PG8_WAIT_L(0); PG8_MMA(1, 0, At, B0); PG8_BAR; PG8_SCHED;
            PG8_STAGE(PG8_SB(1, 1), b3 + hstepB, voffB);
            PG8_WAIT_V(6); PG8_BAR; PG8_MMA(1, 1, At, B1); PG8_BAR;
        }
        PG8_STAMP();
        if constexpr (!Epi::AFTER_DRAIN) { E(acc, cur, wr, wc, fr, fq); S.done(cur); }
        PG8_STAMP();
        if (!has_next) break;
#pragma unroll
        for (int a = 0; a < 2; ++a)
#pragma unroll
            for (int b = 0; b < 2; ++b)
#pragma unroll
                for (int m = 0; m < 4; ++m)
#pragma unroll
                    for (int n = 0; n < 2; ++n) acc[a][b][m][n] = (f32x4){0.f, 0.f, 0.f, 0.f};
        cur = nxt; cA = nA; cB = nB; ++ui;
    }
    PG8_WAIT_V(0);
    if (wr == 0) PG8_BAR;
    PG8_BAR;
    if constexpr (Epi::AFTER_DRAIN) { E.fused(acc, cur, wr, wc, fr, fq, lds, wid, lane); S.done(cur); }
    PG8_STAMP();
    if (STAMP && wid == 0) { stamps[lane] = lane < nts ? (((unsigned long long)(unsigned)ts_hi << 32) | (unsigned)ts_lo) : 0ull;
        if (lane == 62) stamps[62] = rt_entry; if (lane == 63) stamps[63] = 0ull; }
#undef PG8_STAMP
#undef PG8_SA
#undef PG8_SB
#undef PG8_STAGE
#undef PG8_LDA
#undef PG8_LDB
#undef PG8_MMA
#undef PG8_WAIT_V
#undef PG8_WAIT_L
#undef PG8_BAR
#undef PG8_SCHED
}
}

struct EpiSwiglu {
  static constexpr bool PERM = true, AFTER_DRAIN = false;
  u16* H;
  __device__ __forceinline__ void operator()(const pg8::f32x4 (&acc)[2][2][4][2], const pg8::Unit& u, int wr, int wc, int fr,
                                             int fq) const {
    const int row0 = u.pm * 256 + wr * 64 + fr, col0 = u.pn * 128 + wc * 32 + 8 * fq;
#pragma unroll
    for (int ai = 0; ai < 2; ++ai)
#pragma unroll
      for (int m = 0; m < 4; ++m) {
        u16* rowp = H + (size_t)(row0 + ai * 128 + m * 16) * 2816 + col0;
        float v[8];
#pragma unroll
        for (int n = 0; n < 2; ++n)
#pragma unroll
          for (int j = 0; j < 4; ++j) {
            float g = acc[ai][0][m][n][j], uu = acc[ai][1][m][n][j];
            v[4 * n + j] = g * fsig(g) * uu;
          }
        uint4 o;
        o.x = pack2(v[0], v[1]); o.y = pack2(v[2], v[3]); o.z = pack2(v[4], v[5]); o.w = pack2(v[6], v[7]);
        *(uint4*)rowp = o;
      }
  }
};
struct EpiRes {
  static constexpr bool PERM = false, AFTER_DRAIN = false;
  float* out; const float* r0; const float* r1; float scale;
  __device__ __forceinline__ void operator()(const pg8::f32x4 (&acc)[2][2][4][2], const pg8::Unit& u, int wr, int wc, int fr,
                                             int fq) const {
    const int row0 = u.pm * 256 + wr * 64 + fr, col0 = u.pn * 256 + wc * 32 + 4 * fq;
#pragma unroll
    for (int ai = 0; ai < 2; ++ai)
#pragma unroll
      for (int m = 0; m < 4; ++m) {
        const long row = row0 + ai * 128 + m * 16;
        const float* rp = (r1 != nullptr && row >= 32768) ? r1 + (row - 32768) * 1024 : r0 + row * 1024;
        float* op = out + row * 1024;
#pragma unroll
        for (int bj = 0; bj < 2; ++bj)
#pragma unroll
          for (int n = 0; n < 2; ++n) {
            const int c = col0 + bj * 128 + n * 16;
            float4 x = *(const float4*)(rp + c);
            pg8::f32x4 a = acc[ai][bj][m][n];
            float4 o = make_float4(x.x + scale * a[0], x.y + scale * a[1], x.z + scale * a[2], x.w + scale * a[3]);
            *(float4*)(op + c) = o;
          }
      }
  }
};
struct EpiGlu {
  static constexpr bool PERM = true, AFTER_DRAIN = false;
  const u16* RA; u16* YA;
  __device__ __forceinline__ void operator()(const pg8::f32x4 (&acc)[2][2][4][2], const pg8::Unit& u, int wr, int wc, int fr,
                                             int fq) const {
    const int row0 = u.pm * 256 + wr * 64 + fr, col0 = u.pn * 256 + wc * 32 + 8 * fq;
#pragma unroll
    for (int ai = 0; ai < 2; ++ai)
#pragma unroll
      for (int m = 0; m < 4; ++m) {
        const long row = row0 + ai * 128 + m * 16;
#pragma unroll
        for (int bj = 0; bj < 2; ++bj) {
          const int c = col0 + bj * 128;
          uint4 y = *(const uint4*)(RA + row * 1280 + c);
          pg8::f32x4 a0 = acc[ai][bj][m][0], a1 = acc[ai][bj][m][1];
          uint4 o;
          o.x = pack2(bflo(y.x) * fsig(a0[0]), bfhi(y.x) * fsig(a0[1]));
          o.y = pack2(bflo(y.y) * fsig(a0[2]), bfhi(y.y) * fsig(a0[3]));
          o.z = pack2(bflo(y.z) * fsig(a1[0]), bfhi(y.z) * fsig(a1[1]));
          o.w = pack2(bflo(y.w) * fsig(a1[2]), bfhi(y.w) * fsig(a1[3]));
          *(uint4*)(YA + row * 512 + c) = o;
        }
      }
  }
};
struct EpiProj {
  static constexpr bool PERM = true, AFTER_DRAIN = false;
  u16* RA; u16* RZ; int row_off;
  __device__ __forceinline__ void operator()(const pg8::f32x4 (&acc)[2][2][4][2], const pg8::Unit& u, int wr, int wc, int fr,
                                             int fq) const {
    const int row0 = row_off + u.pm * 256 + wr * 64 + fr, col0 = u.pn * 256 + wc * 32 + 8 * fq;
#pragma unroll
    for (int ai = 0; ai < 2; ++ai)
#pragma unroll
      for (int m = 0; m < 4; ++m) {
        const long row = row0 + ai * 128 + m * 16;
#pragma unroll
        for (int bj = 0; bj < 2; ++bj) {
          const int c = col0 + bj * 128;
          if (c >= 3200) continue;
          u16* dst = (c < 1280) ? RA + row * 1280 + c : RZ + row * 1920 + (c - 1280);
          pg8::f32x4 a0 = acc[ai][bj][m][0], a1 = acc[ai][bj][m][1];
          uint4 o;
          o.x = pack2(a0[0], a0[1]); o.y = pack2(a0[2], a0[3]); o.z = pack2(a1[0], a1[1]); o.w = pack2(a1[2], a1[3]);
          *(uint4*)dst = o;
        }
      }
  }
};
struct EpiGate {
  static constexpr bool PERM = true, AFTER_DRAIN = false;
  uint4* scr;
  __device__ __forceinline__ void operator()(const pg8::f32x4 (&acc)[2][2][4][2], const pg8::Unit& u, int wr, int wc, int fr,
                                             int fq) const {
    const int t = (wr * 4 + wc) * 64 + fq * 16 + fr;
#pragma unroll
    for (int ai = 0; ai < 2; ++ai)
#pragma unroll
      for (int m = 0; m < 4; ++m)
#pragma unroll
        for (int bj = 0; bj < 2; ++bj) {
          pg8::f32x4 a0 = acc[ai][bj][m][0], a1 = acc[ai][bj][m][1];
          uint4 o;
          o.x = pack2(fsig(a0[0]), fsig(a0[1])); o.y = pack2(fsig(a0[2]), fsig(a0[3]));
          o.z = pack2(fsig(a1[0]), fsig(a1[1])); o.w = pack2(fsig(a1[2]), fsig(a1[3]));
          scr[((ai * 4 + m) * 2 + bj) * 512 + t] = o;
        }
  }
};
struct EpiUp {
  static constexpr bool PERM = true, AFTER_DRAIN = false;
  const uint4* scr; u16* Mo; bool first;
  __device__ __forceinline__ void operator()(const pg8::f32x4 (&acc)[2][2][4][2], const pg8::Unit& u, int wr, int wc, int fr,
                                             int fq) const {
    const int t = (wr * 4 + wc) * 64 + fq * 16 + fr;
    const int row0 = u.pm * 256 + wr * 64 + fr, col0 = u.pn * 256 + wc * 32 + 8 * fq;
#pragma unroll
    for (int ai = 0; ai < 2; ++ai)
#pragma unroll
      for (int m = 0; m < 4; ++m) {
        const long row = row0 + ai * 128 + m * 16;
#pragma unroll
        for (int bj = 0; bj < 2; ++bj) {
          uint4 g = scr[((ai * 4 + m) * 2 + bj) * 512 + t];
          pg8::f32x4 a0 = acc[ai][bj][m][0], a1 = acc[ai][bj][m][1];
          float v[8] = {bflo(g.x) * a0[0], bfhi(g.x) * a0[1], bflo(g.y) * a0[2], bfhi(g.y) * a0[3],
                        bflo(g.z) * a1[0], bfhi(g.z) * a1[1], bflo(g.w) * a1[2], bfhi(g.w) * a1[3]};
          u16* mp = Mo + row * 1024 + col0 + bj * 128;
          if (!first) {
            uint4 o = *(const uint4*)mp;
            v[0] += bflo(o.x); v[1] += bfhi(o.x); v[2] += bflo(o.y); v[3] += bfhi(o.y);
            v[4] += bflo(o.z); v[5] += bfhi(o.z); v[6] += bflo(o.w); v[7] += bfhi(o.w);
          }
          uint4 w;
          w.x = pack2(v[0], v[1]); w.y = pack2(v[2], v[3]); w.z = pack2(v[4], v[5]); w.w = pack2(v[6], v[7]);
          *(uint4*)mp = w;
        }
      }
  }
};
struct EpiGateG {
  static constexpr bool PERM = true, AFTER_DRAIN = false;
  u16* G;
  __device__ __forceinline__ void operator()(const pg8::f32x4 (&acc)[2][2][4][2], const pg8::Unit& u, int wr, int wc, int fr,
                                             int fq) const {
    const int row0 = u.pm * 256 + wr * 64 + fr, col0 = u.pn * 256 + wc * 32 + 8 * fq;
#pragma unroll
    for (int ai = 0; ai < 2; ++ai)
#pragma unroll
      for (int m = 0; m < 4; ++m) {
        const long row = row0 + ai * 128 + m * 16;
#pragma unroll
        for (int bj = 0; bj < 2; ++bj) {
          pg8::f32x4 a0 = acc[ai][bj][m][0], a1 = acc[ai][bj][m][1];
          uint4 o;
          o.x = pack2(fsig(a0[0]), fsig(a0[1])); o.y = pack2(fsig(a0[2]), fsig(a0[3]));
          o.z = pack2(fsig(a1[0]), fsig(a1[1])); o.w = pack2(fsig(a1[2]), fsig(a1[3]));
          *(uint4*)(G + row * 1024 + col0 + bj * 128) = o;
        }
      }
  }
};
struct EpiUpG {
  static constexpr bool PERM = true, AFTER_DRAIN = false;
  const u16* G; u16* Mo; bool first;
  __device__ __forceinline__ void operator()(const pg8::f32x4 (&acc)[2][2][4][2], const pg8::Unit& u, int wr, int wc, int fr,
                                             int fq) const {
    const int row0 = u.pm * 256 + wr * 64 + fr, col0 = u.pn * 256 + wc * 32 + 8 * fq;
#pragma unroll
    for (int ai = 0; ai < 2; ++ai)
#pragma unroll
      for (int m = 0; m < 4; ++m) {
        const long row = row0 + ai * 128 + m * 16;
#pragma unroll
        for (int bj = 0; bj < 2; ++bj) {
          const int c = col0 + bj * 128;
          uint4 g = *(const uint4*)(G + row * 1024 + c);
          pg8::f32x4 a0 = acc[ai][bj][m][0], a1 = acc[ai][bj][m][1];
          float v[8] = {bflo(g.x) * a0[0], bfhi(g.x) * a0[1], bflo(g.y) * a0[2], bfhi(g.y) * a0[3],
                        bflo(g.z) * a1[0], bfhi(g.z) * a1[1], bflo(g.w) * a1[2], bfhi(g.w) * a1[3]};
          u16* mp = Mo + row * 1024 + c;
          if (!first) {
            uint4 o = *(const uint4*)mp;
            v[0] += bflo(o.x); v[1] += bfhi(o.x); v[2] += bflo(o.y); v[3] += bfhi(o.y);
            v[4] += bflo(o.z); v[5] += bfhi(o.z); v[6] += bflo(o.w); v[7] += bfhi(o.w);
          }
          uint4 w;
          w.x = pack2(v[0], v[1]); w.y = pack2(v[2], v[3]); w.z = pack2(v[4], v[5]); w.w = pack2(v[6], v[7]);
          *(uint4*)mp = w;
        }
      }
  }
};
struct OneUnit {
  int pm, pn;
  __device__ __forceinline__ bool next(int i, pg8::Unit& u) const { if (i) return false; u.pm = pm; u.pn = pn; return true; }
  __device__ __forceinline__ void a_ready(const pg8::Unit&) const {}
  __device__ __forceinline__ void done(const pg8::Unit&) const {}
};
template <class Epi>
__device__ __forceinline__ void run_gemm8(char* smem, const u16* A, const u16* Bt, int N, int K, int lda, int ldb, const Epi& E,
                                          int M = NTOK) {
  pg8::Gemm g{A, Bt, M, N, K, lda, ldb};
  pg8::StaticOrder S;
  S.init(M, N, (int)gridDim.x, (int)blockIdx.x);
  pg8::gemm_phase<Epi, pg8::StaticOrder, false>((PG8_LAS unsigned char*)smem, g, S, E, nullptr);
}

__device__ __forceinline__ float row16_sum(float v) {
  v += dpp_ror1(v);
  v += dpp_ror2(v);
  v += dpp_ror4(v);
  v += dpp_ror8(v);
  return v;
}
template <bool AF32, int NI>
__device__ __forceinline__ void gemm_loop(const void* Aptr, long lda, const u16* Bt, long ldb, int K,
                                          f32x16 (&acc)[2][NI], float& ss, char* smem) {
  const int tid = tid_(), lane = tid & 63, w = tid >> 6;
  const int wm = w >> 1, wn = w & 1, lr = lane & 31, lh = lane >> 5;
  const int arow = tid >> 1, ahalf = tid & 1;
  const int brow = (NI == 2) ? (tid >> 2) : (tid >> 3), bq = (NI == 2) ? (tid & 3) : (tid & 7);
  const int nk = K >> 6;
  float4 raf[8];
  uint4 rab[4];
  uint4 rb[2];
  const float* Af = (const float*)Aptr + (long)arow * lda + 32 * ahalf;
  const u16* Ab = (const u16*)Aptr + (long)arow * lda + 32 * ahalf;
  const u16* Bp = Bt + (long)brow * ldb + 8 * NI * bq;
  char* a_dst = smem + arow * 144 + ahalf * 64;
  char* b_dst = smem + AS_BYTES + brow * 144 + bq * 16 * NI;
  const char* a_src = smem + (wm * 64 + lr) * 144 + lh * 16;
  const char* b_src = smem + AS_BYTES + (wn * 32 * NI + lr) * 144 + lh * 16;

#define G_LOAD(kt)                                                                       \
  {                                                                                      \
    if (AF32) {                                                                          \
      _Pragma("unroll") for (int i = 0; i < 8; ++i) raf[i] = *(const float4*)(Af + (kt) * 64 + 4 * i); \
    } else {                                                                             \
      _Pragma("unroll") for (int i = 0; i < 4; ++i) rab[i] = *(const uint4*)(Ab + (kt) * 64 + 8 * i); \
    }                                                                                    \
    rb[0] = *(const uint4*)(Bp + (kt) * 64);                                             \
    if (NI == 2) rb[1] = *(const uint4*)(Bp + (kt) * 64 + 8);                            \
  }
#define G_STORE(buf)                                                                     \
  {                                                                                      \
    char* ad = a_dst + (buf) * (AS_BYTES + BS_BYTES);                                    \
    char* bd = b_dst + (buf) * (AS_BYTES + BS_BYTES);                                    \
    if (AF32) {                                                                          \
      _Pragma("unroll") for (int i = 0; i < 4; ++i) {                                    \
        float4 x0 = raf[2 * i], x1 = raf[2 * i + 1];                                     \
        ss += x0.x * x0.x + x0.y * x0.y + x0.z * x0.z + x0.w * x0.w;                     \
        ss += x1.x * x1.x + x1.y * x1.y + x1.z * x1.z + x1.w * x1.w;                     \
        uint4 o;                                                                         \
        o.x = pack2(x0.x, x0.y); o.y = pack2(x0.z, x0.w);                                \
        o.z = pack2(x1.x, x1.y); o.w = pack2(x1.z, x1.w);                                \
        *(uint4*)(ad + 16 * i) = o;                                                      \
      }                                                                                  \
    } else {                                                                             \
      _Pragma("unroll") for (int i = 0; i < 4; ++i) *(uint4*)(ad + 16 * i) = rab[i];     \
    }                                                                                    \
    *(uint4*)(bd) = rb[0];                                                               \
    if (NI == 2) *(uint4*)(bd + 16) = rb[1];                                             \
  }

  G_LOAD(0);
  G_STORE(0);
  __syncthreads();
  for (int kt = 0; kt < nk; ++kt) {
    const int buf = kt & 1;
    if (kt + 1 < nk) G_LOAD(kt + 1);
    const char* as = a_src + buf * (AS_BYTES + BS_BYTES);
    const char* bs = b_src + buf * (AS_BYTES + BS_BYTES);
#pragma unroll
    for (int kk = 0; kk < 4; ++kk) {
      bf16x8 a0 = *(const bf16x8*)(as + kk * 32);
      bf16x8 a1 = *(const bf16x8*)(as + 32 * 144 + kk * 32);
      bf16x8 b0 = *(const bf16x8*)(bs + kk * 32);
      acc[0][0] = __builtin_amdgcn_mfma_f32_32x32x16_bf16(a0, b0, acc[0][0], 0, 0, 0);
      acc[1][0] = __builtin_amdgcn_mfma_f32_32x32x16_bf16(a1, b0, acc[1][0], 0, 0, 0);
      if (NI == 2) {
        bf16x8 b1 = *(const bf16x8*)(bs + 32 * 144 + kk * 32);
        acc[0][NI - 1] = __builtin_amdgcn_mfma_f32_32x32x16_bf16(a0, b1, acc[0][NI - 1], 0, 0, 0);
        acc[1][NI - 1] = __builtin_amdgcn_mfma_f32_32x32x16_bf16(a1, b1, acc[1][NI - 1], 0, 0, 0);
      }
    }
    if (kt + 1 < nk) G_STORE(buf ^ 1);
    __syncthreads();
  }
#undef G_LOAD
#undef G_STORE
}

template <int NI>
__device__ __forceinline__ void zero_acc(f32x16 (&acc)[2][NI]) {
#pragma unroll
  for (int i = 0; i < 2; ++i)
#pragma unroll
    for (int j = 0; j < NI; ++j)
#pragma unroll
      for (int r = 0; r < 16; ++r) acc[i][j][r] = 0.f;
}

__device__ __forceinline__ void publish_rstd(float ss, char* smem) {
  float tot = ss + __shfl_xor(ss, 1);
  float* rs = (float*)(smem + MISC_OFF);
  if ((tid_() & 1) == 0) rs[tid_() >> 1] = rsqrtf(tot * (1.f / 1024.f) + 1e-6f);
  __syncthreads();
}

__device__ __forceinline__ void decode_tile(int id, int NT, int& mt, int& nt) {
  int grp = id / (8 * NT);
  int loc = id - grp * 8 * NT;
  mt = grp * 8 + (loc & 7);
  nt = loc >> 3;
}

__device__ __forceinline__ const float* xin_row(const Params& p, long t) {
  return t < 32768 ? p.in[0] + t * 1024 : p.in[1] + (t - 32768) * 1024;
}

__device__ void conv_tile(const float* src, int N, int K, u16* dst, int rs, int off, int tile, char* smem,
                          const float* gain = nullptr, int sh = 5) {
  const int tid = tid_();
  float* tl = (float*)smem;
  int ntn = N >> 6;
  int kt = tile / ntn, nt = tile - kt * ntn;
  int k0 = kt * 64, n0 = nt * 64;
  __syncthreads();
  {
    int ty = tid >> 6, tx = tid & 63;
#pragma unroll
    for (int i = 0; i < 8; ++i) {
      int k = ty + 8 * i;
      float gv = gain ? gain[k0 + k] : 1.f;
      tl[k * 65 + tx] = src[(long)(k0 + k) * N + n0 + tx] * gv;
    }
  }
  __syncthreads();
  {
    int n = tid >> 3, kq = tid & 7;
    float v[8];
#pragma unroll
    for (int j = 0; j < 8; ++j) v[j] = tl[(8 * kq + j) * 65 + n];
    int nn = n0 + n;
    long drow = (long)(nn >> sh) * rs + (nn & ((1 << sh) - 1)) + off;
    uint4 o;
    o.x = pack2(v[0], v[1]); o.y = pack2(v[2], v[3]); o.z = pack2(v[4], v[5]); o.w = pack2(v[6], v[7]);
    *(uint4*)(dst + drow * K + k0 + 8 * kq) = o;
  }
}

__device__ __forceinline__ void conv_ffn(const Params& p, int layer, int which, char* smem) {
  const float* wg = p.in[which ? 34 : 3] + (long)layer * 1024 * 2816;
  const float* wu = p.in[which ? 35 : 4] + (long)layer * 1024 * 2816;
  const float* wd = p.in[which ? 36 : 5] + (long)layer * 1024 * 2816;
  u16* dgu = (u16*)(p.ws + OFF_F);
  u16* dd = (u16*)(p.ws + OFF_FD);
  for (int j = blockIdx.x; j < 2112; j += gridDim.x) {
    if (j < 704) conv_tile(wg, 2816, 1024, dgu, 256, 0, j, smem, nullptr, 7);
    else if (j < 1408) conv_tile(wu, 2816, 1024, dgu, 256, 128, j - 704, smem, nullptr, 7);
    else conv_tile(wd, 1024, 2816, dd, 32, 0, j - 1408, smem);
  }
}
__device__ __forceinline__ void conv_mix(const Params& p, int layer, char* smem) {
  const float* win = p.in[7] + (long)layer * 1024 * 6272;
  const float* wglu = p.in[16] + (long)layer * 512 * 512;
  const float* wb = p.in[31] + (long)layer * 3 * 512 * 1024;
  const float* wout = p.in[32] + (long)layer * 1024 * 1024;
  for (int j = blockIdx.x; j < 2272; j += gridDim.x) {
    if (j < 1568) conv_tile(win, 6272, 1024, (u16*)(p.ws + OFF_WIN), 32, 0, j, smem);
    else if (j < 1632) conv_tile(wglu, 512, 512, (u16*)(p.ws + OFF_WGLU), 32, 0, j - 1568, smem);
    else if (j < 2016) {
      int jj = j - 1632, i = jj >> 7;
      conv_tile(wb + (long)i * 512 * 1024, 1024, 512, (u16*)(p.ws + OFF_WB) + (long)i * 1024 * 512, 32, 0, jj & 127, smem);
    } else conv_tile(wout, 1024, 1024, (u16*)(p.ws + OFF_WOUT), 32, 0, j - 2016, smem);
  }
}

__device__ __forceinline__ void phase_norm(const Params& p, bool from_in, const float* gain, u16* dst, long row_lo,
                                           long row_hi) {
  const int lane = tid_() & 63, w = tid_() >> 6;
  for (long row = row_lo + (long)blockIdx.x * 8 + w; row < row_hi; row += (long)gridDim.x * 8) {
    const float* src = from_in ? xin_row(p, row) : p.out + row * 1024;
    float4 v[4];
    float ss = 0.f;
#pragma unroll
    for (int i = 0; i < 4; ++i) {
      v[i] = *(const float4*)(src + 4 * (i * 64 + lane));
      ss += v[i].x * v[i].x + v[i].y * v[i].y + v[i].z * v[i].z + v[i].w * v[i].w;
    }
#pragma unroll
    for (int m = 32; m >= 1; m >>= 1) ss += __shfl_xor(ss, m);
    float rstd = rsqrtf(ss * (1.f / 1024.f) + 1e-6f);
#pragma unroll
    for (int i = 0; i < 4; ++i) {
      float4 g = *(const float4*)(gain + 4 * (i * 64 + lane));
      uint2 o;
      o.x = pack2(v[i].x * rstd * g.x, v[i].y * rstd * g.y);
      o.y = pack2(v[i].z * rstd * g.z, v[i].w * rstd * g.w);
      *(uint2*)(dst + (row - row_lo) * 1024 + 4 * (i * 64 + lane)) = o;
    }
  }
}

__device__ __forceinline__ void phase_ffn_a(const Params& p, char* smem) {
  EpiSwiglu E{(u16*)(p.ws + OFF_H)};
  run_gemm8(smem, (const u16*)(p.ws + OFF_HN), (const u16*)(p.ws + OFF_F), 5632, 1024, 1024, 1024, E);
}

__device__ __forceinline__ void phase_ffn_b(const Params& p, bool from_in, char* smem) {
  EpiRes E{p.out, from_in ? p.in[0] : p.out, from_in ? p.in[1] : nullptr, 0.5f};
  run_gemm8(smem, (const u16*)(p.ws + OFF_H), (const u16*)(p.ws + OFF_FD), 1024, 2816, 2816, 2816, E);
}

__device__ __forceinline__ void phase_proj(const Params& p, int half, char* smem) {
  EpiProj E{(u16*)(p.ws + OFF_A), (u16*)(p.ws + OFF_Z), half * 32768};
  run_gemm8(smem, (const u16*)(p.ws + OFF_Y), (const u16*)(p.ws + OFF_WIN), 3328, 1024, 1024, 1024, E, 32768);
}

__device__ __forceinline__ void phase_glu(const Params& p, char* smem) {
  EpiGlu E{(const u16*)(p.ws + OFF_A), (u16*)(p.ws + OFF_YA)};
  run_gemm8(smem, (const u16*)(p.ws + OFF_A), (const u16*)(p.ws + OFF_WGLU), 512, 512, 1280, 512, E);
  const int lane = tid_() & 63, w = tid_() >> 6;
  const u16* RA = (const u16*)(p.ws + OFF_A);
  u16* YB = (u16*)(p.ws + OFF_YB);
  for (long row = (long)blockIdx.x * 8 + w; row < NTOK; row += (long)gridDim.x * 8)
    *(uint4*)(YB + row * 512 + 8 * lane) = *(const uint4*)(RA + row * 1280 + 512 + 8 * lane);
}

__device__ __forceinline__ void phase_m(const Params& p, char* smem) {
  const int b = blockIdx.x;
  uint4* scr = (uint4*)(b < 128 ? p.ws + OFF_SCR0 + (long)b * 131072 : p.ws + OFF_CAR + (long)(b - 128) * 131072);
  const u16* hn2 = (const u16*)(p.ws + OFF_HN2);
  const u16* win = (const u16*)(p.ws + OFF_WIN);
  const u16* wb = (const u16*)(p.ws + OFF_WB);
  u16* Mo = (u16*)(p.ws + OFF_M);
#pragma unroll 1
  for (int u = b; u < 1024; u += gridDim.x) {
    OneUnit S{u & 255, u >> 8};
#pragma unroll 1
    for (int i = 0; i < 3; ++i) {
      {
        pg8::Gemm g{hn2, win + (long)(3200 + 1024 * i) * 1024, NTOK, 1024, 1024, 1024, 1024};
        EpiGate E{scr};
        pg8::gemm_phase<EpiGate, OneUnit, false>((PG8_LAS unsigned char*)smem, g, S, E, nullptr);
      }
      {
        const u16* ya = (const u16*)(p.ws + (i == 0 ? OFF_YA : i == 1 ? OFF_YB : OFF_Y));
        pg8::Gemm g{ya, wb + (long)i * 1024 * 512, NTOK, 1024, 512, 512, 512};
        EpiUp E{(const uint4*)scr, Mo, i == 0};
        pg8::gemm_phase<EpiUp, OneUnit, false>((PG8_LAS unsigned char*)smem, g, S, E, nullptr);
      }
    }
  }
}

__device__ __forceinline__ void phase_out(const Params& p, char* smem) {
  EpiRes E{p.out, p.out, nullptr, 1.0f};
  run_gemm8(smem, (const u16*)(p.ws + OFF_M), (const u16*)(p.ws + OFF_WOUT), 1024, 1024, 1024, 1024, E);
}

#define KS_PITCH 144
#define VT_PITCH 784
__device__ __forceinline__ void attn_item(const Params& p, int layer, int item, char* smem) {
  const int tid = tid_(), lane = tid & 63, w = tid >> 6;
  const int lr = lane & 31, lh = lane >> 5;
  const int qb = item >> 1, kvh = item & 1;
  const long t0 = (long)qb * 128;
  int L, pos0;
  if (t0 < 32768) { L = 2048; pos0 = (int)(t0 & 2047); } else { L = 4096; pos0 = (int)((t0 - 32768) & 4095); }
  u16* RA = (u16*)(p.ws + OFF_A);
  char* Ks = smem;
  char* Vt = smem + 384 * KS_PITCH;
  float* gq = (float*)(smem + MISC_OFF);
  float* gk = gq + 64;
  __syncthreads();
  if (tid < 64) gq[tid] = p.in[17][layer * 64 + tid];
  else if (tid < 128) gk[tid - 64] = p.in[18][layer * 64 + tid - 64];
  __syncthreads();
  {
    const int q4 = tid & 3;
    for (int pass = 0; pass < 3; ++pass) {
      int r = pass * 128 + (tid >> 2);
      int kpos = pos0 - 128 + r;
      bool valid = (kpos >= 0) && (kpos < L);
      float kv[16], vv[16];
      if (valid) {
        const u16* kp = RA + (t0 - 128 + r) * 1280 + 1024 + kvh * 64 + 16 * q4;
        uint4 a = *(const uint4*)kp, b = *(const uint4*)(kp + 8);
        uint4 c = *(const uint4*)(kp + 128), d = *(const uint4*)(kp + 136);
        u32 ka[8] = {a.x, a.y, a.z, a.w, b.x, b.y, b.z, b.w};
        u32 va[8] = {c.x, c.y, c.z, c.w, d.x, d.y, d.z, d.w};
#pragma unroll
        for (int i = 0; i < 8; ++i) {
          kv[2 * i] = bflo(ka[i]); kv[2 * i + 1] = bfhi(ka[i]);
          vv[2 * i] = bflo(va[i]); vv[2 * i + 1] = bfhi(va[i]);
        }
      } else {
#pragma unroll
        for (int i = 0; i < 16; ++i) { kv[i] = 0.f; vv[i] = 0.f; }
      }
      float ss = 0.f;
#pragma unroll
      for (int i = 0; i < 16; ++i) ss += kv[i] * kv[i];
      ss += __shfl_xor(ss, 1);
      ss += __shfl_xor(ss, 2);
      float rstd = rsqrtf(ss * (1.f / 64.f) + 1e-6f);
#pragma unroll
      for (int i = 0; i < 16; ++i) kv[i] = kv[i] * rstd * gk[16 * q4 + i];
      if (q4 == 0) {
#pragma unroll
        for (int i = 0; i < 8; ++i) {
          float invf = __expf(-1.6402954f * (float)i);
          float rev = (float)kpos * invf * 0.15915494f;
          rev -= floorf(rev);
          float cs = __builtin_amdgcn_cosf(rev), sn = __builtin_amdgcn_sinf(rev);
          float t1 = kv[i], t2 = kv[8 + i];
          kv[i] = t1 * cs - t2 * sn;
          kv[8 + i] = t2 * cs + t1 * sn;
        }
      }
      uint4 o0, o1;
      o0.x = pack2(kv[0], kv[1]); o0.y = pack2(kv[2], kv[3]); o0.z = pack2(kv[4], kv[5]); o0.w = pack2(kv[6], kv[7]);
      o1.x = pack2(kv[8], kv[9]); o1.y = pack2(kv[10], kv[11]); o1.z = pack2(kv[12], kv[13]); o1.w = pack2(kv[14], kv[15]);
      *(uint4*)(Ks + r * KS_PITCH + q4 * 32) = o0;
      *(uint4*)(Ks + r * KS_PITCH + q4 * 32 + 16) = o1;
#pragma unroll
      for (int i = 0; i < 16; ++i) *(u16*)(Vt + (16 * q4 + i) * VT_PITCH + r * 2) = f2bf(vv[i]);
    }
  }
  __syncthreads();
  float gqm = 0.f, gkm = 0.f;
  for (int i = 0; i < 64; ++i) { gqm = fmaxf(gqm, fabsf(gq[i])); gkm = fmaxf(gkm, fabsf(gk[i])); }
  const float mb = 8.f * gqm * gkm;
  for (int uu = 0; uu < 2; ++uu) {
    const int u = 2 * w + uu;
    const int hl = u >> 2, qt = u & 3;
    const int head = kvh * 4 + hl;
    const long tq = t0 + 32 * qt + lr;
    const int qpos = pos0 + 32 * qt + lr;
    u16* qrow = RA + tq * 1280 + 512 + head * 64;
    bf16x8 qf[4];
    {
      uint4 qraw[8];
      float ss = 0.f;
#pragma unroll
      for (int i = 0; i < 8; ++i) {
        uint4 a = *(const uint4*)(qrow + 8 * i);
        qraw[i] = a;
        float f0 = bflo(a.x), f1 = bfhi(a.x), f2 = bflo(a.y), f3 = bfhi(a.y);
        float f4 = bflo(a.z), f5 = bfhi(a.z), f6 = bflo(a.w), f7 = bfhi(a.w);
        ss += f0 * f0 + f1 * f1 + f2 * f2 + f3 * f3 + f4 * f4 + f5 * f5 + f6 * f6 + f7 * f7;
      }
      const float rstd = rsqrtf(ss * (1.f / 64.f) + 1e-6f) * 0.125f;
      {
        uint4 lo = qraw[0], hi = qraw[1];
        float t1[8] = {bflo(lo.x), bfhi(lo.x), bflo(lo.y), bfhi(lo.y), bflo(lo.z), bfhi(lo.z), bflo(lo.w), bfhi(lo.w)};
        float t2[8] = {bflo(hi.x), bfhi(hi.x), bflo(hi.y), bfhi(hi.y), bflo(hi.z), bfhi(hi.z), bflo(hi.w), bfhi(hi.w)};
        float f[8];
#pragma unroll
        for (int i = 0; i < 8; ++i) {
          float invf = __expf(-1.6402954f * (float)i);
          float rev = (float)qpos * invf * 0.15915494f;
          rev -= floorf(rev);
          float cs = __builtin_amdgcn_cosf(rev), sn = __builtin_amdgcn_sinf(rev);
          float x1 = t1[i] * rstd * gq[i], x2 = t2[i] * rstd * gq[8 + i];
          float a = lh ? x2 : x1;
          float b = lh ? x1 : -x2;
          f[i] = a * cs + b * sn;
        }
        u32 pk[4] = {pack2(f[0], f[1]), pack2(f[2], f[3]), pack2(f[4], f[5]), pack2(f[6], f[7])};
        qf[0] = *(bf16x8*)pk;
      }
#pragma unroll
      for (int s = 1; s < 4; ++s) {
        uint4 lo = qraw[2 * s], hi = qraw[2 * s + 1];
        uint4 sel;
        sel.x = lh ? hi.x : lo.x; sel.y = lh ? hi.y : lo.y; sel.z = lh ? hi.z : lo.z; sel.w = lh ? hi.w : lo.w;
        const float* gp = gq + 16 * s + 8 * lh;
        float f[8] = {bflo(sel.x), bfhi(sel.x), bflo(sel.y), bfhi(sel.y), bflo(sel.z), bfhi(sel.z), bflo(sel.w), bfhi(sel.w)};
#pragma unroll
        for (int i = 0; i < 8; ++i) f[i] = f[i] * rstd * gp[i];
        u32 pk2[4] = {pack2(f[0], f[1]), pack2(f[2], f[3]), pack2(f[4], f[5]), pack2(f[6], f[7])};
        qf[s] = *(bf16x8*)pk2;
      }
    }
    f32x16 o0, o1;
#pragma unroll
    for (int r = 0; r < 16; ++r) { o0[r] = 0.f; o1[r] = 0.f; }
    float lsum = 0.f;
    for (int kt = qt; kt < qt + 9; ++kt) {
      f32x16 s;
#pragma unroll
      for (int r = 0; r < 16; ++r) s[r] = 0.f;
      const char* kb = Ks + (kt * 32 + lr) * KS_PITCH + lh * 16;
#pragma unroll
      for (int ks = 0; ks < 4; ++ks) {
        bf16x8 kf = *(const bf16x8*)(kb + ks * 32);
        s = __builtin_amdgcn_mfma_f32_32x32x16_bf16(kf, qf[ks], s, 0, 0, 0);
      }
      float pv[16];
#pragma unroll
      for (int r = 0; r < 16; ++r) {
        int kw = kt * 32 + (r & 3) + 8 * (r >> 2) + 4 * lh;
        int kpos = pos0 - 128 + kw;
        int dlt = kpos - qpos;
        bool ok = (dlt <= 128) && (dlt >= -128) && (kpos >= 0) && (kpos < L);
        float e = ok ? __expf(s[r] - mb) : 0.f;
        pv[r] = e;
        lsum += e;
      }
#pragma unroll
      for (int sk = 0; sk < 2; ++sk) {
        u32 pk[4] = {pack2(pv[8 * sk + 0], pv[8 * sk + 1]), pack2(pv[8 * sk + 2], pv[8 * sk + 3]),
                     pack2(pv[8 * sk + 4], pv[8 * sk + 5]), pack2(pv[8 * sk + 6], pv[8 * sk + 7])};
        bf16x8 pf = *(bf16x8*)pk;
        const char* vb = Vt + lr * VT_PITCH + (kt * 32 + 16 * sk + 4 * lh) * 2;
        uint2 va = *(const uint2*)(vb), vb2 = *(const uint2*)(vb + 16);
        u32 vk[4] = {va.x, va.y, vb2.x, vb2.y};
        bf16x8 vf0 = *(bf16x8*)vk;
        uint2 vc = *(const uint2*)(vb + 32 * VT_PITCH), vd = *(const uint2*)(vb + 32 * VT_PITCH + 16);
        u32 vk1[4] = {vc.x, vc.y, vd.x, vd.y};
        bf16x8 vf1 = *(bf16x8*)vk1;
        o0 = __builtin_amdgcn_mfma_f32_32x32x16_bf16(vf0, pf, o0, 0, 0, 0);
        o1 = __builtin_amdgcn_mfma_f32_32x32x16_bf16(vf1, pf, o1, 0, 0, 0);
      }
    }
    lsum += __shfl_xor(lsum, 32);
    lsum += __expf(p.in[19][layer * 8 + head] - mb);
    float inv = 1.f / lsum;
#pragma unroll
    for (int g = 0; g < 4; ++g) {
      uint2 a, b;
      a.x = pack2(o0[4 * g] * inv, o0[4 * g + 1] * inv); a.y = pack2(o0[4 * g + 2] * inv, o0[4 * g + 3] * inv);
      b.x = pack2(o1[4 * g] * inv, o1[4 * g + 1] * inv); b.y = pack2(o1[4 * g + 2] * inv, o1[4 * g + 3] * inv);
      *(uint2*)(qrow + 8 * g + 4 * lh) = a;
      *(uint2*)(qrow + 32 + 8 * g + 4 * lh) = b;
    }
  }
}

#define S5_WAVE_LDS 12800
#define WAVE_SYNC() do { asm volatile("" ::: "memory"); __builtin_amdgcn_wave_barrier(); asm volatile("" ::: "memory"); } while (0)
template <bool PASS2>
__device__ __forceinline__ void s5_unit(const Params& p, int layer, int unit, char* wsm) {
  const int lane = tid_() & 63;
  const int c = unit >> 5, g = unit & 31;
  const long t0 = (long)c * 128;
  float* BU = (float*)wsm;
  char* ST = wsm + 8448;
  u16* RA = (u16*)(p.ws + OFF_A);
  float* CAR = (float*)(p.ws + OFF_CAR);
  const int c16 = lane & 15, q = lane >> 4;
  const float rt_zero = (float)(blockIdx.x >> 24);
  const bf16x8 zfrag = {0, 0, 0, 0, 0, 0, 0, 0};
  bf16x8 uf[8];
#pragma unroll
  for (int sb = 0; sb < 8; ++sb) {
    bf16x8 v = *(const bf16x8*)(RA + (t0 + 16 * sb + c16) * 1280 + 16 * g + 8 * (q & 1));
    uf[sb] = (q < 2) ? v : zfrag;
  }
  f32x4 acc[8];
#pragma unroll
  for (int i = 0; i < 8; ++i) acc[i] = (f32x4){0.f, 0.f, 0.f, 0.f};
  int clo, chi;
  if (c < 256) { clo = c & ~15; chi = clo + 16; } else { clo = c & ~31; chi = clo + 32; }

#pragma unroll
  for (int d = 0; d < 2; ++d) {
    const long pg = ((long)(layer * 2 + d) * 32 + g);
    float lre = fminf(p.in[8][pg * 64 + lane], -1e-4f);
    float lim = p.in[9][pg * 64 + lane];
    float dt = expf(p.in[10][pg]);
    float er = expf(lre * dt);
    float ang = lim * dt;
    float nrev = rintf(ang * 0.15915494f);
    float rr = fmaf(-nrev, 6.28125f, ang);
    rr = fmaf(-nrev, 1.9353071795864769e-3f, rr);
    float ar = er * cosf(rr), ai = er * sinf(rr);
    float den = 1.f / (lre * lre + lim * lim);
    float nr = ar - 1.f;
    float c0r = (nr * lre + ai * lim) * den, c0i = (ai * lre - nr * lim) * den;
    WAVE_SYNC();
    {
      const float4* br = (const float4*)(p.in[11] + (pg * 64 + lane) * 16);
      const float4* bi = (const float4*)(p.in[12] + (pg * 64 + lane) * 16);
      u32 pr_[8], pi_[8];
#pragma unroll
      for (int i = 0; i < 4; ++i) {
        float4 x = br[i], y = bi[i];
        pr_[2 * i] = pack2(c0r * x.x - c0i * y.x, c0r * x.y - c0i * y.y);
        pr_[2 * i + 1] = pack2(c0r * x.z - c0i * y.z, c0r * x.w - c0i * y.w);
        pi_[2 * i] = pack2(c0r * y.x + c0i * x.x, c0r * y.y + c0i * x.y);
        pi_[2 * i + 1] = pack2(c0r * y.z + c0i * x.z, c0r * y.w + c0i * x.w);
      }
      uint4* dstr = (uint4*)((char*)BU + (2 * lane) * 32);
      dstr[0] = make_uint4(pr_[0], pr_[1], pr_[2], pr_[3]);
      dstr[1] = make_uint4(pr_[4], pr_[5], pr_[6], pr_[7]);
      dstr[2] = make_uint4(pi_[0], pi_[1], pi_[2], pi_[3]);
      dstr[3] = make_uint4(pi_[4], pi_[5], pi_[6], pi_[7]);
    }
    WAVE_SYNC();
    bf16x8 bfr[8];
#pragma unroll
    for (int nt = 0; nt < 8; ++nt) {
      bf16x8 v = *(const bf16x8*)((const char*)BU + (16 * nt + c16) * 32 + 16 * (q & 1));
      bfr[nt] = (q < 2) ? v : zfrag;
    }
    WAVE_SYNC();
    float sr = 0.f, si = 0.f;
    bf16x8 cf[4];
    if (PASS2) {
      float pr = ar, pi = ai;
#pragma unroll
      for (int i = 0; i < 7; ++i) { float t = pr * pr - pi * pi; pi = 2.f * pr * pi; pr = t; }
      if (d == 0) {
        for (int cc = clo; cc < c; ++cc) {
          float2 e = *(const float2*)(CAR + (((long)cc * 32 + g) * 2 + 0) * 128 + 2 * lane);
          float t = pr * sr - pi * si + e.x; si = pr * si + pi * sr + e.y; sr = t;
        }
      } else {
        for (int cc = chi - 1; cc > c; --cc) {
          float2 e = *(const float2*)(CAR + (((long)cc * 32 + g) * 2 + 1) * 128 + 2 * lane);
          float t = pr * sr - pi * si + e.x; si = pr * si + pi * sr + e.y; sr = t;
        }
      }
      const float* cre = p.in[13] + (pg * 16 + c16) * 64;
      const float* cim = p.in[14] + (pg * 16 + c16) * 64;
#pragma unroll
      for (int ks = 0; ks < 4; ++ks) {
        float4 x = *(const float4*)(cre + 16 * ks + 4 * q);
        float4 y = *(const float4*)(cim + 16 * ks + 4 * q);
        u32 pk[4] = {pack2(x.x, -y.x), pack2(x.y, -y.y), pack2(x.z, -y.z), pack2(x.w, -y.w)};
        cf[ks] = *(bf16x8*)pk;
      }
    }
#pragma unroll
    for (int sbi = 0; sbi < 8; ++sbi) {
      const int sb = d ? 7 - sbi : sbi;
      f32x4 z[8];
#pragma unroll
      for (int nt = 0; nt < 8; ++nt) {
        z[nt] = (f32x4){0.f, 0.f, 0.f, 0.f};
        z[nt] = __builtin_amdgcn_mfma_f32_16x16x32_bf16(uf[sb], bfr[nt], z[nt], 0, 0, 0);
      }
      __builtin_amdgcn_sched_barrier(0);
#pragma unroll
      for (int nt = 0; nt < 8; ++nt)
#pragma unroll
        for (int r = 0; r < 4; ++r) BU[(4 * q + r) * 132 + 16 * nt + c16] = z[nt][r] + rt_zero;
      asm volatile("s_waitcnt lgkmcnt(0)" ::: "memory");
      __builtin_amdgcn_sched_barrier(0);
      WAVE_SYNC();
#pragma unroll 4
      for (int s = 0; s < 16; ++s) {
        const int tl = d ? 15 - s : s;
        const float2 bu = *(const float2*)(BU + tl * 132 + 2 * lane);
        float t = ar * sr - ai * si + bu.x;
        si = ar * si + ai * sr + bu.y;
        sr = t;
        if (PASS2) *(u32*)(ST + tl * 272 + 4 * lane) = pack2(sr, si);
      }
      WAVE_SYNC();
      if (PASS2) {
        const char* ab = ST + c16 * 272 + q * 16;
#pragma unroll
        for (int ks = 0; ks < 4; ++ks) {
          bf16x8 af = *(const bf16x8*)(ab + ks * 64);
          acc[sb] = __builtin_amdgcn_mfma_f32_16x16x32_bf16(af, cf[ks], acc[sb], 0, 0, 0);
        }
        WAVE_SYNC();
      }
    }
    if (!PASS2) {
      float2 e = {sr, si};
      *(float2*)(CAR + (((long)c * 32 + g) * 2 + d) * 128 + 2 * lane) = e;
    }
  }
  if (PASS2) {
    const float dsk = p.in[15][(layer * 32 + g) * 16 + c16];
#pragma unroll
    for (int sb = 0; sb < 8; ++sb)
#pragma unroll
      for (int r = 0; r < 4; ++r) {
        int tau = sb * 16 + 4 * q + r;
        u16* up = RA + (t0 + tau) * 1280 + 16 * g + c16;
        float y = acc[sb][r] + dsk * bflo((u32)*up);
        float t = tanhf(0.7978845608f * (y + 0.044715f * y * y * y));
        y = 0.5f * y * (1.f + t);
        *up = f2bf(y);
      }
  }
}

template <bool PASS2>
__device__ __forceinline__ void s5_unit_old(const Params& p, int layer, int unit, char* wsm) {
  const int lane = tid_() & 63;
  const int c = unit >> 5, g = unit & 31;
  const long t0 = (long)c * 128;
  float* U = (float*)wsm;
  char* ST = wsm + 8192;
  u16* RA = (u16*)(p.ws + OFF_A);
  float* CAR = (float*)(p.ws + OFF_CAR);
  __builtin_amdgcn_wave_barrier();
#pragma unroll
  for (int i = 0; i < 2; ++i) {
    int tau = lane + 64 * i;
    const u16* src = RA + (t0 + tau) * 1280 + 16 * g;
    uint4 a = *(const uint4*)src, b = *(const uint4*)(src + 8);
    float4 f0 = {bflo(a.x), bfhi(a.x), bflo(a.y), bfhi(a.y)};
    float4 f1 = {bflo(a.z), bfhi(a.z), bflo(a.w), bfhi(a.w)};
    float4 f2 = {bflo(b.x), bfhi(b.x), bflo(b.y), bfhi(b.y)};
    float4 f3 = {bflo(b.z), bfhi(b.z), bflo(b.w), bfhi(b.w)};
    float4* d = (float4*)(U + tau * 16);
    d[0] = f0; d[1] = f1; d[2] = f2; d[3] = f3;
  }
  __builtin_amdgcn_wave_barrier();
  f32x4 acc[8];
#pragma unroll
  for (int i = 0; i < 8; ++i) acc[i] = (f32x4){0.f, 0.f, 0.f, 0.f};
  int clo, chi;
  if (c < 256) { clo = c & ~15; chi = clo + 16; } else { clo = c & ~31; chi = clo + 32; }

#pragma unroll
  for (int d = 0; d < 2; ++d) {
    const long pg = ((long)(layer * 2 + d) * 32 + g);
    float lre = fminf(p.in[8][pg * 64 + lane], -1e-4f);
    float lim = p.in[9][pg * 64 + lane];
    float dt = expf(p.in[10][pg]);
    float er = expf(lre * dt);
    float ang = lim * dt;
    float nrev = rintf(ang * 0.15915494f);
    float rr = fmaf(-nrev, 6.28125f, ang);
    rr = fmaf(-nrev, 1.9353071795864769e-3f, rr);
    float ar = er * cosf(rr), ai = er * sinf(rr);
    float den = 1.f / (lre * lre + lim * lim);
    float nr = ar - 1.f;
    float c0r = (nr * lre + ai * lim) * den, c0i = (ai * lre - nr * lim) * den;
    float Br[16], Bi[16];
    {
      const float4* br = (const float4*)(p.in[11] + (pg * 64 + lane) * 16);
      const float4* bi = (const float4*)(p.in[12] + (pg * 64 + lane) * 16);
#pragma unroll
      for (int i = 0; i < 4; ++i) {
        float4 x = br[i], y = bi[i];
        Br[4 * i + 0] = c0r * x.x - c0i * y.x; Bi[4 * i + 0] = c0r * y.x + c0i * x.x;
        Br[4 * i + 1] = c0r * x.y - c0i * y.y; Bi[4 * i + 1] = c0r * y.y + c0i * x.y;
        Br[4 * i + 2] = c0r * x.z - c0i * y.z; Bi[4 * i + 2] = c0r * y.z + c0i * x.z;
        Br[4 * i + 3] = c0r * x.w - c0i * y.w; Bi[4 * i + 3] = c0r * y.w + c0i * x.w;
      }
    }
    float sr = 0.f, si = 0.f;
    bf16x8 cf[4];
    if (PASS2) {
      float pr = ar, pi = ai;
#pragma unroll
      for (int i = 0; i < 7; ++i) { float t = pr * pr - pi * pi; pi = 2.f * pr * pi; pr = t; }
      if (d == 0) {
        for (int cc = clo; cc < c; ++cc) {
          float2 e = *(const float2*)(CAR + (((long)cc * 32 + g) * 2 + 0) * 128 + 2 * lane);
          float t = pr * sr - pi * si + e.x; si = pr * si + pi * sr + e.y; sr = t;
        }
      } else {
        for (int cc = chi - 1; cc > c; --cc) {
          float2 e = *(const float2*)(CAR + (((long)cc * 32 + g) * 2 + 1) * 128 + 2 * lane);
          float t = pr * sr - pi * si + e.x; si = pr * si + pi * sr + e.y; sr = t;
        }
      }
      const int h = lane & 15, q = lane >> 4;
      const float* cre = p.in[13] + (pg * 16 + h) * 64;
      const float* cim = p.in[14] + (pg * 16 + h) * 64;
#pragma unroll
      for (int ks = 0; ks < 4; ++ks) {
        float4 x = *(const float4*)(cre + 16 * ks + 4 * q);
        float4 y = *(const float4*)(cim + 16 * ks + 4 * q);
        u32 pk[4] = {pack2(x.x, -y.x), pack2(x.y, -y.y), pack2(x.z, -y.z), pack2(x.w, -y.w)};
        cf[ks] = *(bf16x8*)pk;
      }
    }
#pragma unroll
    for (int sbi = 0; sbi < 8; ++sbi) {
      const int sb = d ? 7 - sbi : sbi;
#pragma unroll 4
      for (int s = 0; s < 16; ++s) {
        const int tl = d ? 15 - s : s;
        const int tau = sb * 16 + tl;
        const float4* up = (const float4*)(U + tau * 16);
        float4 u0 = up[0], u1 = up[1], u2 = up[2], u3 = up[3];
        float uu[16] = {u0.x, u0.y, u0.z, u0.w, u1.x, u1.y, u1.z, u1.w, u2.x, u2.y, u2.z, u2.w, u3.x, u3.y, u3.z, u3.w};
        float bur = 0.f, bui = 0.f;
#pragma unroll
        for (int hh = 0; hh < 16; ++hh) { bur += Br[hh] * uu[hh]; bui += Bi[hh] * uu[hh]; }
        float t = ar * sr - ai * si + bur;
        si = ar * si + ai * sr + bui;
        sr = t;
        if (PASS2) *(u32*)(ST + tl * 272 + 4 * lane) = pack2(sr, si);
      }
      if (PASS2) {
        __builtin_amdgcn_wave_barrier();
        const char* ab = ST + (lane & 15) * 272 + (lane >> 4) * 16;
#pragma unroll
        for (int ks = 0; ks < 4; ++ks) {
          bf16x8 af = *(const bf16x8*)(ab + ks * 64);
          acc[sb] = __builtin_amdgcn_mfma_f32_16x16x32_bf16(af, cf[ks], acc[sb], 0, 0, 0);
        }
        __builtin_amdgcn_wave_barrier();
      }
    }
    if (!PASS2) {
      float2 e = {sr, si};
      *(float2*)(CAR + (((long)c * 32 + g) * 2 + d) * 128 + 2 * lane) = e;
    }
  }
  if (PASS2) {
    const int h = lane & 15, q = lane >> 4;
    const float dsk = p.in[15][(layer * 32 + g) * 16 + h];
#pragma unroll
    for (int sb = 0; sb < 8; ++sb)
#pragma unroll
      for (int r = 0; r < 4; ++r) {
        int tau = sb * 16 + 4 * q + r;
        float y = acc[sb][r] + dsk * U[tau * 16 + h];
        float t = tanhf(0.7978845608f * (y + 0.044715f * y * y * y));
        y = 0.5f * y * (1.f + t);
        RA[(t0 + tau) * 1280 + 16 * g + h] = f2bf(y);
      }
  }
}

#define OFF_FLAG (OFF_CTR + 1024)
__device__ __forceinline__ void rwkv_job(const Params& p, int layer, int job, char* smem) {
  const int tid = tid_(), lane = tid & 63, w = tid >> 6;
  const int pr = job >> 1, d = job & 1;
  int head, L;
  long tok0;
  if (pr < 64) { head = pr & 7; L = 4096; tok0 = 32768 + (long)(pr >> 3) * 4096; }
  else { int q = pr - 64; head = q & 7; L = 2048; tok0 = (long)(q >> 3) * 2048; }
  float* R = (float*)smem;
  float* KP = R + 2048; float* V = KP + 2048; float* W = V + 2048; float* NKK = W + 2048; float* KKA = NKK + 2048;
  float* AA = KKA + 2048; float* G = AA + 2048; float* YO = G + 2048;
  char* TW = smem + 73728; char* AL = TW + 4608; char* SG = AL + 4608;
  float* BON = (float*)(SG + 8704);
  float* MU = BON + 32;
  int* SPROG = (int*)(MU + 896);
  const u16* RZ = (const u16*)(p.ws + OFF_Z);
  u16* RY = (u16*)(p.ws + OFF_Y);
  u32* myflag = (u32*)(p.ws + OFF_FLAG) + layer * 384 + job;
  u32* paflag = (u32*)(p.ws + OFF_FLAG) + layer * 384 + (job ^ 1);
  const float* mu = p.in[20] + (long)layer * 2 * 1920;
  const float* w0 = p.in[21] + (long)(layer * 2 + d) * 512;
  const float* w2 = p.in[22] + (long)(layer * 2 + d) * 64 * 512;
  const float* a0 = p.in[23] + (long)(layer * 2 + d) * 512;
  const float* a2 = p.in[24] + (long)(layer * 2 + d) * 64 * 512;
  const float* g2 = p.in[25] + (long)layer * 128 * 512;
#define RW_ZB(v) ((v) == 0 ? 64 * head : (v) == 1 ? 512 + 64 * head : (v) == 2 ? 1024 + 64 * head \
                 : (v) == 3 ? 1536 + 64 * d : (v) == 4 ? 1664 + 64 * d : (v) == 5 ? 1792 : 1856)
  __syncthreads();
  for (int idx = tid; idx < 896; idx += NTHREADS) {
    int m = idx / 448, rem = idx - m * 448, v = rem >> 6, cc = rem & 63;
    MU[idx] = mu[m * 1920 + RW_ZB(v) + cc];
  }
  const int tau_a = tid >> 4, c4 = tid & 15;
  float kkc[4], kac[4], rkc[4], lnw[4], lnb[4];
#pragma unroll
  for (int e = 0; e < 4; ++e) {
    int cc = 64 * head + 4 * c4 + e;
    kkc[e] = p.in[26][layer * 512 + cc];
    kac[e] = p.in[27][layer * 512 + cc];
    rkc[e] = p.in[28][layer * 512 + cc];
    lnw[e] = p.in[29][layer * 512 + cc];
    lnb[e] = p.in[30][layer * 512 + cc];
  }
  const int c16 = lane & 15, q4 = lane >> 4;
  const int nt = w & 3, th = w >> 2;
  const int colb = 64 * head + 16 * nt + c16;
  bf16x8 w2f[2], a2f[2], g2f[4];
#pragma unroll
  for (int s = 0; s < 4; ++s) {
    float fw[8], fa[8], fg[8];
#pragma unroll
    for (int j = 0; j < 8; ++j) {
      int m = 32 * s + 8 * q4 + j;
      fg[j] = g2[(long)m * 512 + colb];
      if (s < 2) { fw[j] = w2[(long)m * 512 + colb]; fa[j] = a2[(long)m * 512 + colb]; }
    }
    u32 pg[4] = {pack2(fg[0], fg[1]), pack2(fg[2], fg[3]), pack2(fg[4], fg[5]), pack2(fg[6], fg[7])};
    g2f[s] = *(bf16x8*)pg;
    if (s < 2) {
      u32 pw[4] = {pack2(fw[0], fw[1]), pack2(fw[2], fw[3]), pack2(fw[4], fw[5]), pack2(fw[6], fw[7])};
      u32 pa[4] = {pack2(fa[0], fa[1]), pack2(fa[2], fa[3]), pack2(fa[4], fa[5]), pack2(fa[6], fa[7])};
      w2f[s] = *(bf16x8*)pw;
      a2f[s] = *(bf16x8*)pa;
    }
  }
  const float w0c = w0[colb], a0c = a0[colb];
  f2_t S2[2][2];
#pragma unroll
  for (int r = 0; r < 2; ++r) { S2[r][0] = (f2_t){0.f, 0.f}; S2[r][1] = (f2_t){0.f, 0.f}; }
  const int jq16 = lane & 15, rq = lane >> 4;
  const int row0 = 8 * w + 2 * rq;
  const int NC = L >> 5;
  uint2 zr[7][3];
  int prog = 0;

#define RW_LOAD(ci_)                                                                          \
  {                                                                                           \
    const int chunk_ = d ? NC - 1 - (ci_) : (ci_);                                            \
    const long t_ = tok0 + (long)chunk_ * 32 + tau_a;                                         \
    const int pos_ = chunk_ * 32 + tau_a;                                                     \
    const bool hp_ = pos_ > 0, hn_ = pos_ < L - 1;                                            \
    _Pragma("unroll") for (int v = 0; v < 7; ++v) {                                           \
      const u16* zp = RZ + t_ * 1920 + RW_ZB(v) + 4 * c4;                                     \
      zr[v][0] = *(const uint2*)zp;                                                           \
      zr[v][1] = hp_ ? *(const uint2*)(zp - 1920) : make_uint2(0u, 0u);                       \
      zr[v][2] = hn_ ? *(const uint2*)(zp + 1920) : make_uint2(0u, 0u);                       \
    }                                                                                         \
  }
#define RW_PREP_A()                                                                           \
  {                                                                                           \
    _Pragma("unroll") for (int v = 0; v < 7; ++v) {                                           \
      uint2 zc = zr[v][0], zpv = zr[v][1], znv = zr[v][2];                                    \
      float4 m0 = *(const float4*)(MU + v * 64 + 4 * c4);                                     \
      float4 m1 = *(const float4*)(MU + 448 + v * 64 + 4 * c4);                               \
      float zc4[4] = {bflo(zc.x), bfhi(zc.x), bflo(zc.y), bfhi(zc.y)};                        \
      float zp4[4] = {bflo(zpv.x), bfhi(zpv.x), bflo(zpv.y), bfhi(zpv.y)};                    \
      float zn4[4] = {bflo(znv.x), bfhi(znv.x), bflo(znv.y), bfhi(znv.y)};                    \
      float mm0[4] = {m0.x, m0.y, m0.z, m0.w}, mm1[4] = {m1.x, m1.y, m1.z, m1.w};             \
      float o[4];                                                                             \
      _Pragma("unroll") for (int e = 0; e < 4; ++e)                                           \
          o[e] = zc4[e] + mm0[e] * (zp4[e] - zc4[e]) + mm1[e] * (zn4[e] - zc4[e]);            \
      if (v == 0) *(float4*)(R + tau_a * 64 + 4 * c4) = make_float4(o[0], o[1], o[2], o[3]);  \
      else if (v == 1) *(float4*)(KP + tau_a * 64 + 4 * c4) = make_float4(o[0], o[1], o[2], o[3]); \
      else if (v == 2) *(float4*)(V + tau_a * 64 + 4 * c4) = make_float4(o[0], o[1], o[2], o[3]);  \
      else if (v == 3) {                                                                      \
        float th_[4];                                                                         \
        _Pragma("unroll") for (int e = 0; e < 4; ++e) th_[e] = 1.f - 2.f * frcp(1.f + __expf(2.f * o[e])); \
        *(uint2*)(TW + tau_a * 144 + 8 * c4) = make_uint2(pack2(th_[0], th_[1]), pack2(th_[2], th_[3])); \
      } else if (v == 4) {                                                                    \
        *(uint2*)(AL + tau_a * 144 + 8 * c4) = make_uint2(pack2(o[0], o[1]), pack2(o[2], o[3])); \
      } else {                                                                                \
        *(uint2*)(SG + tau_a * 272 + (v - 5) * 128 + 8 * c4) =                                \
            make_uint2(pack2(fsig(o[0]), fsig(o[1])), pack2(fsig(o[2]), fsig(o[3])));         \
      }                                                                                       \
    }                                                                                         \
  }
#define RW_PREP_B()                                                                           \
  {                                                                                           \
    f32x4 cw = {0.f, 0.f, 0.f, 0.f}, ca = cw, cgt = cw;                                       \
    const int tr_ = 16 * th + c16;                                                            \
    _Pragma("unroll") for (int s = 0; s < 2; ++s) {                                           \
      bf16x8 tf = *(const bf16x8*)(TW + tr_ * 144 + (32 * s + 8 * q4) * 2);                   \
      bf16x8 af = *(const bf16x8*)(AL + tr_ * 144 + (32 * s + 8 * q4) * 2);                   \
      cw = __builtin_amdgcn_mfma_f32_16x16x32_bf16(tf, w2f[s], cw, 0, 0, 0);                  \
      ca = __builtin_amdgcn_mfma_f32_16x16x32_bf16(af, a2f[s], ca, 0, 0, 0);                  \
    }                                                                                         \
    _Pragma("unroll") for (int s = 0; s < 4; ++s) {                                           \
      bf16x8 sf = *(const bf16x8*)(SG + tr_ * 272 + (32 * s + 8 * q4) * 2);                   \
      cgt = __builtin_amdgcn_mfma_f32_16x16x32_bf16(sf, g2f[s], cgt, 0, 0, 0);                \
    }                                                                                         \
    _Pragma("unroll") for (int r = 0; r < 4; ++r) {                                           \
      int tau = 16 * th + 4 * q4 + r, cc = 16 * nt + c16;                                     \
      W[tau * 64 + cc] = __expf(-0.60653066f * fsig(cw[r] + w0c));                            \
      AA[tau * 64 + cc] = fsig(ca[r] + a0c);                                                  \
      G[tau * 64 + cc] = cgt[r];                                                              \
    }                                                                                         \
  }
#define RW_PREP_C()                                                                           \
  {                                                                                           \
    float4 k4 = *(const float4*)(KP + tau_a * 64 + 4 * c4);                                   \
    float4 a4 = *(const float4*)(AA + tau_a * 64 + 4 * c4);                                   \
    float4 r4 = *(const float4*)(R + tau_a * 64 + 4 * c4);                                    \
    float kk[4] = {k4.x * kkc[0], k4.y * kkc[1], k4.z * kkc[2], k4.w * kkc[3]};               \
    float kx[4] = {k4.x, k4.y, k4.z, k4.w}, ax[4] = {a4.x, a4.y, a4.z, a4.w}, rx[4] = {r4.x, r4.y, r4.z, r4.w}; \
    float ss = kk[0] * kk[0] + kk[1] * kk[1] + kk[2] * kk[2] + kk[3] * kk[3];                 \
    float bn = rx[0] * kx[0] * rkc[0] + rx[1] * kx[1] * rkc[1] + rx[2] * kx[2] * rkc[2] + rx[3] * kx[3] * rkc[3]; \
    ss = row16_sum(ss); bn = row16_sum(bn);                                                   \
    float inv = 1.f / fmaxf(sqrtf(ss), 1e-12f);                                               \
    float nk[4], ka[4], kd[4];                                                                \
    _Pragma("unroll") for (int e = 0; e < 4; ++e) {                                           \
      float k1 = kk[e] * inv;                                                                 \
      nk[e] = -k1;                                                                            \
      ka[e] = k1 * ax[e];                                                                     \
      kd[e] = kx[e] * (1.f + (ax[e] - 1.f) * kac[e]);                                         \
    }                                                                                         \
    *(float4*)(NKK + tau_a * 64 + 4 * c4) = make_float4(nk[0], nk[1], nk[2], nk[3]);          \
    *(float4*)(KKA + tau_a * 64 + 4 * c4) = make_float4(ka[0], ka[1], ka[2], ka[3]);          \
    *(float4*)(KP + tau_a * 64 + 4 * c4) = make_float4(kd[0], kd[1], kd[2], kd[3]);           \
    if (c4 == 0) BON[tau_a] = bn;                                                             \
  }

  __syncthreads();
  RW_LOAD(0);
  RW_PREP_A();
  __syncthreads();
  RW_PREP_B();
  __syncthreads();
  RW_PREP_C();
  __syncthreads();

  for (int ci = 0; ci < NC; ++ci) {
    const int chunk = d ? NC - 1 - ci : ci;
    const long tb = tok0 + (long)chunk * 32;
    const bool more = (ci + 1 < NC);
    const bool second = ci >= (NC >> 1);
    if (more) RW_LOAD(ci + 1);
    u64* yp = (u64*)(RY + (tb + tau_a) * 512 + 64 * head + 4 * c4);
    u64 st = 0;
    if (second) {
      const int need = NC - ci;
      if (prog < need) {
        if (tid == 0) {
          int v = 0;
          for (unsigned spins = 0; spins < (1u << 24); ++spins) {
            v = (int)__hip_atomic_load(paflag, __ATOMIC_RELAXED, __HIP_MEMORY_SCOPE_AGENT);
            if (v >= need) break;
            __builtin_amdgcn_s_sleep(2);
          }
          *SPROG = v;
        }
        __syncthreads();
        prog = *SPROG;
        if (prog < need) prog = need;
      }
      st = __hip_atomic_load(yp, __ATOMIC_RELAXED, __HIP_MEMORY_SCOPE_AGENT);
    }
    {
      float yp0 = 0.f, yp1 = 0.f;
      int tprev = d ? 31 : 0;
#pragma unroll 2
      for (int s = 0; s < 32; ++s) {
        const int tau = d ? 31 - s : s;
        const int o = tau * 64 + 4 * jq16;
        const float4 w4 = *(const float4*)(W + o);
        const float4 n4 = *(const float4*)(NKK + o);
        const float4 a4 = *(const float4*)(KKA + o);
        const float4 d4 = *(const float4*)(KP + o);
        const float4 r4 = *(const float4*)(R + o);
        const float2 v2 = *(const float2*)(V + tau * 64 + row0);
        const f2_t w01 = {w4.x, w4.y}, w23 = {w4.z, w4.w}, n01 = {n4.x, n4.y}, n23 = {n4.z, n4.w};
        const f2_t a01 = {a4.x, a4.y}, a23 = {a4.z, a4.w}, d01 = {d4.x, d4.y}, d23 = {d4.z, d4.w};
        const f2_t r01 = {r4.x, r4.y}, r23 = {r4.z, r4.w};
        f2_t t0 = S2[0][0] * n01 + S2[0][1] * n23;
        f2_t t1 = S2[1][0] * n01 + S2[1][1] * n23;
        float q0 = t0.x + t0.y, q1 = t1.x + t1.y, q2 = yp0, q3 = yp1;
        asm("s_nop 1\n\t"
            "v_add_f32_dpp %0, %0, %0 row_ror:1 row_mask:0xf bank_mask:0xf bound_ctrl:1\n\t"
            "v_add_f32_dpp %1, %1, %1 row_ror:1 row_mask:0xf bank_mask:0xf bound_ctrl:1\n\t"
            "v_add_f32_dpp %2, %2, %2 row_ror:1 row_mask:0xf bank_mask:0xf bound_ctrl:1\n\t"
            "v_add_f32_dpp %3, %3, %3 row_ror:1 row_mask:0xf bank_mask:0xf bound_ctrl:1\n\t"
            "v_add_f32_dpp %0, %0, %0 row_ror:2 row_mask:0xf bank_mask:0xf bound_ctrl:1\n\t"
            "v_add_f32_dpp %1, %1, %1 row_ror:2 row_mask:0xf bank_mask:0xf bound_ctrl:1\n\t"
            "v_add_f32_dpp %2, %2, %2 row_ror:2 row_mask:0xf bank_mask:0xf bound_ctrl:1\n\t"
            "v_add_f32_dpp %3, %3, %3 row_ror:2 row_mask:0xf bank_mask:0xf bound_ctrl:1\n\t"
            "v_add_f32_dpp %0, %0, %0 row_ror:4 row_mask:0xf bank_mask:0xf bound_ctrl:1\n\t"
            "v_add_f32_dpp %1, %1, %1 row_ror:4 row_mask:0xf bank_mask:0xf bound_ctrl:1\n\t"
            "v_add_f32_dpp %2, %2, %2 row_ror:4 row_mask:0xf bank_mask:0xf bound_ctrl:1\n\t"
            "v_add_f32_dpp %3, %3, %3 row_ror:4 row_mask:0xf bank_mask:0xf bound_ctrl:1\n\t"
            "v_add_f32_dpp %0, %0, %0 row_ror:8 row_mask:0xf bank_mask:0xf bound_ctrl:1\n\t"
            "v_add_f32_dpp %1, %1, %1 row_ror:8 row_mask:0xf bank_mask:0xf bound_ctrl:1\n\t"
            "v_add_f32_dpp %2, %2, %2 row_ror:8 row_mask:0xf bank_mask:0xf bound_ctrl:1\n\t"
            "v_add_f32_dpp %3, %3, %3 row_ror:8 row_mask:0xf bank_mask:0xf bound_ctrl:1"
            : "+v"(q0), "+v"(q1), "+v"(q2), "+v"(q3));
        if (jq16 == 0) *(float2*)(YO + tprev * 64 + row0) = make_float2(q2, q3);
        tprev = tau;
        {
          const f2_t sv = {q0, q0}, vr = {v2.x, v2.x};
          S2[0][0] = S2[0][0] * w01 + (sv * a01 + vr * d01);
          S2[0][1] = S2[0][1] * w23 + (sv * a23 + vr * d23);
          f2_t t = S2[0][0] * r01 + S2[0][1] * r23;
          yp0 = t.x + t.y;
        }
        {
          const f2_t sv = {q1, q1}, vr = {v2.y, v2.y};
          S2[1][0] = S2[1][0] * w01 + (sv * a01 + vr * d01);
          S2[1][1] = S2[1][1] * w23 + (sv * a23 + vr * d23);
          f2_t t = S2[1][0] * r01 + S2[1][1] * r23;
          yp1 = t.x + t.y;
        }
      }
      yp0 = row16_sum(yp0);
      yp1 = row16_sum(yp1);
      if (jq16 == 0) *(float2*)(YO + tprev * 64 + row0) = make_float2(yp0, yp1);
    }
    __syncthreads();
    {
      float4 y4 = *(const float4*)(YO + tau_a * 64 + 4 * c4);
      float yv[4] = {y4.x, y4.y, y4.z, y4.w};
      if (!second) {
        u64 pk = (u64)pack2(yv[0], yv[1]) | ((u64)pack2(yv[2], yv[3]) << 32);
        __hip_atomic_store(yp, pk, __ATOMIC_RELAXED, __HIP_MEMORY_SCOPE_AGENT);
        asm volatile("s_waitcnt vmcnt(0)" ::: "memory");
      } else {
        u32 s0 = (u32)st, s1 = (u32)(st >> 32);
        yv[0] += bflo(s0); yv[1] += bfhi(s0); yv[2] += bflo(s1); yv[3] += bfhi(s1);
        float sm1 = row16_sum(yv[0] + yv[1] + yv[2] + yv[3]);
        float mean = sm1 * (1.f / 64.f);
        float vs = 0.f;
#pragma unroll
        for (int e = 0; e < 4; ++e) { float dd = yv[e] - mean; vs += dd * dd; }
        vs = row16_sum(vs);
        float rstd = rsqrtf(vs * (1.f / 64.f) + 64e-5f);
        float4 v4 = *(const float4*)(V + tau_a * 64 + 4 * c4);
        float4 g4 = *(const float4*)(G + tau_a * 64 + 4 * c4);
        float vv[4] = {v4.x, v4.y, v4.z, v4.w}, gg[4] = {g4.x, g4.y, g4.z, g4.w};
        float bn = BON[tau_a];
        float o[4];
#pragma unroll
        for (int e = 0; e < 4; ++e) o[e] = ((yv[e] - mean) * rstd * lnw[e] + lnb[e] + bn * vv[e]) * gg[e];
        *(uint2*)yp = make_uint2(pack2(o[0], o[1]), pack2(o[2], o[3]));
      }
    }
    if (more) RW_PREP_A();
    __syncthreads();
    if (!second && tid == 0) __hip_atomic_store(myflag, (u32)(ci + 1), __ATOMIC_RELAXED, __HIP_MEMORY_SCOPE_AGENT);
    if (more) {
      RW_PREP_B();
      __syncthreads();
      RW_PREP_C();
      __syncthreads();
    }
  }
#undef RW_ZB
#undef RW_LOAD
#undef RW_PREP_A
#undef RW_PREP_B
#undef RW_PREP_C
}

#define N_ATT_ITEMS 1024
#define N_S5_ITEMS 2048
__device__ __forceinline__ void phase_mixer1(const Params& p, int layer, char* smem) {
#ifndef NO_RW
  for (int slot = blockIdx.x; slot < 512; slot += gridDim.x) {
    const int job = slot < 256 ? slot : (slot < 384 ? -1 : slot - 128);
    if (job >= 0) rwkv_job(p, layer, job, smem);
  }
#endif
  int* ctr = (int*)(p.ws + OFF_CTR) + layer;
  int* sitem = (int*)(smem + MISC_OFF + 2048);
  const int w = tid_() >> 6;
  while (true) {
    __syncthreads();
    if (tid_() == 0) *sitem = atomicAdd(ctr, 1);
    __syncthreads();
    int it = *sitem;
    if (it >= N_ATT_ITEMS + N_S5_ITEMS) break;
    if (it < N_ATT_ITEMS) {
#ifndef NO_ATT
      attn_item(p, layer, it, smem);
#endif
    } else {
#ifndef NO_S5
      s5_unit<false>(p, layer, (it - N_ATT_ITEMS) * 8 + w, smem + w * S5_WAVE_LDS);
#endif
    }
  }
}

__device__ __forceinline__ void phase_s5p2(const Params& p, int layer, char* smem) {
  const int w = tid_() >> 6;
  for (int it = blockIdx.x; it < N_S5_ITEMS; it += gridDim.x) s5_unit<true>(p, layer, it * 8 + w, smem + w * S5_WAVE_LDS);
}

#define XB_TMO      128
#define XB_XCNT(j)  (256  + 64 * (j))
#define XB_XSUB(j)  (1280 + 64 * (j))
#define XB_XGEN(j)  (2304 + 64 * (j))
#define XB_TOP      3328
#define XB_TOPGEN   3392
#define XCD_BAR_WORDS 3456
#define XB_SPIN_CAP (1u << 18)
#define XLAS __attribute__((address_space(3)))

__device__ __forceinline__ unsigned xb_ld(unsigned* p)              { return __hip_atomic_load(p, __ATOMIC_RELAXED, __HIP_MEMORY_SCOPE_AGENT); }
__device__ __forceinline__ unsigned xb_add(unsigned* p, unsigned v) { return __hip_atomic_fetch_add(p, v, __ATOMIC_RELAXED, __HIP_MEMORY_SCOPE_AGENT); }
__device__ __forceinline__ unsigned xb_xcc_id() { return (unsigned)__builtin_amdgcn_s_getreg((3 << 11) | 20) & 0xFu; }
#define XB_SPIN(cond, bar) do { unsigned _sp = 0; while (cond) { __builtin_amdgcn_s_sleep(1); \
    if ((++_sp & 255u) == 0u) { if (xb_ld(&(bar)[XB_TMO])) break; if (_sp > XB_SPIN_CAP) { atomicAdd(&(bar)[XB_TMO], 1u); break; } } } } while (0)

struct XcdBarrier {
    unsigned* bar; unsigned x;
    volatile XLAS unsigned* st;
};

__device__ __forceinline__ XcdBarrier xcd_barrier_post(unsigned* bar, volatile XLAS unsigned* st) {
    XcdBarrier b; b.bar = bar; b.x = xb_xcc_id(); b.st = st;
    if (threadIdx.x == 0) (void)xb_add(&bar[XB_XCNT(b.x)], 1u);
    return b;
}
__device__ __forceinline__ void xcd_barrier_complete(unsigned* bar, unsigned x, unsigned& nloc, unsigned& nx) {
    const unsigned G = gridDim.x * gridDim.y * gridDim.z;
    unsigned sum, cnt, mine, sp = 0u;
    for (;;) {
        sum = 0u; cnt = 0u; mine = 0u;
#pragma unroll
        for (unsigned j = 0; j < 16; ++j) { const unsigned c = xb_ld(&bar[XB_XCNT(j)]); sum += c; cnt += (c > 0u) ? 1u : 0u; mine = (j == x) ? c : mine; }
        if (sum == G) break;
        __builtin_amdgcn_s_sleep(1);
        if ((++sp & 255u) == 0u) { if (xb_ld(&bar[XB_TMO])) break; if (sp > XB_SPIN_CAP) { atomicAdd(&bar[XB_TMO], 1u); break; } }
    }
    nloc = mine > 0u ? mine : 1u; nx = cnt > 0u ? cnt : 1u;
}

__device__ __forceinline__ void xcd_barrier(const XcdBarrier& b) {
    asm volatile("s_waitcnt vmcnt(0)" ::: "memory");
    __syncthreads();
    if (threadIdx.x == 0) {
        unsigned* bar = b.bar;
        __builtin_amdgcn_s_waitcnt(0);
        unsigned nloc = b.st[0], nx = b.st[1];
        if (nloc == 0u) { xcd_barrier_complete(bar, b.x, nloc, nx); b.st[0] = nloc; b.st[1] = nx; }
        const unsigned old = xb_add(&bar[XB_XSUB(b.x)], 1u);
        const unsigned gen = old / nloc;
        if (old + 1u == (gen + 1u) * nloc) {
            __builtin_amdgcn_fence(__ATOMIC_RELEASE, "agent");
            asm volatile("s_waitcnt vmcnt(0)" ::: "memory");
            const unsigned og = xb_add(&bar[XB_TOP], 1u);
            const unsigned tg = og / nx;
            if (og + 1u == (tg + 1u) * nx) xb_add(&bar[XB_TOPGEN], 1u);
            else XB_SPIN(xb_ld(&bar[XB_TOPGEN]) == tg, bar);
            __builtin_amdgcn_fence(__ATOMIC_ACQUIRE, "agent");
            xb_add(&bar[XB_XGEN(b.x)], 1u);
            asm volatile("s_waitcnt vmcnt(0)" ::: "memory");
        } else {
            XB_SPIN(xb_ld(&bar[XB_XGEN(b.x)]) == gen, bar);
            __builtin_amdgcn_fence(__ATOMIC_ACQUIRE, "agent");
            asm volatile("s_waitcnt vmcnt(0)" ::: "memory");
        }
    }
    __syncthreads();
}

__device__ __forceinline__ void phase_m_halves(const Params& p, int layer, char* smem, const XcdBarrier& xb) {
  u16* hn2h = (u16*)(p.ws + OFF_HN2);
  u16* G = (u16*)(p.ws + OFF_HN2 + 67108864L);
  const u16* win = (const u16*)(p.ws + OFF_WIN);
  const u16* wb = (const u16*)(p.ws + OFF_WB);
#pragma unroll 1
  for (int h = 0; h < 2; ++h) {
    phase_norm(p, false, p.in[6] + layer * 1024, hn2h, (long)h * 32768, (long)(h + 1) * 32768);
    xcd_barrier(xb);
#pragma unroll 1
    for (int i = 0; i < 3; ++i) {
      {
        EpiGateG E{G};
        run_gemm8(smem, hn2h, win + (long)(3200 + 1024 * i) * 1024, 1024, 1024, 1024, 1024, E, 32768);
      }
      xcd_barrier(xb);
      {
        const u16* ya = (const u16*)(p.ws + (i == 0 ? OFF_YA : i == 1 ? OFF_YB : OFF_Y)) + (long)h * 32768 * 512;
        EpiUpG E{G, (u16*)(p.ws + OFF_M) + (long)h * 32768 * 1024, i == 0};
        run_gemm8(smem, ya, wb + (long)i * 1024 * 512, 1024, 512, 512, 512, E, 32768);
      }
      if (!(h == 1 && i == 2)) xcd_barrier(xb);
    }
  }
}

__global__ void __launch_bounds__(NTHREADS) mega(Params p, int ph_lo, int ph_hi) {
  extern __shared__ __attribute__((aligned(16))) char smem[];
  cg::grid_group grid = cg::this_grid();
  volatile XLAS unsigned* xst = (volatile XLAS unsigned*)(smem + 132096);
  if (tid_() == 0) { xst[0] = 0u; xst[1] = 0u; }
  __syncthreads();
  XcdBarrier xb = xcd_barrier_post((unsigned*)(p.ws + OFF_BAR), xst);
  for (int ph = ph_lo; ph < ph_hi; ++ph) {
    const int layer = ph >> 4, sp = ph & 15;
    switch (sp) {
      case 0:
      case 13:
        if (sp == 0 && blockIdx.x == 0) {
          const int t0_ = tid_();
          if (t0_ == 0) ((int*)(p.ws + OFF_CTR))[layer] = 0;
          if (t0_ < 384) ((u32*)(p.ws + OFF_FLAG))[layer * 384 + t0_] = 0u;
        }
        phase_norm(p, ph == 0, (sp == 0 ? p.in[2] : p.in[33]) + layer * 1024, (u16*)(p.ws + OFF_HN), 0, NTOK);
        if (sp == 0) conv_ffn(p, layer, 0, smem);
        break;
      case 1:
      case 14:
        phase_ffn_a(p, smem);
        break;
      case 2:
      case 15:
        phase_ffn_b(p, ph == 2, smem);
        if (sp == 2) conv_mix(p, layer, smem);
        break;
      case 3:
      case 5: {
        const long lo = (sp == 3 ? 0 : 32768), hi = lo + 32768;
        phase_norm(p, false, p.in[6] + layer * 1024, (u16*)(p.ws + OFF_Y), lo, hi);
        break;
      }
      case 10: phase_m_halves(p, layer, smem, xb); break;
      case 4:
      case 6:
        phase_proj(p, sp == 6, smem);
        break;
      case 7: phase_mixer1(p, layer, smem); break;
      case 8: phase_s5p2(p, layer, smem); break;
      case 9: phase_glu(p, smem); break;
      case 11: break;
      case 12:
        phase_out(p, smem);
        conv_ffn(p, layer, 1, smem);
        break;
    }
    if (ph + 1 < ph_hi) {
      if (ph == ph_lo) {
        asm volatile("s_waitcnt vmcnt(0)" ::: "memory");
        __syncthreads();
        if (tid_() < 64) {
          __builtin_amdgcn_fence(__ATOMIC_RELEASE, "agent");
          asm volatile("s_waitcnt vmcnt(0)" ::: "memory");
        }
        grid.sync();
        if (tid_() < 64) {
          __builtin_amdgcn_fence(__ATOMIC_ACQUIRE, "agent");
          asm volatile("s_waitcnt vmcnt(0)" ::: "memory");
        }
        __syncthreads();
      } else {
        xcd_barrier(xb);
      }
    }
  }
}

extern "C" void kernel_launch(void* const* d_in, const int* in_sizes, int n_in, void* d_out, int out_size, void* d_ws,
                              size_t ws_size, hipStream_t stream) {
  static int grid_blocks = 0;
  if (!grid_blocks) {
    int dev = 0, cus = 0, per_cu = 0;
    hipGetDevice(&dev);
    hipDeviceGetAttribute(&cus, hipDeviceAttributeMultiprocessorCount, dev);
    hipFuncSetAttribute((const void*)mega, hipFuncAttributeMaxDynamicSharedMemorySize, SMEM_BYTES);
    hipOccupancyMaxActiveBlocksPerMultiprocessor(&per_cu, mega, NTHREADS, SMEM_BYTES);
    if (per_cu < 1) per_cu = 1;
    grid_blocks = cus * per_cu;
  }
  if (ws_size < (size_t)WS_NEED) {
    fprintf(stderr, "workspace too small: %zu\n", ws_size);
    return;
  }
  Params p{};
  for (int i = 0; i < 37; ++i) p.in[i] = (const float*)d_in[i];
  p.out = (float*)d_out;
  p.ws = (char*)d_ws;
  hipMemsetAsync((char*)d_ws + OFF_BAR, 0, XCD_BAR_WORDS * sizeof(unsigned), stream);
#ifndef ONE_LAUNCH
  for (int ph = 0; ph < 32; ++ph) {
    hipLaunchKernelGGL(mega, dim3(grid_blocks), dim3(NTHREADS), SMEM_BYTES, stream, p, ph, ph + 1);
  }
#else
  int lo = 0, hi = 32;
  void* args[] = {&p, &lo, &hi};
  hipError_t e = hipLaunchCooperativeKernel((const void*)mega, dim3(grid_blocks), dim3(NTHREADS), args, SMEM_BYTES, stream);
  if (e != hipSuccess) fprintf(stderr, "cooperative launch failed: %s (grid %d)\n", hipGetErrorString(e), grid_blocks);
#endif
}
```
